# Optimizing an MI355X kernel written in HIP

```python
import jax, jax.numpy as jnp
from jax import lax
import numpy as np

D_MODEL = 1024
BATCH = 8
SEQ = 2048
DEPTH = 1

N_META = 16
D_FF = 2816
RET_HEADS = 4
RET_DK = 256
RET_DV = 512
RET_CHUNK = 128
ATT_HEADS = 8
ATT_DH = 128
IDX_HEADS = 8
IDX_DH = 64
TOPK_MAX = 256
DSA_QBLOCK = 32
ROPE_THETA = 10000.0
EPS = 1e-6
RET_QK = RET_HEADS * RET_DK
RET_V = RET_HEADS * RET_DV
ATT_W = ATT_HEADS * ATT_DH
IDX_Q = IDX_HEADS * IDX_DH
IN_SPLITS = (RET_QK, RET_QK, RET_V, RET_V, ATT_W, ATT_W, ATT_W, IDX_Q, IDX_DH, IDX_HEADS, D_MODEL, D_MODEL)
D_IN = sum(IN_SPLITS)

kernel_name = 'hybrid_retention_dsa_macaron'


def rmsnorm(x, g):
    xf = x.astype(jnp.float32)
    y = xf * lax.rsqrt(jnp.mean(xf * xf, axis=-1, keepdims=True) + EPS)
    return (y * g.astype(jnp.float32)).astype(x.dtype)


def rope(x, pos):
    d = x.shape[-1]
    inv_freq = ROPE_THETA ** (-jnp.arange(0, d, 2, dtype=jnp.float32) / d)
    ang = pos.astype(jnp.float32)[:, None] * inv_freq[None, :]
    cos = jnp.cos(ang)[:, None, :]
    sin = jnp.sin(ang)[:, None, :]
    xf = x.astype(jnp.float32)
    x1, x2 = xf[..., : d // 2], xf[..., d // 2:]
    return jnp.concatenate([x1 * cos - x2 * sin, x2 * cos + x1 * sin], axis=-1).astype(x.dtype)


def swiglu(u, w_gate, w_up, w_down):
    return (jax.nn.silu(u @ w_gate) * (u @ w_up)) @ w_down


def retention(q, k, v):
    out_dtype = v.dtype
    q, k, v = (a.astype(jnp.float32) for a in (q, k, v))
    B, H, T, _ = q.shape
    C = RET_CHUNK
    n = (T - N_META) // C
    log_g = jnp.log1p(-(2.0 ** (-5.0 - jnp.arange(H, dtype=jnp.float32))))

    def decay_matrix(c):
        i = jnp.arange(c, dtype=jnp.float32)
        diff = i[:, None] - i[None, :]
        return jnp.where(diff >= 0, jnp.exp(log_g[:, None, None] * jnp.maximum(diff, 0.0)), 0.0)

    qm, km, vm = q[:, :, :N_META], k[:, :, :N_META], v[:, :, :N_META]
    y_meta = jnp.einsum('bhqk,bhke->bhqe', jnp.einsum('bhqd,bhkd->bhqk', qm, km) * decay_matrix(N_META), vm)
    zeta_m = jnp.exp(log_g[:, None] * (N_META - 1.0 - jnp.arange(N_META, dtype=jnp.float32)))
    state0 = jnp.einsum('bhkd,bhke->bhde', km * zeta_m[..., None], vm)

    d_in = decay_matrix(C)
    pos_c = jnp.arange(C, dtype=jnp.float32)
    xi = jnp.exp(log_g[:, None] * (pos_c + 1.0))[..., None]
    zeta = jnp.exp(log_g[:, None] * (C - 1.0 - pos_c))[..., None]
    g_chunk = jnp.exp(log_g * C)[:, None, None]

    def to_chunks(a):
        return a[:, :, N_META:].reshape(B, H, n, C, a.shape[-1]).transpose(2, 0, 1, 3, 4)

    def step(state, qkv):
        qc, kc, vc = qkv
        inner = jnp.einsum('bhqk,bhke->bhqe', jnp.einsum('bhqd,bhkd->bhqk', qc, kc) * d_in, vc)
        cross = jnp.einsum('bhqd,bhde->bhqe', qc, state) * xi
        state = g_chunk * state + jnp.einsum('bhkd,bhke->bhde', kc * zeta, vc)
        return state, inner + cross

    _, y_chunks = lax.scan(step, state0, (to_chunks(q), to_chunks(k), to_chunks(v)))
    y_real = y_chunks.transpose(1, 2, 0, 3, 4).reshape(B, H, n * C, v.shape[-1])
    y = jnp.concatenate([y_meta, y_real], axis=2)
    y = y * lax.rsqrt(jnp.mean(y * y, axis=-1, keepdims=True) + EPS)
    return y.astype(out_dtype)


def dsa_attention(q, k, v, qi, ki, wi, k_top):
    B, T, H, dh = q.shape
    nb = -(-T // DSA_QBLOCK)
    t_pad = nb * DSA_QBLOCK
    pad = t_pad - T

    def blocks(a):
        a = jnp.pad(a, [(0, 0), (0, pad)] + [(0, 0)] * (a.ndim - 2))
        return a.reshape((B, nb, DSA_QBLOCK) + a.shape[2:]).swapaxes(0, 1)

    pos_blocks = jnp.arange(t_pad, dtype=jnp.int32).reshape(nb, DSA_QBLOCK)
    key_pos = jnp.arange(T, dtype=jnp.int32)
    meta_pos = jnp.arange(N_META, dtype=jnp.int32)
    k_meta, v_meta = k[:, :N_META], v[:, :N_META]
    scale = ATT_DH ** -0.5
    idx_scale = (IDX_DH ** -0.5) * (IDX_HEADS ** -0.5)
    gather = jax.vmap(lambda a, i: a[i])

    def one_block(args):
        qb, qib, wib, tq = args
        rel = jax.nn.relu(jnp.einsum('bqhd,bsd->bqhs', qib, ki))
        score = jnp.einsum('bqh,bqhs->bqs', wib, rel).astype(jnp.float32) * idx_scale
        admissible = (key_pos[None, :] >= N_META) & (key_pos[None, :] <= tq[:, None])
        score = jnp.where(admissible[None], score, -jnp.inf)
        _, sel = lax.top_k(score, k_top)
        sel_ok = (sel >= N_META) & (sel <= tq[None, :, None])
        k_sel = gather(k, sel)
        v_sel = gather(v, sel)
        s_meta = jnp.einsum('bqhd,bmhd->bhqm', qb, k_meta).astype(jnp.float32) * scale
        s_meta = jnp.where((meta_pos[None, :] <= tq[:, None])[None, None], s_meta, -jnp.inf)
        s_sel = jnp.einsum('bqhd,bqkhd->bhqk', qb, k_sel).astype(jnp.float32) * scale
        s_sel = jnp.where(sel_ok[:, None], s_sel, -jnp.inf)
        p = jax.nn.softmax(jnp.concatenate([s_meta, s_sel], axis=-1), axis=-1).astype(v.dtype)
        return (jnp.einsum('bhqm,bmhd->bqhd', p[..., :N_META], v_meta)
                + jnp.einsum('bhqk,bqkhd->bqhd', p[..., N_META:], v_sel))

    out = lax.map(one_block, (blocks(q), blocks(qi), blocks(wi), pos_blocks))
    return out.swapaxes(0, 1).reshape(B, t_pad, H, dh)[:, :T]


def hybrid_mixer(u, pos, k_top, w_in, w_ret_out, w_att_out, w_mix_out):
    B, T, _ = u.shape
    proj = u @ w_in
    offs = [int(o) for o in np.cumsum(IN_SPLITS)[:-1]]
    rq, rk, rv, rg, aq, ak, av, iq, ik, iw, g_ret, g_att = jnp.split(proj, offs, axis=-1)
    rq = rope(rq.reshape(B, T, RET_HEADS, RET_DK), pos)
    rk = rope(rk.reshape(B, T, RET_HEADS, RET_DK), pos) * (RET_DK ** -0.5)
    rv = rv.reshape(B, T, RET_HEADS, RET_DV)
    yr = retention(rq.transpose(0, 2, 1, 3), rk.transpose(0, 2, 1, 3), rv.transpose(0, 2, 1, 3))
    yr = yr.transpose(0, 2, 1, 3).reshape(B, T, RET_V)
    yr = (jax.nn.silu(rg) * yr) @ w_ret_out
    aq = rope(aq.reshape(B, T, ATT_HEADS, ATT_DH), pos)
    ak = rope(ak.reshape(B, T, ATT_HEADS, ATT_DH), pos)
    av = av.reshape(B, T, ATT_HEADS, ATT_DH)
    iq = rope(iq.reshape(B, T, IDX_HEADS, IDX_DH), pos)
    ik = rope(ik.reshape(B, T, 1, IDX_DH), pos)[:, :, 0]
    ya = dsa_attention(aq, ak, av, iq, ik, iw, k_top).reshape(B, T, ATT_W) @ w_att_out
    merged = jax.nn.sigmoid(g_ret) * yr + jax.nn.sigmoid(g_att) * ya
    return merged @ w_mix_out


def setup_inputs(seed: int = 0) -> dict:
    key = jax.random.key(seed)
    ks = jax.random.split(key, 16)
    f32 = jnp.float32

    def dense(k, fan_in, fan_out):
        return jax.random.normal(k, (DEPTH, fan_in, fan_out), f32) * fan_in ** -0.5

    def gain(k, shape):
        return 1.0 + 0.02 * jax.random.normal(k, shape, f32)

    return {
        'x': jax.random.normal(ks[0], (BATCH, SEQ, D_MODEL), f32),
        'meta_tokens': jax.random.normal(ks[1], (N_META, D_MODEL), f32),
        'ffn1_norm': gain(ks[2], (DEPTH, D_MODEL)),
        'ffn1_w_gate': dense(ks[3], D_MODEL, D_FF),
        'ffn1_w_up': dense(ks[4], D_MODEL, D_FF),
        'ffn1_w_down': dense(ks[5], D_FF, D_MODEL),
        'mix_norm': gain(ks[6], (DEPTH, D_MODEL)),
        'w_in': dense(ks[7], D_MODEL, D_IN),
        'w_ret_out': dense(ks[8], RET_V, D_MODEL),
        'w_att_out': dense(ks[9], ATT_W, D_MODEL),
        'w_mix_out': dense(ks[10], D_MODEL, D_MODEL),
        'ffn2_norm': gain(ks[11], (DEPTH, D_MODEL)),
        'ffn2_w_gate': dense(ks[12], D_MODEL, D_FF),
        'ffn2_w_up': dense(ks[13], D_MODEL, D_FF),
        'ffn2_w_down': dense(ks[14], D_FF, D_MODEL),
        'final_norm': gain(ks[15], (D_MODEL,)),
    }


def reference(x, meta_tokens, ffn1_norm, ffn1_w_gate, ffn1_w_up, ffn1_w_down, mix_norm, w_in, w_ret_out, w_att_out, w_mix_out, ffn2_norm, ffn2_w_gate, ffn2_w_up, ffn2_w_down, final_norm):
    B, L, D = x.shape
    k_top = min(TOPK_MAX, L // 4)
    meta = jnp.broadcast_to(meta_tokens.astype(x.dtype)[None], (B, N_META, D))
    h = jnp.concatenate([meta, x], axis=1)
    pos = jnp.arange(h.shape[1], dtype=jnp.int32)
    for l in range(DEPTH):
        h = h + 0.5 * swiglu(rmsnorm(h, ffn1_norm[l]), ffn1_w_gate[l], ffn1_w_up[l], ffn1_w_down[l])
        h = h + hybrid_mixer(rmsnorm(h, mix_norm[l]), pos, k_top, w_in[l], w_ret_out[l], w_att_out[l], w_mix_out[l])
        h = h + 0.5 * swiglu(rmsnorm(h, ffn2_norm[l]), ffn2_w_gate[l], ffn2_w_up[l], ffn2_w_down[l])
    y = rmsnorm(h, final_norm)
    return y[:, N_META:]
```

```cpp
#include <hip/hip_runtime.h>
#include <hip/hip_cooperative_groups.h>
#include <cstdio>
#include <cstdint>
#include <cmath>
namespace cg = cooperative_groups;
namespace pg8 {
#define PG8_LAS __attribute__((address_space(3)))
typedef unsigned short bf16_t;
typedef short bf16x8 __attribute__((ext_vector_type(8)));
typedef float f32x4 __attribute__((ext_vector_type(4)));
typedef unsigned u32x4 __attribute__((ext_vector_type(4)));
constexpr int BM = 256, BK = 64, HALF = 128, HTB = HALF * BK * 2  , STAGE_BYTES = 8 * HTB, NXCD = 8, WGM = 8;

__host__ __device__ __forceinline__ int lds_byte(int r, int c) { const int st = (r >> 4) * 2 + (c >> 5), rr = r & 15, cc = c & 31, ob = rr * 64 + cc * 2; return st * 1024 + (ob ^ (((ob >> 9) & 1) << 5)); }
__host__ __device__ __forceinline__ void stage_rc(int b, int& R, int& C) { const int st = b / 1024, sb = b % 1024, swz = sb ^ (((sb >> 9) & 1) << 5); R = (st >> 1) * 16 + swz / 64; C = (st & 1) * 32 + (swz % 64) / 2; }
__host__ __device__ __forceinline__ int perm32(int rho) { const int n = rho >> 4, i = rho & 15; return 8 * (i >> 2) + 4 * n + (i & 3); }

struct Unit { int pm, pn; };
struct Gemm { const bf16_t* A; const bf16_t* Bt; int M, N, K; };

struct StaticOrder {
    int nM, nN, nwg, G, c;
    __host__ __device__ void init(int M, int N, int G_, int c_) { nM = M / BM; nN = N / BM; nwg = nM * nN; G = G_; c = c_; }
    __host__ __device__ bool next(int i, Unit& u) const {
        const long L = (long)i * G + c; if (L >= nwg) return false;
        int wgid = (int)L; { const int q = nwg / NXCD, r = nwg % NXCD, xcd = wgid % NXCD, off = wgid / NXCD; wgid = (xcd < r ? xcd * (q + 1) : r * (q + 1) + (xcd - r) * q) + off; }
        const int nig = WGM * nN, gid = wgid / nig, fm = gid * WGM, gsz = (nM - fm) < WGM ? (nM - fm) : WGM;
        u.pm = fm + ((wgid % nig) % gsz); u.pn = (wgid % nig) / gsz; return true;
    }
    __device__ __forceinline__ void a_ready(const Unit&) const {}
    __device__ __forceinline__ void done(const Unit&) const {}
};

__device__ __forceinline__ unsigned cvt_pk_bf16(float lo, float hi) { unsigned r; asm volatile("v_cvt_pk_bf16_f32 %0, %1, %2" : "=v"(r) : "v"(lo), "v"(hi)); return r; }

template <class Epi, class Sched, bool ALIGN_EPI = false, bool SP2 = false>
__device__ __forceinline__ void gemm_phase(PG8_LAS unsigned char* lds, const Gemm g, const Sched& S, const Epi& E) {
    const int tid = threadIdx.x, wid = __builtin_amdgcn_readfirstlane(tid >> 6), lane = tid & 63, wr = wid >> 2, wc = wid & 3, fr = lane & 15, fq = lane >> 4;
    const int K = g.K, nt = K / BK;
    unsigned voffA[2], voffB[2];
#pragma unroll
    for (int i = 0; i < 2; ++i) { int R, C; stage_rc(tid * 16 + i * 8192, R, C); const int Rb = Epi::PERM ? ((R & ~31) + perm32(R & 31)) : R;
        voffA[i] = (unsigned)(R * K + C) * 2u; voffB[i] = (unsigned)(Rb * K + C) * 2u; }
    const size_t kstep = (size_t)(BK * 2);
    const size_t hstep = (size_t)HALF * K * 2;
    const size_t tstep = 2 * hstep;
    const unsigned ldsw = (unsigned)wid * 1024u;
    const int aoff = lds_byte(wr * 64 + fr, fq * 8), boff = lds_byte(wc * 32 + fr, fq * 8);
#define PG8_SA(b, h) (((b) * 2 + (h)) * HTB)
#define PG8_SB(b, h) ((4 + (b) * 2 + (h)) * HTB)
#define PG8_STAGE(bufoff, gbase, voff) do { _Pragma("unroll") for (int _i = 0; _i < 2; ++_i) \
        __builtin_amdgcn_global_load_lds((const unsigned*)((const char*)(gbase) + (voff)[_i]), (PG8_LAS unsigned*)(lds + (bufoff) + ldsw + _i * 8192), 16, 0, 0); } while (0)
#define PG8_LDA(dst, b, h) do { _Pragma("unroll") for (int m = 0; m < 4; ++m) _Pragma("unroll") for (int k = 0; k < 2; ++k) dst[m][k] = *(const PG8_LAS bf16x8*)(lds + PG8_SA(b, h) + aoff + m * 2048 + k * 1024); } while (0)
#define PG8_LDB(dst, b, h) do { _Pragma("unroll") for (int n = 0; n < 2; ++n) _Pragma("unroll") for (int k = 0; k < 2; ++k) dst[n][k] = *(const PG8_LAS bf16x8*)(lds + PG8_SB(b, h) + boff + n * 2048 + k * 1024); } while (0)
#define PG8_MMA(ai, bj, At, Bt) do { __builtin_amdgcn_s_setprio(1); _Pragma("unroll") for (int m = 0; m < 4; ++m) _Pragma("unroll") for (int n = 0; n < 2; ++n) _Pragma("unroll") for (int k = 0; k < 2; ++k) \
        acc[ai][bj][m][n] = __builtin_amdgcn_mfma_f32_16x16x32_bf16(Bt[n][k], At[m][k], acc[ai][bj][m][n], 0, 0, 0); __builtin_amdgcn_s_setprio(0); } while (0)
#define PG8_WAIT_V(n) asm volatile("s_waitcnt vmcnt(" #n ")" ::: "memory")
#define PG8_WAIT_L(n) asm volatile("s_waitcnt lgkmcnt(" #n ")" ::: "memory")
#define PG8_BAR __builtin_amdgcn_s_barrier()
#define PG8_SCHED __builtin_amdgcn_sched_barrier(0)
    Unit cur, nxt; int ui = 0;
    if (!S.next(0, cur)) return;
    f32x4 acc[2][2][4][2];
#pragma unroll
    for (int a = 0; a < 2; ++a)
#pragma unroll
        for (int b = 0; b < 2; ++b)
#pragma unroll
            for (int m = 0; m < 4; ++m)
#pragma unroll
                for (int n = 0; n < 2; ++n) acc[a][b][m][n] = (f32x4){0.f, 0.f, 0.f, 0.f};
    bf16x8 At[4][2], B0[2][2], B1[2][2];
    const char* cA = (const char*)g.A + (size_t)cur.pm * tstep; const char* cB = (const char*)g.Bt + (size_t)cur.pn * tstep;
    S.a_ready(cur);
    if constexpr (SP2) {
        PG8_STAGE(PG8_SB(0, 0), cB, voffB); PG8_STAGE(PG8_SB(0, 1), cB + hstep, voffB); PG8_STAGE(PG8_SA(0, 0), cA, voffA); PG8_STAGE(PG8_SA(0, 1), cA + hstep, voffA);
        if (wr == 1) PG8_BAR;
        PG8_WAIT_V(2); PG8_BAR;
        PG8_STAGE(PG8_SB(1, 0), cB + kstep, voffB); PG8_STAGE(PG8_SA(1, 0), cA + kstep, voffA); PG8_STAGE(PG8_SB(1, 1), cB + hstep + kstep, voffB);
        PG8_WAIT_V(6); PG8_BAR;
    } else {
        PG8_STAGE(PG8_SB(0, 0), cB, voffB); PG8_STAGE(PG8_SA(0, 0), cA, voffA); PG8_STAGE(PG8_SB(0, 1), cB + hstep, voffB); PG8_STAGE(PG8_SA(0, 1), cA + hstep, voffA);
        if (wr == 1) PG8_BAR;
        PG8_WAIT_V(4); PG8_BAR;
        PG8_STAGE(PG8_SB(1, 0), cB + kstep, voffB); PG8_STAGE(PG8_SA(1, 0), cA + kstep, voffA); PG8_STAGE(PG8_SB(1, 1), cB + hstep + kstep, voffB);
        PG8_WAIT_V(6); PG8_BAR;
    }
    for (;;) {
        const bool has_next = S.next(ui + 1, nxt);
        const char* nA = has_next ? (const char*)g.A + (size_t)nxt.pm * tstep : cA; const char* nB = has_next ? (const char*)g.Bt + (size_t)nxt.pn * tstep : cB;
        for (int t = 0; t < nt; t += 2) {
            const bool last = (t == nt - 2);
            const char* a1 = cA + (size_t)(t + 1) * kstep;
            const char* a2 = last ? nA : cA + (size_t)(t + 2) * kstep; const char* b2 = last ? nB : cB + (size_t)(t + 2) * kstep;
            const char* a3 = a2 + kstep; const char* b3 = b2 + kstep;
            if (last && has_next) S.a_ready(nxt);
            if constexpr (SP2) {
            PG8_LDB(B0, 0, 0); PG8_LDB(B1, 0, 1); PG8_SCHED; PG8_LDA(At, 0, 0); PG8_STAGE(PG8_SA(1, 1), a1 + hstep, voffA);
            PG8_WAIT_V(8); PG8_WAIT_L(0); PG8_BAR; PG8_MMA(0, 0, At, B0); PG8_MMA(0, 1, At, B1); PG8_BAR; PG8_SCHED;
            PG8_LDA(At, 0, 1); PG8_STAGE(PG8_SB(0, 0), b2, voffB); PG8_STAGE(PG8_SB(0, 1), b2 + hstep, voffB); PG8_STAGE(PG8_SA(0, 0), a2, voffA);
            PG8_WAIT_V(8); PG8_WAIT_L(0); PG8_BAR; PG8_MMA(1, 0, At, B0); PG8_MMA(1, 1, At, B1); PG8_BAR; PG8_SCHED;
            PG8_LDB(B0, 1, 0); PG8_LDB(B1, 1, 1); PG8_SCHED; PG8_LDA(At, 1, 0); PG8_STAGE(PG8_SA(0, 1), a2 + hstep, voffA);
            PG8_WAIT_V(8); PG8_WAIT_L(0); PG8_BAR; PG8_MMA(0, 0, At, B0); PG8_MMA(0, 1, At, B1); PG8_BAR; PG8_SCHED;
            PG8_LDA(At, 1, 1); PG8_STAGE(PG8_SB(1, 0), b3, voffB); PG8_STAGE(PG8_SB(1, 1), b3 + hstep, voffB); PG8_STAGE(PG8_SA(1, 0), a3, voffA);
            PG8_WAIT_V(8); PG8_WAIT_L(0); PG8_BAR; PG8_MMA(1, 0, At, B0); PG8_MMA(1, 1, At, B1); PG8_BAR; PG8_SCHED;
            } else {
            PG8_LDB(B0, 0, 0); PG8_SCHED; PG8_LDA(At, 0, 0); PG8_STAGE(PG8_SA(1, 1), a1 + hstep, voffA);
            PG8_WAIT_L(8); PG8_BAR; PG8_WAIT_L(0); PG8_MMA(0, 0, At, B0); PG8_BAR; PG8_SCHED;
            PG8_LDB(B1, 0, 1); PG8_STAGE(PG8_SB(0, 0), b2, voffB);
            PG8_BAR; PG8_WAIT_L(0); PG8_MMA(0, 1, At, B1); PG8_BAR;
            PG8_LDA(At, 0, 1); PG8_STAGE(PG8_SA(0, 0), a2, voffA);
            PG8_BAR; PG8_WAIT_L(0); PG8_MMA(1, 0, At, B0); PG8_BAR; PG8_SCHED;
            PG8_STAGE(PG8_SB(0, 1), b2 + hstep, voffB);
            PG8_WAIT_V(6); PG8_BAR; PG8_MMA(1, 1, At, B1); PG8_BAR;
            PG8_LDB(B0, 1, 0); PG8_SCHED; PG8_LDA(At, 1, 0); PG8_STAGE(PG8_SA(0, 1), a2 + hstep, voffA);
            PG8_WAIT_L(8); PG8_BAR; PG8_WAIT_L(0); PG8_MMA(0, 0, At, B0); PG8_BAR; PG8_SCHED;
            PG8_LDB(B1, 1, 1); PG8_STAGE(PG8_SB(1, 0), b3, voffB);
            PG8_BAR; PG8_WAIT_L(0); PG8_MMA(0, 1, At, B1); PG8_BAR;
            PG8_LDA(At, 1, 1); PG8_STAGE(PG8_SA(1, 0), a3, voffA);
            PG8_BAR; PG8_WAIT_L(0); PG8_MMA(1, 0, At, B0); PG8_BAR; PG8_SCHED;
            PG8_STAGE(PG8_SB(1, 1), b3 + hstep, voffB);
            PG8_WAIT_V(6); PG8_BAR; PG8_MMA(1, 1, At, B1); PG8_BAR;
            }
        }
        if constexpr (ALIGN_EPI) { if (wr == 0) PG8_BAR; }
        if constexpr (!Epi::AFTER_DRAIN) { E(acc, cur, wr, wc, fr, fq); S.done(cur); }
        if (!has_next) break;
#pragma unroll
        for (int a = 0; a < 2; ++a)
#pragma unroll
            for (int b = 0; b < 2; ++b)
#pragma unroll
                for (int m = 0; m < 4; ++m)
#pragma unroll
                    for (int n = 0; n < 2; ++n) acc[a][b][m][n] = (f32x4){0.f, 0.f, 0.f, 0.f};
        cur = nxt; cA = nA; cB = nB; ++ui;
        if constexpr (ALIGN_EPI) { if (wr == 1) PG8_BAR; }
    }
    PG8_WAIT_V(0);
    if constexpr (!ALIGN_EPI) { if (wr == 0) PG8_BAR; }
    PG8_BAR;
    if constexpr (Epi::AFTER_DRAIN) { E.fused(acc, cur, wr, wc, fr, fq, lds, wid, lane); S.done(cur); }
#undef PG8_SA
#undef PG8_SB
#undef PG8_STAGE
#undef PG8_LDA
#undef PG8_LDB
#undef PG8_MMA
#undef PG8_WAIT_V
#undef PG8_WAIT_L
#undef PG8_BAR
#undef PG8_SCHED
}
}
#ifndef MK_COOP
#define MK_COOP 1
#endif
using pg8::bf16_t; using pg8::bf16x8; using pg8::f32x4; using pg8::cvt_pk_bf16;
typedef short bf16x4 __attribute__((ext_vector_type(4)));
typedef unsigned long long u64;

constexpr int NB = 8, SEQ = 2048, NMETA = 16, TT = 2064, TP = 2112, DM = 1024, DFF = 2816;
constexpr int MR = NB * SEQ;
constexpr int MP = MR + 256;
constexpr int DIN = 11848;
constexpr int O_RQ = 0, O_RK = 1024, O_RV = 2048, O_RG = 4096, O_AQ = 6144, O_AK = 7168, O_AV = 8192, O_IQ = 9216, O_IK = 9728, O_IW = 9792, O_GR = 9800, O_GA = 10824;
constexpr float EPSN = 1e-6f;
constexpr size_t MiB = 1u << 20;
constexpr size_t WS_ZERO = 0;
constexpr size_t OFF_CTR = 0;
constexpr size_t OFF_SSQ1 = 4096;
constexpr size_t OFF_SSQ2 = OFF_SSQ1 + MP * 4;
constexpr size_t OFF_SSQ3 = OFF_SSQ2 + MR * 4;
constexpr size_t OFF_SSQY = OFF_SSQ3 + MR * 4;
constexpr size_t ZERO_BYTES = OFF_SSQY + (size_t)MR * 16;
constexpr size_t OFF_SSQ0 = 512 * 1024;
constexpr size_t OFF_IW = 1 * MiB;
constexpr size_t OFF_TAB256 = 2 * MiB;
constexpr size_t OFF_TAB128 = OFF_TAB256 + (size_t)TT * 128 * 8;
constexpr size_t OFF_TAB64 = OFF_TAB128 + (size_t)TT * 64 * 8;
constexpr size_t OFF_MASK = 6 * MiB;
constexpr size_t OFF_WINA = 11 * MiB;
constexpr size_t OFF_WINB = 19 * MiB;
constexpr size_t OFF_WINC = OFF_WINB + (size_t)5888 * 1024 * 2;
constexpr size_t OFF_WRO = OFF_WINC + 4 * MiB;
constexpr size_t OFF_WAO = OFF_WRO + 4 * MiB;
constexpr size_t OFF_WMX = OFF_WAO + 2 * MiB;
constexpr size_t OFF_W2 = OFF_WMX + 2 * MiB;
constexpr size_t OFF_WD2 = OFF_W2 + 11 * MiB;
constexpr size_t OFF_H1B = 59 * MiB;
constexpr size_t OFF_DELTA = OFF_H1B + (size_t)MP * 1024 * 2;
constexpr size_t OFF_R = OFF_DELTA + 32 * MiB;
constexpr size_t OFF_W1 = OFF_R;
constexpr size_t OFF_WD1 = OFF_R + 11 * MiB;
constexpr size_t OFF_ACT = OFF_R + 16 * MiB + MiB / 2;
constexpr size_t OFF_RQ = OFF_R;
constexpr size_t OFF_RKS = OFF_R + 32 * MiB;
constexpr size_t OFF_RVT = OFF_R + 65 * MiB;
constexpr size_t OFF_AQ = OFF_R;
constexpr size_t OFF_AKS = OFF_R + 32 * MiB;
constexpr size_t OFF_AVT = OFF_R + 65 * MiB;
constexpr size_t OFF_IQ = OFF_R + 98 * MiB;
constexpr size_t OFF_IK = OFF_R + 114 * MiB;
constexpr size_t OFF_YR = OFF_R + 32 * MiB;
constexpr size_t OFF_YA = OFF_R + 65 * MiB;
constexpr size_t OFF_ACT2 = OFF_R;
static_assert(OFF_ACT + (size_t)MP * DFF * 2 <= 256 * MiB && OFF_RVT + (size_t)8 * 4 * 512 * TP * 2 <= 256 * MiB && OFF_IK + 2 * MiB <= 256 * MiB, "ws map");
static_assert(OFF_WD2 + (size_t)1024 * 2816 * 2 <= OFF_H1B && OFF_MASK + (size_t)MR * 66 * 4 <= OFF_WINA && OFF_TAB64 + (size_t)TT * 32 * 8 <= OFF_MASK && ZERO_BYTES <= OFF_SSQ0, "ws map 2");
constexpr int LDS_BYTES = 131072 + 1024;
constexpr int LDS_CTL = 131072;

struct Args {
    const float* in[16]; float* out; unsigned char* ws; float l2g[4]; int ph_lo, ph_hi;
};
static_assert(sizeof(Args) == 16 * 8 + 16 + 16 + 8, "Args has no padding");

__device__ __forceinline__ float wave_sum(float v) {
#pragma unroll
    for (int o = 1; o < 64; o <<= 1) v += __shfl_xor(v, o);
    return v;
}
__device__ __forceinline__ bf16_t f2bf(float v) { return (bf16_t)(cvt_pk_bf16(v, 0.f) & 0xffffu); }
__device__ __forceinline__ float bf2f(unsigned short b) { return __uint_as_float((unsigned)b << 16); }
__device__ __forceinline__ uint2 pack4(float a, float b, float c, float d) { uint2 r; r.x = cvt_pk_bf16(a, b); r.y = cvt_pk_bf16(c, d); return r; }
__device__ __forceinline__ f32x4 unpack4(uint2 v) { f32x4 r; r[0] = __uint_as_float(v.x << 16); r[1] = __uint_as_float(v.x & 0xffff0000u); r[2] = __uint_as_float(v.y << 16); r[3] = __uint_as_float(v.y & 0xffff0000u); return r; }
__device__ __forceinline__ float silu_f(float x) { return x * __builtin_amdgcn_rcpf(1.f + __expf(-x)); }
__device__ __forceinline__ float sigm_f(float x) { return __builtin_amdgcn_rcpf(1.f + __expf(-x)); }
__device__ __forceinline__ float rstd1024(const float* ssq, int row) { return rsqrtf(ssq[row] * (1.f / 1024.f) + EPSN); }
#define EPI_ROWS_BEGIN  _Pragma("unroll") for (int ai = 0; ai < 2; ++ai) _Pragma("unroll") for (int m = 0; m < 4; ++m) { const int row = u.pm * 256 + ai * 128 + wr * 64 + m * 16 + fr;
#define EPI_ROWS_END    }

struct EpiSwiGLU {
    static constexpr bool PERM = false, AFTER_DRAIN = false;
    bf16_t* act; const float* ssq;
    __device__ __forceinline__ void operator()(const f32x4 (&acc)[2][2][4][2], const pg8::Unit& u, int wr, int wc, int fr, int fq) const {
        EPI_ROWS_BEGIN
            const float r = rstd1024(ssq, row);
#pragma unroll
            for (int bj = 0; bj < 2; ++bj) {
                const int f0 = u.pn * 128 + bj * 64 + wc * 16 + fq * 4;
                const f32x4 g = acc[ai][bj][m][0] * r, uu = acc[ai][bj][m][1] * r;
                *(uint2*)(act + (size_t)row * DFF + f0) = pack4(silu_f(g[0]) * uu[0], silu_f(g[1]) * uu[1], silu_f(g[2]) * uu[2], silu_f(g[3]) * uu[3]);
            }
        EPI_ROWS_END
    }
};

struct EpiResid {
    static constexpr bool PERM = false, AFTER_DRAIN = false;
    const float* resf; const bf16_t* resd; const float* meta; float* outf; bf16_t* outb; bf16_t* outd; float* ssq; float alpha;
    __device__ __forceinline__ void operator()(const f32x4 (&acc)[2][2][4][2], const pg8::Unit& u, int wr, int wc, int fr, int fq) const {
        EPI_ROWS_BEGIN
            float part = 0.f;
#pragma unroll
            for (int bj = 0; bj < 2; ++bj)
#pragma unroll
                for (int n = 0; n < 2; ++n) {
                    const int c0 = u.pn * 256 + bj * 128 + wc * 32 + n * 16 + fq * 4;
                    const f32x4 a = acc[ai][bj][m][n] * alpha;
                    f32x4 res = (f32x4){0.f, 0.f, 0.f, 0.f};
                    if (row < MR) { res = *(const f32x4*)(resf + (size_t)row * DM + c0); if (resd) res += unpack4(*(const uint2*)(resd + (size_t)row * DM + c0)); }
                    else if (meta && row < MR + NMETA) res = *(const f32x4*)(meta + (size_t)(row - MR) * DM + c0);
                    const f32x4 h = res + a;
                    part += (h[0] * h[0] + h[1] * h[1]) + (h[2] * h[2] + h[3] * h[3]);
                    if (outf && row < MR) *(f32x4*)(outf + (size_t)row * DM + c0) = h;
                    if (outb) *(uint2*)(outb + (size_t)row * DM + c0) = pack4(h[0], h[1], h[2], h[3]);
                    if (outd && row < MR) *(uint2*)(outd + (size_t)row * DM + c0) = pack4(a[0], a[1], a[2], a[3]);
                }
            part += __shfl_xor(part, 16); part += __shfl_xor(part, 32);
            if (fq == 0) atomicAdd(ssq + row, part);
        EPI_ROWS_END
    }
};

struct EpiRet {
    static constexpr bool PERM = false, AFTER_DRAIN = false;
    const float* ssq1; const float2* tab256; bf16_t* RQ; bf16_t* RKs; bf16_t* RVt;
    __device__ __forceinline__ void operator()(const f32x4 (&acc)[2][2][4][2], const pg8::Unit& u, int wr, int wc, int fr, int fq) const {
        EPI_ROWS_BEGIN
            if (row < MR + NMETA) {
                const float r = rstd1024(ssq1, row);
                const bool real = row < MR; const int b = row >> 11; const int pos = real ? NMETA + (row & 2047) : row - MR;
                if (u.pn < 8) {
                    if (u.pn >= 4 || real) {
                        const int head = u.pn & 3; const float sc = u.pn < 4 ? 1.f : 0.0625f;
#pragma unroll
                        for (int bj = 0; bj < 2; ++bj) {
                            const int jj0 = 16 * (4 * bj + wc) + 4 * fq;
                            const float4* tp = (const float4*)(tab256 + (size_t)pos * 128 + jj0);
                            const float4 t0 = tp[0], t1 = tp[1];
                            const f32x4 x1 = acc[ai][bj][m][0] * (r * sc), x2 = acc[ai][bj][m][1] * (r * sc);
                            const uint2 o1 = pack4(x1[0] * t0.x - x2[0] * t0.y, x1[1] * t0.z - x2[1] * t0.w, x1[2] * t1.x - x2[2] * t1.y, x1[3] * t1.z - x2[3] * t1.w);
                            const uint2 o2 = pack4(x2[0] * t0.x + x1[0] * t0.y, x2[1] * t0.z + x1[1] * t0.w, x2[2] * t1.x + x1[2] * t1.y, x2[3] * t1.z + x1[3] * t1.w);
                            if (u.pn < 4) { bf16_t* d = RQ + (size_t)row * 1024 + head * 256 + jj0; *(uint2*)d = o1; *(uint2*)(d + 128) = o2; }
                            else if (real) { bf16_t* d = RKs + ((size_t)b * TP + pos) * 1024 + head * 256 + jj0; *(uint2*)d = o1; *(uint2*)(d + 128) = o2; }
                            else { for (int bb = 0; bb < NB; ++bb) { bf16_t* d = RKs + ((size_t)bb * TP + pos) * 1024 + head * 256 + jj0; *(uint2*)d = o1; *(uint2*)(d + 128) = o2; } }
                        }
                    }
                } else {
#pragma unroll
                    for (int bj = 0; bj < 2; ++bj)
#pragma unroll
                        for (int n = 0; n < 2; ++n) {
                            const int cin = (u.pn - 8) * 256 + bj * 128 + wc * 32 + n * 16 + fq * 4; const int head = cin >> 9, dv = cin & 511;
                            const f32x4 v = acc[ai][bj][m][n] * r;
                            const bf16_t v0 = f2bf(v[0]), v1 = f2bf(v[1]), v2 = f2bf(v[2]), v3 = f2bf(v[3]);
                            if (real) { bf16_t* d = RVt + ((size_t)(b * 4 + head) * 512 + dv) * TP + pos; d[0] = v0; d[TP] = v1; d[2 * TP] = v2; d[3 * TP] = v3; }
                            else { for (int bb = 0; bb < NB; ++bb) { bf16_t* d = RVt + ((size_t)(bb * 4 + head) * 512 + dv) * TP + pos; d[0] = v0; d[TP] = v1; d[2 * TP] = v2; d[3 * TP] = v3; } }
                        }
                }
            }
        EPI_ROWS_END
    }
};

struct EpiAtt {
    static constexpr bool PERM = false, AFTER_DRAIN = false;
    const float* ssq1; const float2* tab128; const float2* tab64; const float* ssqY;
    bf16_t* AQ; bf16_t* AKs; bf16_t* AVt; bf16_t* IQ; bf16_t* IK; float* IW; bf16_t* Y;
    __device__ __forceinline__ void operator()(const f32x4 (&acc)[2][2][4][2], const pg8::Unit& u, int wr, int wc, int fr, int fq) const {
        EPI_ROWS_BEGIN
            const bool real = row < MR;
            if (real || (row < MR + NMETA && u.pn >= 4 && u.pn < 12)) {
                const float r = rstd1024(ssq1, row);
                const int b = row >> 11; const int pos = real ? NMETA + (row & 2047) : row - MR;
                if (u.pn < 8) {
#pragma unroll
                    for (int bj = 0; bj < 2; ++bj) {
                        const int head = 2 * (u.pn & 3) + bj; const int jj0 = 16 * wc + 4 * fq;
                        const float4* tp = (const float4*)(tab128 + (size_t)pos * 64 + jj0);
                        const float4 t0 = tp[0], t1 = tp[1];
                        const f32x4 x1 = acc[ai][bj][m][0] * r, x2 = acc[ai][bj][m][1] * r;
                        const uint2 o1 = pack4(x1[0] * t0.x - x2[0] * t0.y, x1[1] * t0.z - x2[1] * t0.w, x1[2] * t1.x - x2[2] * t1.y, x1[3] * t1.z - x2[3] * t1.w);
                        const uint2 o2 = pack4(x2[0] * t0.x + x1[0] * t0.y, x2[1] * t0.z + x1[1] * t0.w, x2[2] * t1.x + x1[2] * t1.y, x2[3] * t1.z + x1[3] * t1.w);
                        if (u.pn < 4) { bf16_t* d = AQ + (size_t)row * 1024 + head * 128 + jj0; *(uint2*)d = o1; *(uint2*)(d + 64) = o2; }
                        else if (real) { bf16_t* d = AKs + ((size_t)b * TP + pos) * 1024 + head * 128 + jj0; *(uint2*)d = o1; *(uint2*)(d + 64) = o2; }
                        else { for (int bb = 0; bb < NB; ++bb) { bf16_t* d = AKs + ((size_t)bb * TP + pos) * 1024 + head * 128 + jj0; *(uint2*)d = o1; *(uint2*)(d + 64) = o2; } }
                    }
                } else if (u.pn < 12) {
#pragma unroll
                    for (int bj = 0; bj < 2; ++bj)
#pragma unroll
                        for (int n = 0; n < 2; ++n) {
                            const int cin = (u.pn - 8) * 256 + bj * 128 + wc * 32 + n * 16 + fq * 4; const int head = cin >> 7, dd = cin & 127;
                            const f32x4 v = acc[ai][bj][m][n] * r;
                            const bf16_t v0 = f2bf(v[0]), v1 = f2bf(v[1]), v2 = f2bf(v[2]), v3 = f2bf(v[3]);
                            if (real) { bf16_t* d = AVt + ((size_t)(b * 8 + head) * 128 + dd) * TP + pos; d[0] = v0; d[TP] = v1; d[2 * TP] = v2; d[3 * TP] = v3; }
                            else { for (int bb = 0; bb < NB; ++bb) { bf16_t* d = AVt + ((size_t)(bb * 8 + head) * 128 + dd) * TP + pos; d[0] = v0; d[TP] = v1; d[2 * TP] = v2; d[3 * TP] = v3; } }
                        }
                } else if (u.pn < 14) {
#pragma unroll
                    for (int bj = 0; bj < 2; ++bj) {
                        const int head = (u.pn - 12) * 4 + 2 * bj + (wc >> 1); const int jj0 = 16 * (wc & 1) + 4 * fq;
                        const float4* tp = (const float4*)(tab64 + (size_t)pos * 32 + jj0);
                        const float4 t0 = tp[0], t1 = tp[1];
                        const f32x4 x1 = acc[ai][bj][m][0] * r, x2 = acc[ai][bj][m][1] * r;
                        bf16_t* d = IQ + (size_t)row * 512 + head * 64 + jj0;
                        *(uint2*)d = pack4(x1[0] * t0.x - x2[0] * t0.y, x1[1] * t0.z - x2[1] * t0.w, x1[2] * t1.x - x2[2] * t1.y, x1[3] * t1.z - x2[3] * t1.w);
                        *(uint2*)(d + 32) = pack4(x2[0] * t0.x + x1[0] * t0.y, x2[1] * t0.z + x1[1] * t0.w, x2[2] * t1.x + x1[2] * t1.y, x2[3] * t1.z + x1[3] * t1.w);
                    }
                } else if (u.pn == 14) {
                    if (wc < 2) {
                        const int jj0 = 16 * wc + 4 * fq;
                        const float4* tp = (const float4*)(tab64 + (size_t)pos * 32 + jj0);
                        const float4 t0 = tp[0], t1 = tp[1];
                        const f32x4 x1 = acc[ai][0][m][0] * r, x2 = acc[ai][0][m][1] * r;
                        bf16_t* d = IK + (size_t)row * 64 + jj0;
                        *(uint2*)d = pack4(x1[0] * t0.x - x2[0] * t0.y, x1[1] * t0.z - x2[1] * t0.w, x1[2] * t1.x - x2[2] * t1.y, x1[3] * t1.z - x2[3] * t1.w);
                        *(uint2*)(d + 32) = pack4(x2[0] * t0.x + x1[0] * t0.y, x2[1] * t0.z + x1[1] * t0.w, x2[2] * t1.x + x1[2] * t1.y, x2[3] * t1.z + x1[3] * t1.w);
                    } else if (wc == 2 && fq < 2) {
                        *(f32x4*)(IW + (size_t)row * 8 + 4 * fq) = acc[ai][0][m][0] * r;
                    }
                } else {
#pragma unroll
                    for (int bj = 0; bj < 2; ++bj)
#pragma unroll
                        for (int n = 0; n < 2; ++n) {
                            const int cin = (u.pn - 15) * 256 + bj * 128 + wc * 32 + n * 16 + fq * 4; const int head = cin >> 9;
                            const float ys = rsqrtf(ssqY[(size_t)row * 4 + head] * (1.f / 512.f) + EPSN);
                            bf16_t* yp = Y + (size_t)row * 2048 + cin;
                            const f32x4 y = unpack4(*(const uint2*)yp); const f32x4 g = acc[ai][bj][m][n] * r;
                            *(uint2*)yp = pack4(silu_f(g[0]) * y[0] * ys, silu_f(g[1]) * y[1] * ys, silu_f(g[2]) * y[2] * ys, silu_f(g[3]) * y[3] * ys);
                        }
                }
            }
        EPI_ROWS_END
    }
};

struct EpiPlain {
    static constexpr bool PERM = false, AFTER_DRAIN = false;
    bf16_t* out;
    __device__ __forceinline__ void operator()(const f32x4 (&acc)[2][2][4][2], const pg8::Unit& u, int wr, int wc, int fr, int fq) const {
        EPI_ROWS_BEGIN
#pragma unroll
            for (int bj = 0; bj < 2; ++bj)
#pragma unroll
                for (int n = 0; n < 2; ++n) {
                    const int c0 = u.pn * 256 + bj * 128 + wc * 32 + n * 16 + fq * 4; const f32x4 a = acc[ai][bj][m][n];
                    *(uint2*)(out + (size_t)row * DM + c0) = pack4(a[0], a[1], a[2], a[3]);
                }
        EPI_ROWS_END
    }
};

struct EpiGate {
    static constexpr bool PERM = false, AFTER_DRAIN = false;
    const float* ssq1; bf16_t* yr; const bf16_t* ya;
    __device__ __forceinline__ void operator()(const f32x4 (&acc)[2][2][4][2], const pg8::Unit& u, int wr, int wc, int fr, int fq) const {
        EPI_ROWS_BEGIN
            const float r = rstd1024(ssq1, row);
#pragma unroll
            for (int bj = 0; bj < 2; ++bj) {
                const int f0 = u.pn * 128 + bj * 64 + wc * 16 + fq * 4;
                const f32x4 gr = acc[ai][bj][m][0] * r, ga = acc[ai][bj][m][1] * r;
                bf16_t* yp = yr + (size_t)row * DM + f0;
                const f32x4 a = unpack4(*(const uint2*)yp), c = unpack4(*(const uint2*)(ya + (size_t)row * DM + f0));
                *(uint2*)yp = pack4(sigm_f(gr[0]) * a[0] + sigm_f(ga[0]) * c[0], sigm_f(gr[1]) * a[1] + sigm_f(ga[1]) * c[1],
                                    sigm_f(gr[2]) * a[2] + sigm_f(ga[2]) * c[2], sigm_f(gr[3]) * a[3] + sigm_f(ga[3]) * c[3]);
            }
        EPI_ROWS_END
    }
};
template <class Map>
__device__ __forceinline__ void convert_w(int K, int N, bf16_t* Wt, int Nd, const float* gain, Map map, unsigned char* smem) {
    bf16_t* tile = (bf16_t*)smem;
    const int tid = threadIdx.x; const int ntk = K / 64, nt = (Nd / 64) * ntk;
    for (int t = blockIdx.x; t < nt; t += gridDim.x) {
        const int n0 = (t / ntk) * 64, k0 = (t % ntk) * 64;
        const int kr = tid >> 4, nq = tid & 15;
        const float* W = nullptr; const int src = map(n0 + 4 * nq, W);
#pragma unroll
        for (int p = 0; p < 2; ++p) {
            const int kl = kr + 32 * p, k = k0 + kl;
            float4 v = make_float4(0.f, 0.f, 0.f, 0.f);
            if (src >= 0) v = *(const float4*)(W + (size_t)k * N + src);
            const float g = gain ? gain[k] : 1.f;
            tile[(4 * nq + 0) * 72 + kl] = f2bf(v.x * g); tile[(4 * nq + 1) * 72 + kl] = f2bf(v.y * g);
            tile[(4 * nq + 2) * 72 + kl] = f2bf(v.z * g); tile[(4 * nq + 3) * 72 + kl] = f2bf(v.w * g);
        }
        __syncthreads();
        const int nl = tid >> 3, kc = tid & 7;
        *(uint4*)(Wt + (size_t)(n0 + nl) * K + k0 + 8 * kc) = *(const uint4*)(tile + nl * 72 + 8 * kc);
        __syncthreads();
    }
}
__device__ __forceinline__ int rope_nat(int c, int dbits) {
    const int g = c >> 5, hi = (c >> 4) & 1, i = c & 15; return (hi << (dbits - 1)) + 16 * g + i;
}

__device__ __forceinline__ void p0_prologue(const Args& A, unsigned char* smem) {
    unsigned char* ws = A.ws;
    const int tid = threadIdx.x, lane = tid & 63, wave = tid >> 6;
    const size_t gtid = (size_t)blockIdx.x * 512 + tid, gsz = (size_t)gridDim.x * 512;
    for (size_t i = gtid; i < ZERO_BYTES / 16; i += gsz) ((uint4*)(ws + WS_ZERO))[i] = make_uint4(0, 0, 0, 0);
    {
        bf16_t* xb = (bf16_t*)A.out; float* ssq0 = (float*)(ws + OFF_SSQ0);
        const int gw = blockIdx.x * 8 + wave, ngw = gridDim.x * 8;
        for (int row = gw; row < MP; row += ngw) {
            const float* src = row < MR ? A.in[0] + (size_t)row * DM : (row < MR + NMETA ? A.in[1] + (size_t)(row - MR) * DM : nullptr);
            float s = 0.f;
#pragma unroll
            for (int j = 0; j < 4; ++j) {
                float4 v = make_float4(0.f, 0.f, 0.f, 0.f);
                if (src) v = ((const float4*)src)[lane + 64 * j];
                s += (v.x * v.x + v.y * v.y) + (v.z * v.z + v.w * v.w);
                *(uint2*)(xb + (size_t)row * DM + 4 * (lane + 64 * j)) = pack4(v.x, v.y, v.z, v.w);
            }
            s = wave_sum(s);
            if (lane == 0) ssq0[row] = s;
        }
    }
    {
        float2* t256 = (float2*)(ws + OFF_TAB256); float2* t128 = (float2*)(ws + OFF_TAB128); float2* t64 = (float2*)(ws + OFF_TAB64);
        for (size_t i = gtid; i < (size_t)TT * 128; i += gsz) {
            const int pos = (int)(i >> 7), j = (int)(i & 127);
            const float inv = exp2f(-(float)j * (13.287712379549449f / 128.f));
            const float ang = (float)pos * inv;
            const double a = (double)ang; const double k = __builtin_rint(a * 0.15915494309189535);
            const double rr = a - k * 6.283185307179586; const double x = rr * 0.25, x2 = x * x;
            double s = x * (1.0 - x2 * (1.0 / 6.0) * (1.0 - x2 * (1.0 / 20.0) * (1.0 - x2 * (1.0 / 42.0) * (1.0 - x2 * (1.0 / 72.0) * (1.0 - x2 * (1.0 / 110.0) * (1.0 - x2 * (1.0 / 156.0)))))));
            double c = 1.0 - x2 * 0.5 * (1.0 - x2 * (1.0 / 12.0) * (1.0 - x2 * (1.0 / 30.0) * (1.0 - x2 * (1.0 / 56.0) * (1.0 - x2 * (1.0 / 90.0) * (1.0 - x2 * (1.0 / 132.0) * (1.0 - x2 * (1.0 / 182.0)))))));
            const double s2 = 2.0 * s * c, c2 = c * c - s * s; const double s4 = 2.0 * s2 * c2, c4 = c2 * c2 - s2 * s2;
            const float2 o = make_float2((float)c4, (float)s4);
            t256[i] = o;
            if ((j & 1) == 0) t128[(size_t)pos * 64 + (j >> 1)] = o;
            if ((j & 3) == 0) t64[(size_t)pos * 32 + (j >> 2)] = o;
        }
    }
    const float* w_in = A.in[7];
    convert_w(DM, DFF, (bf16_t*)(ws + OFF_W1), 5632, A.in[2], [&](int n, const float*& W) { W = ((n >> 4) & 1) ? A.in[4] : A.in[3]; return 16 * (n >> 5) + (n & 15); }, smem);
    convert_w(DFF, DM, (bf16_t*)(ws + OFF_WD1), 1024, nullptr, [&](int n, const float*& W) { W = A.in[5]; return n; }, smem);
    convert_w(DM, DIN, (bf16_t*)(ws + OFF_WINA), 4096, A.in[6], [&](int n, const float*& W) { W = w_in;
        if (n < 2048) return (n < 1024 ? O_RQ : O_RK) + ((n & 1023) >> 8) * 256 + rope_nat(n & 255, 8);
        return O_RV + (n - 2048); }, smem);
    convert_w(DM, DIN, (bf16_t*)(ws + OFF_WINB), 5888, A.in[6], [&](int n, const float*& W) { W = w_in;
        if (n < 2048) return (n < 1024 ? O_AQ : O_AK) + ((n & 1023) >> 7) * 128 + rope_nat(n & 127, 7);
        if (n < 3072) return O_AV + (n - 2048);
        if (n < 3584) return O_IQ + ((n - 3072) >> 6) * 64 + rope_nat((n - 3072) & 63, 6);
        if (n < 3648) return O_IK + rope_nat(n - 3584, 6);
        if (n < 3656) return O_IW + (n - 3648);
        if (n < 3840) return -1;
        return O_RG + (n - 3840); }, smem);
    convert_w(DM, DIN, (bf16_t*)(ws + OFF_WINC), 2048, A.in[6], [&](int n, const float*& W) { W = w_in; return (((n >> 4) & 1) ? O_GA : O_GR) + 16 * (n >> 5) + (n & 15); }, smem);
    convert_w(2048, DM, (bf16_t*)(ws + OFF_WRO), 1024, nullptr, [&](int n, const float*& W) { W = A.in[8]; return n; }, smem);
    convert_w(DM, DM, (bf16_t*)(ws + OFF_WAO), 1024, nullptr, [&](int n, const float*& W) { W = A.in[9]; return n; }, smem);
    convert_w(DM, DM, (bf16_t*)(ws + OFF_WMX), 1024, nullptr, [&](int n, const float*& W) { W = A.in[10]; return n; }, smem);
    convert_w(DM, DFF, (bf16_t*)(ws + OFF_W2), 5632, A.in[11], [&](int n, const float*& W) { W = ((n >> 4) & 1) ? A.in[13] : A.in[12]; return 16 * (n >> 5) + (n & 15); }, smem);
    convert_w(DFF, DM, (bf16_t*)(ws + OFF_WD2), 1024, nullptr, [&](int n, const float*& W) { W = A.in[14]; return n; }, smem);
}

template <int DQK, int DV, int RB, bool SOFTMAX>
__device__ __forceinline__ void flash_unit(const bf16_t* __restrict__ Q, int ldq, const bf16_t* __restrict__ Kb, int ldk, const bf16_t* __restrict__ Vt,
                                           bf16_t* Out, int ldo, int qpos0, int kt_lo, int kt_hi, const u64* __restrict__ mask64, float p0, float* ssqY, unsigned char* smem) {
    constexpr int KSTR = DQK + 8, VSTR = 72, KCH = DQK / 8, NKL = (64 * KCH) / 512, NVL = (DV * 8) / 512, NKS = DQK / 32, NNB = DV / 16;
    bf16_t* Ks = (bf16_t*)smem; bf16_t* Vs = (bf16_t*)(smem + 64 * KSTR * 2);
    const int tid = threadIdx.x, lane = tid & 63, w = tid >> 6, fr = lane & 15, quad = lane >> 4;
    bf16x8 qf[RB][NKS];
#pragma unroll
    for (int rb = 0; rb < RB; ++rb)
#pragma unroll
        for (int ks = 0; ks < NKS; ++ks) qf[rb][ks] = *(const bf16x8*)(Q + (size_t)(w * 16 * RB + rb * 16 + fr) * ldq + ks * 32 + quad * 8);
    f32x4 o[NNB][RB];
#pragma unroll
    for (int nb = 0; nb < NNB; ++nb)
#pragma unroll
        for (int rb = 0; rb < RB; ++rb) o[nb][rb] = (f32x4){0.f, 0.f, 0.f, 0.f};
    float mrun[RB], lrun[RB];
#pragma unroll
    for (int rb = 0; rb < RB; ++rb) { mrun[rb] = -INFINITY; lrun[rb] = 0.f; }
    uint4 kpre[NKL], vpre[NVL];
#define FL_PREFETCH(KT) do { \
    _Pragma("unroll") for (int i = 0; i < NKL; ++i) { const int c = tid + 512 * i, r = c / KCH, cc = c % KCH; const int t = 64 * (KT) + r; \
        kpre[i] = t < TT ? *(const uint4*)(Kb + (size_t)t * ldk + cc * 8) : make_uint4(0, 0, 0, 0); } \
    _Pragma("unroll") for (int i = 0; i < NVL; ++i) { const int c = tid + 512 * i, r = c >> 3, cc = c & 7; const int t = 64 * (KT) + 8 * cc; \
        vpre[i] = t < TT ? *(const uint4*)(Vt + (size_t)r * TP + t) : make_uint4(0, 0, 0, 0); } } while (0)
    FL_PREFETCH(kt_lo);
    for (int kt = kt_lo; kt <= kt_hi; ++kt) {
        __syncthreads();
#pragma unroll
        for (int i = 0; i < NKL; ++i) { const int c = tid + 512 * i, r = c / KCH, cc = c % KCH; *(uint4*)(Ks + r * KSTR + cc * 8) = kpre[i]; }
#pragma unroll
        for (int i = 0; i < NVL; ++i) { const int c = tid + 512 * i, r = c >> 3, cc = c & 7; *(uint4*)(Vs + r * VSTR + cc * 8) = vpre[i]; }
        __syncthreads();
        u64 mw[RB];
        if (SOFTMAX) {
#pragma unroll
            for (int rb = 0; rb < RB; ++rb) mw[rb] = mask64[(size_t)(w * 16 * RB + rb * 16 + fr) * 33 + kt];
        }
        f32x4 s[4][RB];
#pragma unroll
        for (int kb = 0; kb < 4; ++kb) {
#pragma unroll
            for (int rb = 0; rb < RB; ++rb) s[kb][rb] = (f32x4){0.f, 0.f, 0.f, 0.f};
#pragma unroll
            for (int ks = 0; ks < NKS; ++ks) {
                const bf16x8 kf = *(const bf16x8*)(Ks + (kb * 16 + fr) * KSTR + ks * 32 + quad * 8);
#pragma unroll
                for (int rb = 0; rb < RB; ++rb) s[kb][rb] = __builtin_amdgcn_mfma_f32_16x16x32_bf16(kf, qf[rb][ks], s[kb][rb], 0, 0, 0);
            }
        }
        bf16x8 pa[RB][2];
#pragma unroll
        for (int rb = 0; rb < RB; ++rb) {
            const int qpos = qpos0 + w * 16 * RB + rb * 16 + fr;
            float p[4][4];
            if (SOFTMAX) {
                float tmax = -INFINITY;
#pragma unroll
                for (int kb = 0; kb < 4; ++kb)
#pragma unroll
                    for (int j = 0; j < 4; ++j) {
                        const int kk = kb * 16 + quad * 4 + j; const int kpos = 64 * kt + kk;
                        const bool ok = ((mw[rb] >> kk) & 1ull) && (kpos <= qpos);
                        const float v = ok ? s[kb][rb][j] * p0 : -INFINITY;
                        p[kb][j] = v; tmax = fmaxf(tmax, v);
                    }
                tmax = fmaxf(tmax, __shfl_xor(tmax, 16)); tmax = fmaxf(tmax, __shfl_xor(tmax, 32));
                const float mnew = fmaxf(mrun[rb], tmax); const float msafe = (mnew == -INFINITY) ? 0.f : mnew;
                const float alpha = exp2f(mrun[rb] - msafe);
                float ps = 0.f;
#pragma unroll
                for (int kb = 0; kb < 4; ++kb)
#pragma unroll
                    for (int j = 0; j < 4; ++j) { const float e = exp2f(p[kb][j] - msafe); p[kb][j] = e; ps += e; }
                lrun[rb] = lrun[rb] * alpha + ps; mrun[rb] = mnew;
#pragma unroll
                for (int nb = 0; nb < NNB; ++nb) o[nb][rb] *= alpha;
            } else {
#pragma unroll
                for (int kb = 0; kb < 4; ++kb)
#pragma unroll
                    for (int j = 0; j < 4; ++j) {
                        const int kpos = 64 * kt + kb * 16 + quad * 4 + j; const int diff = qpos - kpos;
                        const float wgt = diff >= 0 ? exp2f((float)diff * p0) : 0.f;
                        p[kb][j] = s[kb][rb][j] * wgt;
                    }
            }
#pragma unroll
            for (int i = 0; i < 2; ++i) {
                union { bf16x8 v; unsigned u[4]; } t;
                t.u[0] = cvt_pk_bf16(p[2 * i][0], p[2 * i][1]); t.u[1] = cvt_pk_bf16(p[2 * i][2], p[2 * i][3]);
                t.u[2] = cvt_pk_bf16(p[2 * i + 1][0], p[2 * i + 1][1]); t.u[3] = cvt_pk_bf16(p[2 * i + 1][2], p[2 * i + 1][3]);
                pa[rb][i] = t.v;
            }
        }
        if (kt < kt_hi) FL_PREFETCH(kt + 1);
#pragma unroll
        for (int i = 0; i < 2; ++i)
#pragma unroll
            for (int nb = 0; nb < NNB; ++nb) {
                const bf16_t* vp = Vs + (nb * 16 + fr) * VSTR + 32 * i + quad * 4;
                union { bf16x8 v; uint2 h[2]; } t; t.h[0] = *(const uint2*)vp; t.h[1] = *(const uint2*)(vp + 16);
#pragma unroll
                for (int rb = 0; rb < RB; ++rb) o[nb][rb] = __builtin_amdgcn_mfma_f32_16x16x32_bf16(t.v, pa[rb][i], o[nb][rb], 0, 0, 0);
            }
    }
#pragma unroll
    for (int rb = 0; rb < RB; ++rb) {
        const int qrow = w * 16 * RB + rb * 16 + fr;
        float scale = 1.f;
        if (SOFTMAX) { float l = lrun[rb]; l += __shfl_xor(l, 16); l += __shfl_xor(l, 32); scale = 1.f / l; }
        float part = 0.f;
#pragma unroll
        for (int nb = 0; nb < NNB; ++nb) {
            const f32x4 v = o[nb][rb] * scale;
            part += (v[0] * v[0] + v[1] * v[1]) + (v[2] * v[2] + v[3] * v[3]);
            *(uint2*)(Out + (size_t)qrow * ldo + nb * 16 + quad * 4) = pack4(v[0], v[1], v[2], v[3]);
        }
        if (!SOFTMAX) { part += __shfl_xor(part, 16); part += __shfl_xor(part, 32); if (quad == 0) atomicAdd(ssqY + (size_t)qrow * 4, part); }
    }
}

__device__ __forceinline__ unsigned next_unit(unsigned* ctr, unsigned char* smem) {
    volatile unsigned* sh = (volatile unsigned*)(smem + LDS_CTL);
    __syncthreads();
    if (threadIdx.x == 0) *sh = atomicAdd(ctr, 1u);
    __syncthreads();
    return *sh;
}

__device__ __forceinline__ void retention_phase(const Args& A, unsigned char* smem) {
    unsigned char* ws = A.ws; unsigned* ctr = (unsigned*)(ws + OFF_CTR) + 0;
    const bf16_t* RQ = (const bf16_t*)(ws + OFF_RQ); const bf16_t* RKs = (const bf16_t*)(ws + OFF_RKS); const bf16_t* RVt = (const bf16_t*)(ws + OFF_RVT);
    bf16_t* Y = (bf16_t*)A.out; float* ssqY = (float*)(ws + OFF_SSQY);
    for (;;) {
        const unsigned u = next_unit(ctr, smem); if (u >= 1024u) break;
        const int qb = 15 - (int)(u >> 6), rest = (int)(u & 63), b = rest >> 3, h = (rest >> 1) & 3, dvh = rest & 1;
        const int s0 = 128 * qb, row0 = b * SEQ + s0, qpos0 = NMETA + s0;
        const float l2g = A.l2g[h]; const int cut = (int)(40.f / -l2g);
        int kt_lo = (qpos0 - cut) / 64; if (qpos0 < cut) kt_lo = 0;
        flash_unit<256, 256, 1, false>(RQ + (size_t)row0 * 1024 + h * 256, 1024, RKs + (size_t)b * TP * 1024 + h * 256, 1024, RVt + ((size_t)(b * 4 + h) * 512 + dvh * 256) * TP,
                                       Y + (size_t)row0 * 2048 + h * 512 + dvh * 256, 2048, qpos0, kt_lo, (qpos0 + 127) / 64, nullptr, l2g, ssqY + (size_t)row0 * 4 + h, smem);
    }
}

__device__ __forceinline__ void attention_phase(const Args& A, unsigned char* smem) {
    unsigned char* ws = A.ws; unsigned* ctr = (unsigned*)(ws + OFF_CTR) + 2;
    bf16_t* AQ = (bf16_t*)(ws + OFF_AQ); const bf16_t* AKs = (const bf16_t*)(ws + OFF_AKS); const bf16_t* AVt = (const bf16_t*)(ws + OFF_AVT);
    const u64* mask64 = (const u64*)(ws + OFF_MASK);
    for (;;) {
        const unsigned u = next_unit(ctr, smem); if (u >= 1024u) break;
        const int qb = 15 - (int)(u >> 6), bh = (int)(u & 63), b = bh >> 3, h = bh & 7;
        const int s0 = 128 * qb, row0 = b * SEQ + s0, qpos0 = NMETA + s0;
        flash_unit<128, 128, 1, true>(AQ + (size_t)row0 * 1024 + h * 128, 1024, AKs + (size_t)b * TP * 1024 + h * 128, 1024, AVt + (size_t)(b * 8 + h) * 128 * TP,
                                      AQ + (size_t)row0 * 1024 + h * 128, 1024, qpos0, 0, (qpos0 + 127) / 64, mask64 + (size_t)row0 * 33, 0.08838834764831845f * 1.4426950408889634f, nullptr, smem);
    }
}


__device__ __forceinline__ void cnt_ge_u32(int& c, unsigned a, unsigned b) { asm volatile("v_cmp_ge_u32 vcc, %1, %2\n\tv_addc_co_u32 %0, vcc, 0, %0, vcc" : "+v"(c) : "v"(a), "v"(b) : "vcc"); }
__device__ __forceinline__ void cnt_gt_u32(int& c, unsigned a, unsigned b) { asm volatile("v_cmp_gt_u32 vcc, %1, %2\n\tv_addc_co_u32 %0, vcc, 0, %0, vcc" : "+v"(c) : "v"(a), "v"(b) : "vcc"); }
__device__ __forceinline__ void cnt_eq_u32(int& c, unsigned a, unsigned b) { asm volatile("v_cmp_eq_u32 vcc, %1, %2\n\tv_addc_co_u32 %0, vcc, 0, %0, vcc" : "+v"(c) : "v"(a), "v"(b) : "vcc"); }
__device__ __forceinline__ void cnt_lt_i32(int& c, int a, int b) { asm volatile("v_cmp_lt_i32 vcc, %1, %2\n\tv_addc_co_u32 %0, vcc, 0, %0, vcc" : "+v"(c) : "v"(a), "v"(b) : "vcc"); }
__device__ __forceinline__ int sel_eq_idx(unsigned a, unsigned b, int idx) { int e; const int huge = 0x7fffffff; asm volatile("v_cmp_eq_u32 vcc, %1, %2\n\tv_cndmask_b32 %0, %3, %4, vcc" : "=v"(e) : "v"(a), "v"(b), "v"(huge), "v"(idx) : "vcc"); return e; }
__device__ __forceinline__ int sel_gt_m1(unsigned a, unsigned b, int e) { int v; const int m1 = -1; asm volatile("v_cmp_gt_u32 vcc, %1, %2\n\tv_cndmask_b32 %0, %3, %4, vcc" : "=v"(v) : "v"(a), "v"(b), "v"(e), "v"(m1) : "vcc"); return v; }
__device__ __forceinline__ void shl_in_le_i32(unsigned& nib, int a, int b) { asm volatile("v_cmp_le_i32 vcc, %1, %2\n\tv_addc_co_u32 %0, vcc, %0, %0, vcc" : "+v"(nib) : "v"(a), "v"(b) : "vcc"); }
__device__ __forceinline__ void indexer_phase(const Args& A, unsigned char* smem) {
    unsigned char* ws = A.ws; unsigned* ctr = (unsigned*)(ws + OFF_CTR) + 1;
    const bf16_t* IQ = (const bf16_t*)(ws + OFF_IQ); const bf16_t* IK = (const bf16_t*)(ws + OFF_IK); const float* IW = (const float*)(ws + OFF_IW);
    unsigned* mask = (unsigned*)(ws + OFF_MASK);
    int* cnt = (int*)smem;
    unsigned* mbuf = (unsigned*)(smem + 4096);
    bf16_t* qs = (bf16_t*)(smem + 8448);
    const int tid = threadIdx.x, lane = tid & 63, w = tid >> 6, fr = lane & 15, quad = lane >> 4;
    for (;;) {
        const unsigned u = next_unit(ctr, smem); if (u >= 1024u) break;
        const int g = 127 - (int)(u >> 3), b = (int)(u & 7), s0 = 16 * g, row0 = b * SEQ + s0;
        if (g < 16) { for (int i = tid; i < 16 * 66; i += 512) mask[(size_t)row0 * 66 + i] = 0xFFFFFFFFu; continue; }
        for (int i = tid; i < 16 * 66; i += 512) mbuf[i] = 0u;
        for (int i = tid; i < 16 * 64; i += 512) { const int r = i >> 6, c = i & 63; *(uint4*)(qs + r * 520 + c * 8) = *(const uint4*)(IQ + (size_t)(row0 + r) * 512 + c * 8); }
        __syncthreads();
        unsigned uk[16][4];
        {
            const float4 w0 = *(const float4*)(IW + (size_t)(row0 + fr) * 8), w1 = *(const float4*)(IW + (size_t)(row0 + fr) * 8 + 4);
            const float wq[8] = {w0.x, w0.y, w0.z, w0.w, w1.x, w1.y, w1.z, w1.w};
#pragma unroll
            for (int li = 0; li < 16; ++li) {
                const int kt = li * 8 + w;
                if (kt <= g) {
                    const bf16_t* kp = IK + (size_t)(b * SEQ + 16 * kt + fr) * 64 + quad * 8;
                    const bf16x8 kf0 = *(const bf16x8*)kp, kf1 = *(const bf16x8*)(kp + 32);
                    float sc[4] = {0.f, 0.f, 0.f, 0.f};
#pragma unroll
                    for (int h = 0; h < 8; ++h) {
                        const bf16x8 q0 = *(const bf16x8*)(qs + fr * 520 + h * 64 + quad * 8), q1 = *(const bf16x8*)(qs + fr * 520 + h * 64 + 32 + quad * 8);
                        f32x4 c = __builtin_amdgcn_mfma_f32_16x16x32_bf16(kf0, q0, (f32x4){0.f, 0.f, 0.f, 0.f}, 0, 0, 0);
                        c = __builtin_amdgcn_mfma_f32_16x16x32_bf16(kf1, q1, c, 0, 0, 0);
#pragma unroll
                        for (int j = 0; j < 4; ++j) sc[j] += wq[h] * fmaxf(c[j], 0.f);
                    }
#pragma unroll
                    for (int j = 0; j < 4; ++j) {
                        const int s = 16 * kt + quad * 4 + j;
                        const float v = (s > s0 + fr) ? -INFINITY : sc[j] + 0.0f;
                        const unsigned bits = __float_as_uint(v);
                        uk[li][j] = bits ^ ((unsigned)((int)bits >> 31) | 0x80000000u);
                    }
                } else {
#pragma unroll
                    for (int j = 0; j < 4; ++j) uk[li][j] = 0u;
                }
                asm volatile("" ::: "memory"); __builtin_amdgcn_sched_barrier(0);
            }
        }
        const int nli = (g >> 3) + 1;
        unsigned Tq = 0u;
        for (int bit = 31; bit >= 0; --bit) {
            const unsigned cand = Tq | (1u << bit);
            int c = 0;
#pragma unroll
            for (int li = 0; li < 16; ++li) if (li < nli) {
#pragma unroll
                for (int j = 0; j < 4; ++j) cnt_ge_u32(c, uk[li][j], cand); }
            c += __shfl_xor(c, 16); c += __shfl_xor(c, 32);
            int* cb = cnt + (bit & 1) * 128;
            if (quad == 0) cb[w * 16 + fr] = c;
            __syncthreads();
            int tot = 0;
#pragma unroll
            for (int ww = 0; ww < 8; ++ww) tot += cb[ww * 16 + fr];
            if (tot >= 256) Tq = cand;
        }
        int cg_ = 0, ce = 0;
#pragma unroll
        for (int li = 0; li < 16; ++li) if (li < nli) {
#pragma unroll
            for (int j = 0; j < 4; ++j) { cnt_gt_u32(cg_, uk[li][j], Tq); cnt_eq_u32(ce, uk[li][j], Tq); } }
        cg_ += __shfl_xor(cg_, 16); cg_ += __shfl_xor(cg_, 32); ce += __shfl_xor(ce, 16); ce += __shfl_xor(ce, 32);
        if (quad == 0) { cnt[256 + w * 16 + fr] = cg_; cnt[384 + w * 16 + fr] = ce; }
        __syncthreads();
        int tgt = 0, teq = 0;
#pragma unroll
        for (int ww = 0; ww < 8; ++ww) { tgt += cnt[256 + ww * 16 + fr]; teq += cnt[384 + ww * 16 + fr]; }
        const int need = 256 - tgt;
        int lo = 0x7fff;
        if (__ballot(teq != need) != 0ull) {
            lo = 0;
            for (int bit = 10; bit >= 0; --bit) {
                const int test = lo | (1 << bit);
                int c = 0;
#pragma unroll
                for (int li = 0; li < 16; ++li) if (li < nli) {
#pragma unroll
                    for (int j = 0; j < 4; ++j) { const int idx = 16 * (li * 8 + w) + quad * 4 + j; cnt_lt_i32(c, sel_eq_idx(uk[li][j], Tq, idx), test); } }
                c += __shfl_xor(c, 16); c += __shfl_xor(c, 32);
                int* cb = cnt + (bit & 1) * 128;
                if (quad == 0) cb[w * 16 + fr] = c;
                __syncthreads();
                int tot = 0;
#pragma unroll
                for (int ww = 0; ww < 8; ++ww) tot += cb[ww * 16 + fr];
                if (tot < need) lo = test;
            }
        }
#pragma unroll
        for (int li = 0; li < 16; ++li) {
            const int kt = li * 8 + w;
            if (kt <= g) {
                unsigned nib = 0u;
#pragma unroll
                for (int j = 3; j >= 0; --j) { const int idx = 16 * kt + quad * 4 + j; shl_in_le_i32(nib, sel_gt_m1(uk[li][j], Tq, sel_eq_idx(uk[li][j], Tq, idx)), lo); }
                const int p = kt + 1;
                atomicOr(&mbuf[fr * 66 + (p >> 1)], nib << ((p & 1) * 16 + quad * 4));
            }
        }
        if (tid < 16) atomicOr(&mbuf[tid * 66], 0xFFFFu);
        __syncthreads();
        for (int i = tid; i < 16 * 66; i += 512) mask[(size_t)row0 * 66 + i] = mbuf[i];
    }
}
#define GEMM_PHASE(EPI, e, Aptr, Bptr, Mrows, Ncols, Kdim) do { pg8::Gemm g_{(const bf16_t*)(Aptr), (const bf16_t*)(Bptr), (Mrows), (Ncols), (Kdim)}; pg8::StaticOrder S_; S_.init((Mrows), (Ncols), (int)gridDim.x, (int)blockIdx.x); \
    pg8::gemm_phase<EPI, pg8::StaticOrder, true, true>((PG8_LAS unsigned char*)smem, g_, S_, e); } while (0)

__global__ void __launch_bounds__(512, 2) mk_fwd(Args A) {
    extern __shared__ __attribute__((aligned(16))) unsigned char smem[];
    unsigned char* ws = A.ws;
    const int lo = A.ph_lo, hi = A.ph_hi;
#ifndef PHMASK
#define PHMASK 0xFFFFF
#endif
#define IN(k) (((PHMASK >> (k)) & 1) && lo <= (k) && (k) < hi)
#if MK_COOP
#define SEAM(k) do { if (IN(k) && IN((k) + 1)) cg::this_grid().sync(); } while (0)
#else
#define SEAM(k) do { } while (0)
#endif
    float* ssq0 = (float*)(ws + OFF_SSQ0); float* ssq1 = (float*)(ws + OFF_SSQ1); float* ssq2 = (float*)(ws + OFF_SSQ2); float* ssq3 = (float*)(ws + OFF_SSQ3); float* ssqY = (float*)(ws + OFF_SSQY);
    bf16_t* h1b = (bf16_t*)(ws + OFF_H1B); bf16_t* delta = (bf16_t*)(ws + OFF_DELTA);
    if (IN(0)) { p0_prologue(A, smem); }
    SEAM(0);
    if (IN(1)) { EpiSwiGLU e{(bf16_t*)(ws + OFF_ACT), ssq0}; GEMM_PHASE(EpiSwiGLU, e, A.out, ws + OFF_W1, MP, 5632, DM); }
    SEAM(1);
    if (IN(2)) { EpiResid e{A.in[0], nullptr, A.in[1], nullptr, h1b, delta, ssq1, 0.5f}; GEMM_PHASE(EpiResid, e, ws + OFF_ACT, ws + OFF_WD1, MP, DM, DFF); }
    SEAM(2);
    if (IN(3)) { EpiRet e{ssq1, (const float2*)(ws + OFF_TAB256), (bf16_t*)(ws + OFF_RQ), (bf16_t*)(ws + OFF_RKS), (bf16_t*)(ws + OFF_RVT)}; GEMM_PHASE(EpiRet, e, h1b, ws + OFF_WINA, MP, 4096, DM); }
    SEAM(3);
    if (IN(4)) { retention_phase(A, smem); }
    SEAM(4);
    if (IN(5)) { EpiAtt e{ssq1, (const float2*)(ws + OFF_TAB128), (const float2*)(ws + OFF_TAB64), ssqY, (bf16_t*)(ws + OFF_AQ), (bf16_t*)(ws + OFF_AKS), (bf16_t*)(ws + OFF_AVT),
                          (bf16_t*)(ws + OFF_IQ), (bf16_t*)(ws + OFF_IK), (float*)(ws + OFF_IW), (bf16_t*)A.out};
                 GEMM_PHASE(EpiAtt, e, h1b, ws + OFF_WINB, MP, 5888, DM); }
    SEAM(5);
    if (IN(6)) { indexer_phase(A, smem); }
    SEAM(6);
    if (IN(7)) { attention_phase(A, smem); }
    SEAM(7);
    if (IN(8)) { { EpiPlain e{(bf16_t*)(ws + OFF_YR)}; GEMM_PHASE(EpiPlain, e, A.out, ws + OFF_WRO, MR, DM, 2048); }
                 { EpiPlain e{(bf16_t*)(ws + OFF_YA)}; GEMM_PHASE(EpiPlain, e, ws + OFF_AQ, ws + OFF_WAO, MR, DM, DM); } }
    SEAM(8);
    if (IN(9)) { EpiGate e{ssq1, (bf16_t*)(ws + OFF_YR), (const bf16_t*)(ws + OFF_YA)}; GEMM_PHASE(EpiGate, e, h1b, ws + OFF_WINC, MR, 2048, DM); }
    SEAM(9);
    if (IN(10)) { EpiResid e{A.in[0], delta, nullptr, A.out, h1b, nullptr, ssq2, 1.0f}; GEMM_PHASE(EpiResid, e, ws + OFF_YR, ws + OFF_WMX, MR, DM, DM); }
    SEAM(10);
    if (IN(11)) { EpiSwiGLU e{(bf16_t*)(ws + OFF_ACT2), ssq2}; GEMM_PHASE(EpiSwiGLU, e, h1b, ws + OFF_W2, MR, 5632, DM); }
    SEAM(11);
    if (IN(12)) { EpiResid e{A.out, nullptr, nullptr, A.out, nullptr, nullptr, ssq3, 0.5f}; GEMM_PHASE(EpiResid, e, ws + OFF_ACT2, ws + OFF_WD2, MR, DM, DFF); }
    SEAM(12);
    if (IN(13)) {
        const float* gf = A.in[15];
        const int lane = threadIdx.x & 63, wave = threadIdx.x >> 6;
        for (int row = blockIdx.x * 8 + wave; row < MR; row += gridDim.x * 8) {
            const float r = rstd1024(ssq3, row);
            float4* p = (float4*)(A.out + (size_t)row * DM);
#pragma unroll
            for (int j = 0; j < 4; ++j) { float4 v = p[lane + 64 * j]; const float4 g = ((const float4*)gf)[lane + 64 * j];
                v.x *= r * g.x; v.y *= r * g.y; v.z *= r * g.z; v.w *= r * g.w; p[lane + 64 * j] = v; }
        }
    }
}
constexpr int NPHASE = 14;

extern "C" void kernel_launch(void* const* d_in, const int* in_sizes, int n_in, void* d_out, int out_size, void* d_ws, size_t ws_size, hipStream_t stream) {
    static int grid = 0;
    if (grid == 0) {
        if (n_in != 16 || out_size != MR * DM || ws_size < 256 * MiB) { fprintf(stderr, "kernel_launch: unexpected problem (n_in %d out %d ws %zu)\n", n_in, out_size, ws_size); grid = -1; return; }
        int dev = 0, cus = 0, per_cu = 0;
        hipGetDevice(&dev); hipDeviceGetAttribute(&cus, hipDeviceAttributeMultiprocessorCount, dev);
        if (hipFuncSetAttribute((const void*)mk_fwd, hipFuncAttributeMaxDynamicSharedMemorySize, LDS_BYTES) != hipSuccess) { fprintf(stderr, "kernel_launch: hipFuncSetAttribute failed\n"); grid = -1; return; }
        hipOccupancyMaxActiveBlocksPerMultiprocessor(&per_cu, (const void*)mk_fwd, 512, LDS_BYTES);
        (void)hipGetLastError();
        if (per_cu < 1) per_cu = 1;
        grid = cus * 1;
        fprintf(stderr, "kernel_launch: cus %d per_cu %d grid %d\n", cus, per_cu, grid);
    }
    if (grid < 0) return;
    Args a{};
    for (int i = 0; i < 16; ++i) a.in[i] = (const float*)d_in[i];
    a.out = (float*)d_out; a.ws = (unsigned char*)d_ws;
    for (int h = 0; h < 4; ++h) a.l2g[h] = (float)(std::log1p(-std::ldexp(1.0, -5 - h)) / std::log(2.0));
#if MK_COOP
    a.ph_lo = 0; a.ph_hi = NPHASE;
    void* args[] = {&a};
    hipError_t e = hipLaunchCooperativeKernel((const void*)mk_fwd, dim3(grid), dim3(512), args, LDS_BYTES, stream);
    if (e != hipSuccess) fprintf(stderr, "cooperative launch failed: %s (grid %d)\n", hipGetErrorString(e), grid);
#else
    for (int p = 0; p < NPHASE; ++p) { a.ph_lo = p; a.ph_hi = p + 1; hipLaunchKernelGGL(mk_fwd, dim3(grid), dim3(512), LDS_BYTES, stream, a); }
#endif
}
```

```cpp
#include <hip/hip_runtime.h>
#include <hip/hip_cooperative_groups.h>
#include <cstdio>
#include <cstdint>
#include <cmath>
namespace cg = cooperative_groups;
namespace pg8 {
#define PG8_LAS __attribute__((address_space(3)))
typedef unsigned short bf16_t;
typedef short bf16x8 __attribute__((ext_vector_type(8)));
typedef float f32x4 __attribute__((ext_vector_type(4)));
typedef unsigned u32x4 __attribute__((ext_vector_type(4)));
constexpr int BM = 256, BK = 64, HALF = 128, HTB = HALF * BK * 2  , STAGE_BYTES = 8 * HTB, NXCD = 8, WGM = 8;

__host__ __device__ __forceinline__ int lds_byte(int r, int c) { const int st = (r >> 4) * 2 + (c >> 5), rr = r & 15, cc = c & 31, ob = rr * 64 + cc * 2; return st * 1024 + (ob ^ (((ob >> 9) & 1) << 5)); }
__host__ __device__ __forceinline__ void stage_rc(int b, int& R, int& C) { const int st = b / 1024, sb = b % 1024, swz = sb ^ (((sb >> 9) & 1) << 5); R = (st >> 1) * 16 + swz / 64; C = (st & 1) * 32 + (swz % 64) / 2; }
__host__ __device__ __forceinline__ int perm32(int rho) { const int n = rho >> 4, i = rho & 15; return 8 * (i >> 2) + 4 * n + (i & 3); }

struct Unit { int pm, pn; };
struct Gemm { const bf16_t* A; const bf16_t* Bt; int M, N, K; };

struct StaticOrder {
    int nM, nN, nwg, G, c;
    __host__ __device__ void init(int M, int N, int G_, int c_) { nM = M / BM; nN = N / BM; nwg = nM * nN; G = G_; c = c_; }
    __host__ __device__ bool next(int i, Unit& u) const {
        const long L = (long)i * G + c; if (L >= nwg) return false;
        int wgid = (int)L; { const int q = nwg / NXCD, r = nwg % NXCD, xcd = wgid % NXCD, off = wgid / NXCD; wgid = (xcd < r ? xcd * (q + 1) : r * (q + 1) + (xcd - r) * q) + off; }
        const int nig = WGM * nN, gid = wgid / nig, fm = gid * WGM, gsz = (nM - fm) < WGM ? (nM - fm) : WGM;
        u.pm = fm + ((wgid % nig) % gsz); u.pn = (wgid % nig) / gsz; return true;
    }
    __device__ __forceinline__ void a_ready(const Unit&) const {}
    __device__ __forceinline__ void done(const Unit&) const {}
};

__device__ __forceinline__ unsigned cvt_pk_bf16(float lo, float hi) { unsigned r; asm volatile("v_cvt_pk_bf16_f32 %0, %1, %2" : "=v"(r) : "v"(lo), "v"(hi)); return r; }

template <class Epi, class Sched, bool ALIGN_EPI = false, bool SP2 = false>
__device__ __forceinline__ void gemm_phase(PG8_LAS unsigned char* lds, const Gemm g, const Sched& S, const Epi& E) {
    const int tid = threadIdx.x, wid = __builtin_amdgcn_readfirstlane(tid >> 6), lane = tid & 63, wr = wid >> 2, wc = wid & 3, fr = lane & 15, fq = lane >> 4;
    const int K = g.K, nt = K / BK;
    unsigned voffA[2], voffB[2];
#pragma unroll
    for (int i = 0; i < 2; ++i) { int R, C; stage_rc(tid * 16 + i * 8192, R, C); const int Rb = Epi::PERM ? ((R & ~31) + perm32(R & 31)) : R;
        voffA[i] = (unsigned)(R * K + C) * 2u; voffB[i] = (unsigned)(Rb * K + C) * 2u; }
    const size_t kstep = (size_t)(BK * 2);
    const size_t hstep = (size_t)HALF * K * 2;
    const size_t tstep = 2 * hstep;
    const unsigned ldsw = (unsigned)wid * 1024u;
    const int aoff = lds_byte(wr * 64 + fr, fq * 8), boff = lds_byte(wc * 32 + fr, fq * 8);
#define PG8_SA(b, h) (((b) * 2 + (h)) * HTB)
#define PG8_SB(b, h) ((4 + (b) * 2 + (h)) * HTB)
#define PG8_STAGE(bufoff, gbase, voff) do { _Pragma("unroll") for (int _i = 0; _i < 2; ++_i) \
        __builtin_amdgcn_global_load_lds((const unsigned*)((const char*)(gbase) + (voff)[_i]), (PG8_LAS unsigned*)(lds + (bufoff) + ldsw + _i * 8192), 16, 0, 0); } while (0)
#define PG8_LDA(dst, b, h) do { _Pragma("unroll") for (int m = 0; m < 4; ++m) _Pragma("unroll") for (int k = 0; k < 2; ++k) dst[m][k] = *(const PG8_LAS bf16x8*)(lds + PG8_SA(b, h) + aoff + m * 2048 + k * 1024); } while (0)
#define PG8_LDB(dst, b, h) do { _Pragma("unroll") for (int n = 0; n < 2; ++n) _Pragma("unroll") for (int k = 0; k < 2; ++k) dst[n][k] = *(const PG8_LAS bf16x8*)(lds + PG8_SB(b, h) + boff + n * 2048 + k * 1024); } while (0)
#define PG8_MMA(ai, bj, At, Bt) do { __builtin_amdgcn_s_setprio(1); _Pragma("unroll") for (int m = 0; m < 4; ++m) _Pragma("unroll") for (int n = 0; n < 2; ++n) _Pragma("unroll") for (int k = 0; k < 2; ++k) \
        acc[ai][bj][m][n] = __builtin_amdgcn_mfma_f32_16x16x32_bf16(Bt[n][k], At[m][k], acc[ai][bj][m][n], 0, 0, 0); __builtin_amdgcn_s_setprio(0); } while (0)
#define PG8_WAIT_V(n) asm volatile("s_waitcnt vmcnt(" #n ")" ::: "memory")
#define PG8_WAIT_L(n) asm volatile("s_waitcnt lgkmcnt(" #n ")" ::: "memory")
#define PG8_BAR __builtin_amdgcn_s_barrier()
#define PG8_SCHED __builtin_amdgcn_sched_barrier(0)
    Unit cur, nxt; int ui = 0;
    if (!S.next(0, cur)) return;
    f32x4 acc[2][2][4][2];
#pragma unroll
    for (int a = 0; a < 2; ++a)
#pragma unroll
        for (int b = 0; b < 2; ++b)
#pragma unroll
            for (int m = 0; m < 4; ++m)
#pragma unroll
                for (int n = 0; n < 2; ++n) acc[a][b][m][n] = (f32x4){0.f, 0.f, 0.f, 0.f};
    bf16x8 At[4][2], B0[2][2], B1[2][2];
    const char* cA = (const char*)g.A + (size_t)cur.pm * tstep; const char* cB = (const char*)g.Bt + (size_t)cur.pn * tstep;
    S.a_ready(cur);
    if constexpr (SP2) {
        PG8_STAGE(PG8_SB(0, 0), cB, voffB); PG8_STAGE(PG8_SB(0, 1), cB + hstep, voffB); PG8_STAGE(PG8_SA(0, 0), cA, voffA); PG8_STAGE(PG8_SA(0, 1), cA + hstep, voffA);
        if (wr == 1) PG8_BAR;
        PG8_WAIT_V(2); PG8_BAR;
        PG8_STAGE(PG8_SB(1, 0), cB + kstep, voffB); PG8_STAGE(PG8_SA(1, 0), cA + kstep, voffA); PG8_STAGE(PG8_SB(1, 1), cB + hstep + kstep, voffB);
        PG8_WAIT_V(6); PG8_BAR;
    } else {
        PG8_STAGE(PG8_SB(0, 0), cB, voffB); PG8_STAGE(PG8_SA(0, 0), cA, voffA); PG8_STAGE(PG8_SB(0, 1), cB + hstep, voffB); PG8_STAGE(PG8_SA(0, 1), cA + hstep, voffA);
        if (wr == 1) PG8_BAR;
        PG8_WAIT_V(4); PG8_BAR;
        PG8_STAGE(PG8_SB(1, 0), cB + kstep, voffB); PG8_STAGE(PG8_SA(1, 0), cA + kstep, voffA); PG8_STAGE(PG8_SB(1, 1), cB + hstep + kstep, voffB);
        PG8_WAIT_V(6); PG8_BAR;
    }
    for (;;) {
        const bool has_next = S.next(ui + 1, nxt);
        const char* nA = has_next ? (const char*)g.A + (size_t)nxt.pm * tstep : cA; const char* nB = has_next ? (const char*)g.Bt + (size_t)nxt.pn * tstep : cB;
        for (int t = 0; t < nt; t += 2) {
            const bool last = (t == nt - 2);
            const char* a1 = cA + (size_t)(t + 1) * kstep;
            const char* a2 = last ? nA : cA + (size_t)(t + 2) * kstep; const char* b2 = last ? nB : cB + (size_t)(t + 2) * kstep;
            const char* a3 = a2 + kstep; const char* b3 = b2 + kstep;
            if (last && has_next) S.a_ready(nxt);
            if constexpr (SP2) {
            PG8_LDB(B0, 0, 0); PG8_LDB(B1, 0, 1); PG8_SCHED; PG8_LDA(At, 0, 0); PG8_STAGE(PG8_SA(1, 1), a1 + hstep, voffA);
            PG8_WAIT_V(8); PG8_WAIT_L(0); PG8_BAR; PG8_MMA(0, 0, At, B0); PG8_MMA(0, 1, At, B1); PG8_BAR; PG8_SCHED;
            PG8_LDA(At, 0, 1); PG8_STAGE(PG8_SB(0, 0), b2, voffB); PG8_STAGE(PG8_SB(0, 1), b2 + hstep, voffB); PG8_STAGE(PG8_SA(0, 0), a2, voffA);
            PG8_WAIT_V(8); PG8_WAIT_L(0); PG8_BAR; PG8_MMA(1, 0, At, B0); PG8_MMA(1, 1, At, B1); PG8_BAR; PG8_SCHED;
            PG8_LDB(B0, 1, 0); PG8_LDB(B1, 1, 1); PG8_SCHED; PG8_LDA(At, 1, 0); PG8_STAGE(PG8_SA(0, 1), a2 + hstep, voffA);
            PG8_WAIT_V(8); PG8_WAIT_L(0); PG8_BAR; PG8_MMA(0, 0, At, B0); PG8_MMA(0, 1, At, B1); PG8_BAR; PG8_SCHED;
            PG8_LDA(At, 1, 1); PG8_STAGE(PG8_SB(1, 0), b3, voffB); PG8_STAGE(PG8_SB(1, 1), b3 + hstep, voffB); PG8_STAGE(PG8_SA(1, 0), a3, voffA);
            PG8_WAIT_V(8); PG8_WAIT_L(0); PG8_BAR; PG8_MMA(1, 0, At, B0); PG8_MMA(1, 1, At, B1); PG8_BAR; PG8_SCHED;
            } else {
            PG8_LDB(B0, 0, 0); PG8_SCHED; PG8_LDA(At, 0, 0); PG8_STAGE(PG8_SA(1, 1), a1 + hstep, voffA);
            PG8_WAIT_L(8); PG8_BAR; PG8_WAIT_L(0); PG8_MMA(0, 0, At, B0); PG8_BAR; PG8_SCHED;
            PG8_LDB(B1, 0, 1); PG8_STAGE(PG8_SB(0, 0), b2, voffB);
            PG8_BAR; PG8_WAIT_L(0); PG8_MMA(0, 1, At, B1); PG8_BAR;
            PG8_LDA(At, 0, 1); PG8_STAGE(PG8_SA(0, 0), a2, voffA);
            PG8_BAR; PG8_WAIT_L(0); PG8_MMA(1, 0, At, B0); PG8_BAR; PG8_SCHED;
            PG8_STAGE(PG8_SB(0, 1), b2 + hstep, voffB);
            PG8_WAIT_V(6); PG8_BAR; PG8_MMA(1, 1, At, B1); PG8_BAR;
            PG8_LDB(B0, 1, 0); PG8_SCHED; PG8_LDA(At, 1, 0); PG8_STAGE(PG8_SA(0, 1), a2 + hstep, voffA);
            PG8_WAIT_L(8); PG8_BAR; PG8_WAIT_L(0); PG8_MMA(0, 0, At, B0); PG8_BAR; PG8_SCHED;
            PG8_LDB(B1, 1, 1); PG8_STAGE(PG8_SB(1, 0), b3, voffB);
            PG8_BAR; PG8_WAIT_L(0); PG8_MMA(0, 1, At, B1); PG8_BAR;
            PG8_LDA(At, 1, 1); PG8_STAGE(PG8_SA(1, 0), a3, voffA);
            PG8_BAR; PG8_WAIT_L(0); PG8_MMA(1, 0, At, B0); PG8_BAR; PG8_SCHED;
            PG8_STAGE(PG8_SB(1, 1), b3 + hstep, voffB);
            PG8_WAIT_V(6); PG8_BAR; PG8_MMA(1, 1, At, B1); PG8_BAR;
            }
        }
        if constexpr (ALIGN_EPI) { if (wr == 0) PG8_BAR; }
        if constexpr (!Epi::AFTER_DRAIN) { E(acc, cur, wr, wc, fr, fq); S.done(cur); }
        if (!has_next) break;
#pragma unroll
        for (int a = 0; a < 2; ++a)
#pragma unroll
            for (int b = 0; b < 2; ++b)
#pragma unroll
                for (int m = 0; m < 4; ++m)
#pragma unroll
                    for (int n = 0; n < 2; ++n) acc[a][b][m][n] = (f32x4){0.f, 0.f, 0.f, 0.f};
        cur = nxt; cA = nA; cB = nB; ++ui;
        if constexpr (ALIGN_EPI) { if (wr == 1) PG8_BAR; }
    }
    PG8_WAIT_V(0);
    if constexpr (!ALIGN_EPI) { if (wr == 0) PG8_BAR; }
    PG8_BAR;
    if constexpr (Epi::AFTER_DRAIN) { E.fused(acc, cur, wr, wc, fr, fq, lds, wid, lane); S.done(cur); }
#undef PG8_SA
#undef PG8_SB
#undef PG8_STAGE
#undef PG8_LDA
#undef PG8_LDB
#undef PG8_MMA
#undef PG8_WAIT_V
#undef PG8_WAIT_L
#undef PG8_BAR
#undef PG8_SCHED
}
}
#ifndef MK_COOP
#define MK_COOP 1
#endif
using pg8::bf16_t; using pg8::bf16x8; using pg8::f32x4; using pg8::cvt_pk_bf16;
typedef short bf16x4 __attribute__((ext_vector_type(4)));
typedef unsigned long long u64;
typedef unsigned u32x2 __attribute__((ext_vector_type(2)));

constexpr int NB = 8, SEQ = 2048, NMETA = 16, TT = 2064, TP = 2112, DM = 1024, DFF = 2816;
constexpr int MR = NB * SEQ;
constexpr int MP = MR + 256;
constexpr int DIN = 11848;
constexpr int O_RQ = 0, O_RK = 1024, O_RV = 2048, O_RG = 4096, O_AQ = 6144, O_AK = 7168, O_AV = 8192, O_IQ = 9216, O_IK = 9728, O_IW = 9792, O_GR = 9800, O_GA = 10824;
constexpr float EPSN = 1e-6f;
constexpr size_t MiB = 1u << 20;
constexpr size_t WS_ZERO = 0;
constexpr size_t OFF_CTR = 0;
constexpr size_t OFF_SSQ1 = 4096;
constexpr size_t OFF_SSQ2 = OFF_SSQ1 + MP * 4;
constexpr size_t OFF_SSQ3 = OFF_SSQ2 + MR * 4;
constexpr size_t OFF_SSQY = OFF_SSQ3 + MR * 4;
constexpr size_t OFF_HACC = OFF_SSQY + (size_t)MR * 16;
constexpr size_t ZERO_BYTES = OFF_HACC + 16 * 1024 * 4;
constexpr size_t OFF_SSQ0 = 576 * 1024;
constexpr size_t OFF_BAR = 768 * 1024;
constexpr size_t OFF_IW = 1 * MiB;
constexpr size_t OFF_TAB256 = 2 * MiB;
constexpr size_t OFF_TAB128 = OFF_TAB256 + (size_t)TT * 128 * 8;
constexpr size_t OFF_TAB64 = OFF_TAB128 + (size_t)TT * 64 * 8;
constexpr size_t OFF_MASK = 6 * MiB;
constexpr size_t OFF_WINA = 11 * MiB;
constexpr size_t OFF_WINB = 19 * MiB;
constexpr size_t OFF_WINC = OFF_WINB + (size_t)5888 * 1024 * 2;
constexpr size_t OFF_WRO = OFF_WINC + 4 * MiB;
constexpr size_t OFF_WAO = OFF_WRO + 4 * MiB;
constexpr size_t OFF_WMX = OFF_WAO + 2 * MiB;
constexpr size_t OFF_W2 = OFF_WMX + 2 * MiB;
constexpr size_t OFF_WD2 = OFF_W2 + 11 * MiB;
constexpr size_t OFF_H1B = 59 * MiB;
constexpr size_t OFF_DELTA = OFF_H1B + (size_t)MP * 1024 * 2;
constexpr size_t OFF_R = OFF_DELTA + 32 * MiB;
constexpr size_t OFF_W1 = OFF_R;
constexpr size_t OFF_WD1 = OFF_R + 11 * MiB;
constexpr size_t OFF_ACT = OFF_R + 16 * MiB + MiB / 2;
constexpr size_t OFF_RQ = OFF_R;
constexpr size_t OFF_RKS = OFF_R + 32 * MiB;
constexpr size_t OFF_RVT = OFF_R + 65 * MiB;
constexpr size_t OFF_AQ = OFF_R;
constexpr size_t OFF_AKS = OFF_R + 32 * MiB;
constexpr size_t OFF_AVT = OFF_R + 65 * MiB;
constexpr size_t OFF_IQ = OFF_R + 98 * MiB;
constexpr size_t OFF_IK = OFF_R + 114 * MiB;
constexpr size_t OFF_YR = OFF_R + 32 * MiB;
constexpr size_t OFF_YA = OFF_R + 65 * MiB;
constexpr size_t OFF_ACT2 = OFF_R;
static_assert(OFF_ACT + (size_t)MP * DFF * 2 <= 256 * MiB && OFF_RVT + (size_t)8 * 4 * 512 * TP * 2 <= 256 * MiB && OFF_IK + 2 * MiB <= 256 * MiB, "ws map");
static_assert(OFF_WD2 + (size_t)1024 * 2816 * 2 <= OFF_H1B && OFF_MASK + (size_t)MR * 66 * 4 <= OFF_WINA && OFF_TAB64 + (size_t)TT * 32 * 8 <= OFF_MASK && ZERO_BYTES <= OFF_SSQ0, "ws map 2");
constexpr int LDS_BYTES = 135168 + 1024;
constexpr int LDS_CTL = 135168;

struct Args {
    const float* in[16]; float* out; unsigned char* ws; float l2g[4]; int ph_lo, ph_hi;
};
static_assert(sizeof(Args) == 16 * 8 + 16 + 16 + 8, "Args has no padding");

__device__ __forceinline__ float wave_sum(float v) {
#pragma unroll
    for (int o = 1; o < 64; o <<= 1) v += __shfl_xor(v, o);
    return v;
}
__device__ __forceinline__ bf16_t f2bf(float v) { return (bf16_t)(cvt_pk_bf16(v, 0.f) & 0xffffu); }
__device__ __forceinline__ float bf2f(unsigned short b) { return __uint_as_float((unsigned)b << 16); }
__device__ __forceinline__ uint2 pack4(float a, float b, float c, float d) { uint2 r; r.x = cvt_pk_bf16(a, b); r.y = cvt_pk_bf16(c, d); return r; }
__device__ __forceinline__ f32x4 unpack4(uint2 v) { f32x4 r; r[0] = __uint_as_float(v.x << 16); r[1] = __uint_as_float(v.x & 0xffff0000u); r[2] = __uint_as_float(v.y << 16); r[3] = __uint_as_float(v.y & 0xffff0000u); return r; }
__device__ __forceinline__ int vpos(int pos) { return (pos & ~31) | (((pos >> 2) & 3) << 3) | (((pos >> 4) & 1) << 2) | (pos & 3); }
__device__ __forceinline__ float silu_f(float x) { return x * __builtin_amdgcn_rcpf(1.f + __expf(-x)); }
__device__ __forceinline__ float sigm_f(float x) { return __builtin_amdgcn_rcpf(1.f + __expf(-x)); }
__device__ __forceinline__ float rstd1024(const float* ssq, int row) { return rsqrtf(ssq[row] * (1.f / 1024.f) + EPSN); }
#define EPI_ROWS_BEGIN  _Pragma("unroll") for (int ai = 0; ai < 2; ++ai) _Pragma("unroll") for (int m = 0; m < 4; ++m) { const int row = u.pm * 256 + ai * 128 + wr * 64 + m * 16 + fr;
#define EPI_ROWS_END    }

struct EpiSwiGLU {
    static constexpr bool PERM = false, AFTER_DRAIN = false;
    bf16_t* act; const float* ssq;
    __device__ __forceinline__ void operator()(const f32x4 (&acc)[2][2][4][2], const pg8::Unit& u, int wr, int wc, int fr, int fq) const {
        EPI_ROWS_BEGIN
            const float r = rstd1024(ssq, row);
#pragma unroll
            for (int bj = 0; bj < 2; ++bj) {
                const int f0 = u.pn * 128 + bj * 64 + wc * 16 + fq * 4;
                const f32x4 g = acc[ai][bj][m][0] * r, uu = acc[ai][bj][m][1] * r;
                *(uint2*)(act + (size_t)row * DFF + f0) = pack4(silu_f(g[0]) * uu[0], silu_f(g[1]) * uu[1], silu_f(g[2]) * uu[2], silu_f(g[3]) * uu[3]);
            }
        EPI_ROWS_END
    }
};

struct EpiResid {
    static constexpr bool PERM = false, AFTER_DRAIN = false;
    const float* resf; const bf16_t* resd; const float* meta; float* outf; bf16_t* outb; bf16_t* outd; float* ssq; float alpha;
    __device__ __forceinline__ void operator()(const f32x4 (&acc)[2][2][4][2], const pg8::Unit& u, int wr, int wc, int fr, int fq) const {
        EPI_ROWS_BEGIN
            float part = 0.f;
#pragma unroll
            for (int bj = 0; bj < 2; ++bj)
#pragma unroll
                for (int n = 0; n < 2; ++n) {
                    const int c0 = u.pn * 256 + bj * 128 + wc * 32 + n * 16 + fq * 4;
                    const f32x4 a = acc[ai][bj][m][n] * alpha;
                    f32x4 res = (f32x4){0.f, 0.f, 0.f, 0.f};
                    if (row < MR) { res = *(const f32x4*)(resf + (size_t)row * DM + c0); if (resd) res += unpack4(*(const uint2*)(resd + (size_t)row * DM + c0)); }
                    else if (meta && row < MR + NMETA) res = *(const f32x4*)(meta + (size_t)(row - MR) * DM + c0);
                    const f32x4 h = res + a;
                    part += (h[0] * h[0] + h[1] * h[1]) + (h[2] * h[2] + h[3] * h[3]);
                    if (outf && row < MR) *(f32x4*)(outf + (size_t)row * DM + c0) = h;
                    if (outb) *(uint2*)(outb + (size_t)row * DM + c0) = pack4(h[0], h[1], h[2], h[3]);
                    if (outd && row < MR) *(uint2*)(outd + (size_t)row * DM + c0) = pack4(a[0], a[1], a[2], a[3]);
                }
            part += __shfl_xor(part, 16); part += __shfl_xor(part, 32);
            if (fq == 0) atomicAdd(ssq + row, part);
        EPI_ROWS_END
    }
};

struct EpiRet {
    static constexpr bool PERM = false, AFTER_DRAIN = false;
    const float* ssq1; const float2* tab256; bf16_t* RQ; bf16_t* RKs; bf16_t* RVt;
    __device__ __forceinline__ void operator()(const f32x4 (&acc)[2][2][4][2], const pg8::Unit& u, int wr, int wc, int fr, int fq) const {
        EPI_ROWS_BEGIN
            if (row < MR + NMETA) {
                const float r = rstd1024(ssq1, row);
                const bool real = row < MR; const int b = row >> 11; const int pos = real ? NMETA + (row & 2047) : row - MR;
                if (u.pn < 8) {
                    if (u.pn >= 4 || real) {
                        const int head = u.pn & 3; const float sc = u.pn < 4 ? 1.f : 0.0625f;
#pragma unroll
                        for (int bj = 0; bj < 2; ++bj) {
                            const int jj0 = 16 * (4 * bj + wc) + 4 * fq;
                            const float4* tp = (const float4*)(tab256 + (size_t)pos * 128 + jj0);
                            const float4 t0 = tp[0], t1 = tp[1];
                            const f32x4 x1 = acc[ai][bj][m][0] * (r * sc), x2 = acc[ai][bj][m][1] * (r * sc);
                            const uint2 o1 = pack4(x1[0] * t0.x - x2[0] * t0.y, x1[1] * t0.z - x2[1] * t0.w, x1[2] * t1.x - x2[2] * t1.y, x1[3] * t1.z - x2[3] * t1.w);
                            const uint2 o2 = pack4(x2[0] * t0.x + x1[0] * t0.y, x2[1] * t0.z + x1[1] * t0.w, x2[2] * t1.x + x1[2] * t1.y, x2[3] * t1.z + x1[3] * t1.w);
                            if (u.pn < 4) { bf16_t* d = RQ + (size_t)row * 1024 + head * 256 + jj0; *(uint2*)d = o1; *(uint2*)(d + 128) = o2; }
                            else if (real) { bf16_t* d = RKs + ((size_t)b * TP + pos) * 1024 + head * 256 + jj0; *(uint2*)d = o1; *(uint2*)(d + 128) = o2; }
                            else { for (int bb = 0; bb < NB; ++bb) { bf16_t* d = RKs + ((size_t)bb * TP + pos) * 1024 + head * 256 + jj0; *(uint2*)d = o1; *(uint2*)(d + 128) = o2; } }
                        }
                    }
                } else {
#pragma unroll
                    for (int bj = 0; bj < 2; ++bj)
#pragma unroll
                        for (int n = 0; n < 2; ++n) {
                            const int cin = (u.pn - 8) * 256 + bj * 128 + wc * 32 + n * 16 + fq * 4; const int head = cin >> 9, dv = cin & 511;
                            const f32x4 v = acc[ai][bj][m][n] * r;
                            const bf16_t v0 = f2bf(v[0]), v1 = f2bf(v[1]), v2 = f2bf(v[2]), v3 = f2bf(v[3]);
                            if (real) { bf16_t* d = RVt + ((size_t)(b * 4 + head) * 512 + dv) * TP + vpos(pos); d[0] = v0; d[TP] = v1; d[2 * TP] = v2; d[3 * TP] = v3; }
                            else { for (int bb = 0; bb < NB; ++bb) { bf16_t* d = RVt + ((size_t)(bb * 4 + head) * 512 + dv) * TP + vpos(pos); d[0] = v0; d[TP] = v1; d[2 * TP] = v2; d[3 * TP] = v3; } }
                        }
                }
            }
        EPI_ROWS_END
    }
};

struct EpiAtt {
    static constexpr bool PERM = false, AFTER_DRAIN = false;
    const float* ssq1; const float2* tab128; const float2* tab64; const float* ssqY;
    bf16_t* AQ; bf16_t* AKs; bf16_t* AVt; bf16_t* IQ; bf16_t* IK; float* IW; bf16_t* Y;
    __device__ __forceinline__ void operator()(const f32x4 (&acc)[2][2][4][2], const pg8::Unit& u, int wr, int wc, int fr, int fq) const {
        EPI_ROWS_BEGIN
            const bool real = row < MR;
            if (real || (row < MR + NMETA && u.pn >= 4 && u.pn < 12)) {
                const float r = rstd1024(ssq1, row);
                const int b = row >> 11; const int pos = real ? NMETA + (row & 2047) : row - MR;
                if (u.pn < 8) {
#pragma unroll
                    for (int bj = 0; bj < 2; ++bj) {
                        const int head = 2 * (u.pn & 3) + bj; const int jj0 = 16 * wc + 4 * fq;
                        const float4* tp = (const float4*)(tab128 + (size_t)pos * 64 + jj0);
                        const float4 t0 = tp[0], t1 = tp[1];
                        const f32x4 x1 = acc[ai][bj][m][0] * r, x2 = acc[ai][bj][m][1] * r;
                        const uint2 o1 = pack4(x1[0] * t0.x - x2[0] * t0.y, x1[1] * t0.z - x2[1] * t0.w, x1[2] * t1.x - x2[2] * t1.y, x1[3] * t1.z - x2[3] * t1.w);
                        const uint2 o2 = pack4(x2[0] * t0.x + x1[0] * t0.y, x2[1] * t0.z + x1[1] * t0.w, x2[2] * t1.x + x1[2] * t1.y, x2[3] * t1.z + x1[3] * t1.w);
                        if (u.pn < 4) { bf16_t* d = AQ + (size_t)row * 1024 + head * 128 + jj0; *(uint2*)d = o1; *(uint2*)(d + 64) = o2; }
                        else if (real) { bf16_t* d = AKs + ((size_t)b * TP + pos) * 1024 + head * 128 + jj0; *(uint2*)d = o1; *(uint2*)(d + 64) = o2; }
                        else { for (int bb = 0; bb < NB; ++bb) { bf16_t* d = AKs + ((size_t)bb * TP + pos) * 1024 + head * 128 + jj0; *(uint2*)d = o1; *(uint2*)(d + 64) = o2; } }
                    }
                } else if (u.pn < 12) {
#pragma unroll
                    for (int bj = 0; bj < 2; ++bj)
#pragma unroll
                        for (int n = 0; n < 2; ++n) {
                            const int cin = (u.pn - 8) * 256 + bj * 128 + wc * 32 + n * 16 + fq * 4; const int head = cin >> 7, dd = cin & 127;
                            const f32x4 v = acc[ai][bj][m][n] * r;
                            const bf16_t v0 = f2bf(v[0]), v1 = f2bf(v[1]), v2 = f2bf(v[2]), v3 = f2bf(v[3]);
                            if (real) { bf16_t* d = AVt + ((size_t)(b * 8 + head) * 128 + dd) * TP + vpos(pos); d[0] = v0; d[TP] = v1; d[2 * TP] = v2; d[3 * TP] = v3; }
                            else { for (int bb = 0; bb < NB; ++bb) { bf16_t* d = AVt + ((size_t)(bb * 8 + head) * 128 + dd) * TP + vpos(pos); d[0] = v0; d[TP] = v1; d[2 * TP] = v2; d[3 * TP] = v3; } }
                        }
                } else if (u.pn < 14) {
#pragma unroll
                    for (int bj = 0; bj < 2; ++bj) {
                        const int head = (u.pn - 12) * 4 + 2 * bj + (wc >> 1); const int jj0 = 16 * (wc & 1) + 4 * fq;
                        const float4* tp = (const float4*)(tab64 + (size_t)pos * 32 + jj0);
                        const float4 t0 = tp[0], t1 = tp[1];
                        const f32x4 x1 = acc[ai][bj][m][0] * r, x2 = acc[ai][bj][m][1] * r;
                        bf16_t* d = IQ + (size_t)row * 512 + head * 64 + jj0;
                        *(uint2*)d = pack4(x1[0] * t0.x - x2[0] * t0.y, x1[1] * t0.z - x2[1] * t0.w, x1[2] * t1.x - x2[2] * t1.y, x1[3] * t1.z - x2[3] * t1.w);
                        *(uint2*)(d + 32) = pack4(x2[0] * t0.x + x1[0] * t0.y, x2[1] * t0.z + x1[1] * t0.w, x2[2] * t1.x + x1[2] * t1.y, x2[3] * t1.z + x1[3] * t1.w);
                    }
                } else if (u.pn == 14) {
                    if (wc < 2) {
                        const int jj0 = 16 * wc + 4 * fq;
                        const float4* tp = (const float4*)(tab64 + (size_t)pos * 32 + jj0);
                        const float4 t0 = tp[0], t1 = tp[1];
                        const f32x4 x1 = acc[ai][0][m][0] * r, x2 = acc[ai][0][m][1] * r;
                        bf16_t* d = IK + (size_t)row * 64 + jj0;
                        *(uint2*)d = pack4(x1[0] * t0.x - x2[0] * t0.y, x1[1] * t0.z - x2[1] * t0.w, x1[2] * t1.x - x2[2] * t1.y, x1[3] * t1.z - x2[3] * t1.w);
                        *(uint2*)(d + 32) = pack4(x2[0] * t0.x + x1[0] * t0.y, x2[1] * t0.z + x1[1] * t0.w, x2[2] * t1.x + x1[2] * t1.y, x2[3] * t1.z + x1[3] * t1.w);
                    } else if (wc == 2 && fq < 2) {
                        *(f32x4*)(IW + (size_t)row * 8 + 4 * fq) = acc[ai][0][m][0] * r;
                    }
                } else {
#pragma unroll
                    for (int bj = 0; bj < 2; ++bj)
#pragma unroll
                        for (int n = 0; n < 2; ++n) {
                            const int cin = (u.pn - 15) * 256 + bj * 128 + wc * 32 + n * 16 + fq * 4; const int head = cin >> 9;
                            const float ys = rsqrtf(ssqY[(size_t)row * 4 + head] * (1.f / 512.f) + EPSN);
                            bf16_t* yp = Y + (size_t)row * 2048 + cin;
                            const f32x4 y = unpack4(*(const uint2*)yp); const f32x4 g = acc[ai][bj][m][n] * r;
                            *(uint2*)yp = pack4(silu_f(g[0]) * y[0] * ys, silu_f(g[1]) * y[1] * ys, silu_f(g[2]) * y[2] * ys, silu_f(g[3]) * y[3] * ys);
                        }
                }
            }
        EPI_ROWS_END
    }
};

struct EpiPlain {
    static constexpr bool PERM = false, AFTER_DRAIN = false;
    bf16_t* out;
    __device__ __forceinline__ void operator()(const f32x4 (&acc)[2][2][4][2], const pg8::Unit& u, int wr, int wc, int fr, int fq) const {
        EPI_ROWS_BEGIN
#pragma unroll
            for (int bj = 0; bj < 2; ++bj)
#pragma unroll
                for (int n = 0; n < 2; ++n) {
                    const int c0 = u.pn * 256 + bj * 128 + wc * 32 + n * 16 + fq * 4; const f32x4 a = acc[ai][bj][m][n];
                    *(uint2*)(out + (size_t)row * DM + c0) = pack4(a[0], a[1], a[2], a[3]);
                }
        EPI_ROWS_END
    }
};

struct EpiGate {
    static constexpr bool PERM = false, AFTER_DRAIN = false;
    const float* ssq1; bf16_t* yr; const bf16_t* ya;
    __device__ __forceinline__ void operator()(const f32x4 (&acc)[2][2][4][2], const pg8::Unit& u, int wr, int wc, int fr, int fq) const {
        EPI_ROWS_BEGIN
            const float r = rstd1024(ssq1, row);
#pragma unroll
            for (int bj = 0; bj < 2; ++bj) {
                const int f0 = u.pn * 128 + bj * 64 + wc * 16 + fq * 4;
                const f32x4 gr = acc[ai][bj][m][0] * r, ga = acc[ai][bj][m][1] * r;
                bf16_t* yp = yr + (size_t)row * DM + f0;
                const f32x4 a = unpack4(*(const uint2*)yp), c = unpack4(*(const uint2*)(ya + (size_t)row * DM + f0));
                *(uint2*)yp = pack4(sigm_f(gr[0]) * a[0] + sigm_f(ga[0]) * c[0], sigm_f(gr[1]) * a[1] + sigm_f(ga[1]) * c[1],
                                    sigm_f(gr[2]) * a[2] + sigm_f(ga[2]) * c[2], sigm_f(gr[3]) * a[3] + sigm_f(ga[3]) * c[3]);
            }
        EPI_ROWS_END
    }
};
template <class Map>
__device__ __forceinline__ void convert_w(int K, int N, bf16_t* Wt, int Nd, const float* gain, Map map, unsigned char* smem) {
    bf16_t* tile = (bf16_t*)smem;
    const int tid = threadIdx.x; const int ntk = K / 256, nt = (Nd / 64) * ntk;
    for (int t = blockIdx.x; t < nt; t += gridDim.x) {
        const int n0 = (t / ntk) * 64, k0 = (t % ntk) * 256;
        const int kr = tid >> 4, nq = tid & 15;
        const float* W = nullptr; const int src = map(n0 + 4 * nq, W);
        float4 v[8];
#pragma unroll
        for (int p = 0; p < 8; ++p) { v[p] = make_float4(0.f, 0.f, 0.f, 0.f); if (src >= 0) v[p] = *(const float4*)(W + (size_t)(k0 + kr + 32 * p) * N + src); }
#pragma unroll
        for (int p = 0; p < 8; ++p) {
            const int kl = kr + 32 * p; const float g = gain ? gain[k0 + kl] : 1.f;
            bf16_t* tl = tile + (kl >> 6) * (64 * 72) + (kl & 63);
            tl[(4 * nq + 0) * 72] = f2bf(v[p].x * g); tl[(4 * nq + 1) * 72] = f2bf(v[p].y * g); tl[(4 * nq + 2) * 72] = f2bf(v[p].z * g); tl[(4 * nq + 3) * 72] = f2bf(v[p].w * g);
        }
        __syncthreads();
        const int nl = tid >> 3, kc = tid & 7;
#pragma unroll
        for (int q = 0; q < 4; ++q) *(uint4*)(Wt + (size_t)(n0 + nl) * K + k0 + 64 * q + 8 * kc) = *(const uint4*)(tile + q * (64 * 72) + nl * 72 + 8 * kc);
        __syncthreads();
    }
}
__device__ __forceinline__ int rope_nat(int c, int dbits) {
    const int g = c >> 5, hi = (c >> 4) & 1, i = c & 15; return (hi << (dbits - 1)) + 16 * g + i;
}

__device__ __forceinline__ void p0_prologue(const Args& A, unsigned char* smem) {
    unsigned char* ws = A.ws;
    const int tid = threadIdx.x, lane = tid & 63, wave = tid >> 6;
    const size_t gtid = (size_t)blockIdx.x * 512 + tid, gsz = (size_t)gridDim.x * 512;
    for (size_t i = gtid; i < ZERO_BYTES / 16; i += gsz) ((uint4*)(ws + WS_ZERO))[i] = make_uint4(0, 0, 0, 0);
    {
        bf16_t* xb = (bf16_t*)A.out; float* ssq0 = (float*)(ws + OFF_SSQ0);
        const int gw = blockIdx.x * 8 + wave, ngw = gridDim.x * 8;
        for (int row = gw; row < MP; row += ngw) {
            const float* src = row < MR ? A.in[0] + (size_t)row * DM : (row < MR + NMETA ? A.in[1] + (size_t)(row - MR) * DM : nullptr);
            float s = 0.f;
#pragma unroll
            for (int j = 0; j < 4; ++j) {
                float4 v = make_float4(0.f, 0.f, 0.f, 0.f);
                if (src) v = ((const float4*)src)[lane + 64 * j];
                s += (v.x * v.x + v.y * v.y) + (v.z * v.z + v.w * v.w);
                *(uint2*)(xb + (size_t)row * DM + 4 * (lane + 64 * j)) = pack4(v.x, v.y, v.z, v.w);
            }
            s = wave_sum(s);
            if (lane == 0) ssq0[row] = s;
        }
    }
    { uint4* hp = (uint4*)(ws + OFF_H1B + (size_t)(MR + NMETA) * DM * 2); for (size_t i = gtid; i < (size_t)(MP - MR - NMETA) * DM * 2 / 16; i += gsz) hp[i] = make_uint4(0, 0, 0, 0); }
    {
        float2* t256 = (float2*)(ws + OFF_TAB256); float2* t128 = (float2*)(ws + OFF_TAB128); float2* t64 = (float2*)(ws + OFF_TAB64);
        for (size_t i = gtid; i < (size_t)TT * 128; i += gsz) {
            const int pos = (int)(i >> 7), j = (int)(i & 127);
            const float inv = exp2f(-(float)j * (13.287712379549449f / 128.f));
            const float ang = (float)pos * inv;
            const double a = (double)ang; const double k = __builtin_rint(a * 0.15915494309189535);
            const double rr = a - k * 6.283185307179586; const double x = rr * 0.25, x2 = x * x;
            double s = x * (1.0 - x2 * (1.0 / 6.0) * (1.0 - x2 * (1.0 / 20.0) * (1.0 - x2 * (1.0 / 42.0) * (1.0 - x2 * (1.0 / 72.0) * (1.0 - x2 * (1.0 / 110.0) * (1.0 - x2 * (1.0 / 156.0)))))));
            double c = 1.0 - x2 * 0.5 * (1.0 - x2 * (1.0 / 12.0) * (1.0 - x2 * (1.0 / 30.0) * (1.0 - x2 * (1.0 / 56.0) * (1.0 - x2 * (1.0 / 90.0) * (1.0 - x2 * (1.0 / 132.0) * (1.0 - x2 * (1.0 / 182.0)))))));
            const double s2 = 2.0 * s * c, c2 = c * c - s * s; const double s4 = 2.0 * s2 * c2, c4 = c2 * c2 - s2 * s2;
            const float2 o = make_float2((float)c4, (float)s4);
            t256[i] = o;
            if ((j & 1) == 0) t128[(size_t)pos * 64 + (j >> 1)] = o;
            if ((j & 3) == 0) t64[(size_t)pos * 32 + (j >> 2)] = o;
        }
    }
    const float* w_in = A.in[7];
    convert_w(DM, DFF, (bf16_t*)(ws + OFF_W1), 5632, A.in[2], [&](int n, const float*& W) { W = ((n >> 4) & 1) ? A.in[4] : A.in[3]; return 16 * (n >> 5) + (n & 15); }, smem);
    convert_w(DFF, DM, (bf16_t*)(ws + OFF_WD1), 1024, nullptr, [&](int n, const float*& W) { W = A.in[5]; return n; }, smem);
    convert_w(DM, DIN, (bf16_t*)(ws + OFF_WINA), 4096, A.in[6], [&](int n, const float*& W) { W = w_in;
        if (n < 2048) return (n < 1024 ? O_RQ : O_RK) + ((n & 1023) >> 8) * 256 + rope_nat(n & 255, 8);
        return O_RV + (n - 2048); }, smem);
    convert_w(DM, DIN, (bf16_t*)(ws + OFF_WINB), 5888, A.in[6], [&](int n, const float*& W) { W = w_in;
        if (n < 2048) return (n < 1024 ? O_AQ : O_AK) + ((n & 1023) >> 7) * 128 + rope_nat(n & 127, 7);
        if (n < 3072) return O_AV + (n - 2048);
        if (n < 3584) return O_IQ + ((n - 3072) >> 6) * 64 + rope_nat((n - 3072) & 63, 6);
        if (n < 3648) return O_IK + rope_nat(n - 3584, 6);
        if (n < 3656) return O_IW + (n - 3648);
        if (n < 3840) return -1;
        return O_RG + (n - 3840); }, smem);
    convert_w(DM, DIN, (bf16_t*)(ws + OFF_WINC), 2048, A.in[6], [&](int n, const float*& W) { W = w_in; return (((n >> 4) & 1) ? O_GA : O_GR) + 16 * (n >> 5) + (n & 15); }, smem);
    convert_w(2048, DM, (bf16_t*)(ws + OFF_WRO), 1024, nullptr, [&](int n, const float*& W) { W = A.in[8]; return n; }, smem);
    convert_w(DM, DM, (bf16_t*)(ws + OFF_WAO), 1024, nullptr, [&](int n, const float*& W) { W = A.in[9]; return n; }, smem);
    convert_w(DM, DM, (bf16_t*)(ws + OFF_WMX), 1024, nullptr, [&](int n, const float*& W) { W = A.in[10]; return n; }, smem);
    convert_w(DM, DFF, (bf16_t*)(ws + OFF_W2), 5632, A.in[11], [&](int n, const float*& W) { W = ((n >> 4) & 1) ? A.in[13] : A.in[12]; return 16 * (n >> 5) + (n & 15); }, smem);
    convert_w(DFF, DM, (bf16_t*)(ws + OFF_WD2), 1024, nullptr, [&](int n, const float*& W) { W = A.in[14]; return n; }, smem);
}

template <int DQK, int DV, int RB, bool SOFTMAX, int NSTG>
__device__ __forceinline__ void flash_unit(const bf16_t* __restrict__ Q, int ldq, const bf16_t* __restrict__ Kb, int ldk, const bf16_t* __restrict__ Vt,
                                           bf16_t* Out, int ldo, int qpos0, int kt_lo, int kt_hi, const u64* __restrict__ mask64, float p0, float* ssqY, unsigned char* smem) {
    constexpr int KCH = DQK / 8, NKD = KCH / 8, NVD = DV / 64, NKS = DQK / 32, NNB = DV / 16;
    constexpr int KBYTES = 64 * DQK * 2, STAGE = KBYTES + DV * 64 * 2;
    const int tid = threadIdx.x, lane = tid & 63, w = __builtin_amdgcn_readfirstlane(tid >> 6), fr = lane & 15, quad = lane >> 4;
    bf16x8 qf[RB][NKS];
#pragma unroll
    for (int rb = 0; rb < RB; ++rb)
#pragma unroll
        for (int ks = 0; ks < NKS; ++ks) qf[rb][ks] = *(const bf16x8*)(Q + (size_t)(w * 16 * RB + rb * 16 + fr) * ldq + ks * 32 + quad * 8);
    f32x4 o[NNB][RB];
#pragma unroll
    for (int nb = 0; nb < NNB; ++nb)
#pragma unroll
        for (int rb = 0; rb < RB; ++rb) o[nb][rb] = (f32x4){0.f, 0.f, 0.f, 0.f};
    float mrun[RB], lrun[RB];
#pragma unroll
    for (int rb = 0; rb < RB; ++rb) { mrun[rb] = -INFINITY; lrun[rb] = 0.f; }
    PG8_LAS unsigned char* lds = (PG8_LAS unsigned char*)smem;
    int koff[4], voff[4];
    float bk[4][4];
#pragma unroll
    for (int kb = 0; kb < 4; ++kb)
#pragma unroll
        for (int j = 0; j < 4; ++j) bk[kb][j] = SOFTMAX ? 1.f : __builtin_amdgcn_exp2f(-(float)(kb * 16 + quad * 4 + j) * p0);
#pragma unroll
    for (int a = 0; a < 4; ++a) { koff[a] = (fr * KCH + ((a * 4) ^ quad ^ fr)) * 16; voff[a] = (fr * 8 + (((a & 1) * 4) ^ quad ^ ((fr >> 1) & 7))) * 16; }
#define FL_DMA(KT, BUF) do { \
    _Pragma("unroll") for (int i = 0; i < NKD; ++i) { const int gi = (i * 8 + w) * 64 + lane, r = gi / KCH, cc = (gi % KCH) ^ (r & 15); int t = 64 * (KT) + r; t = t < TT ? t : TT - 1; \
        __builtin_amdgcn_global_load_lds((const unsigned*)(Kb + (size_t)t * ldk + cc * 8), (PG8_LAS unsigned*)(lds + (BUF) * STAGE + (i * 8 + w) * 1024), 16, 0, 0); } \
    _Pragma("unroll") for (int i = 0; i < NVD; ++i) { const int gi = (i * 8 + w) * 64 + lane, r = gi >> 3, cc = (gi & 7) ^ ((r >> 1) & 7); int t = 64 * (KT) + 8 * cc; t = t < 2080 ? t : 2072; \
        __builtin_amdgcn_global_load_lds((const unsigned*)(Vt + (size_t)r * TP + t), (PG8_LAS unsigned*)(lds + (BUF) * STAGE + KBYTES + (i * 8 + w) * 1024), 16, 0, 0); } } while (0)
    constexpr int NDMA = NKD + NVD;
    PG8_LAS u64* mlds = (PG8_LAS u64*)(lds + NSTG * STAGE);
    if (SOFTMAX) {
        constexpr int NR = 16 * RB * 8;
        for (int i = tid; i < NR * 33; i += 512) { const int r = i / 33, c = i % 33; mlds[c * NR + r] = mask64[(size_t)r * 33 + c]; }
    }
    FL_DMA(kt_lo, 0);
#pragma unroll
    for (int p = 1; p < NSTG - 1; ++p) if (kt_lo + p <= kt_hi) FL_DMA(kt_lo + p, p);
    int cur = 0;
    for (int kt = kt_lo; kt <= kt_hi; ++kt) {
        if (NSTG == 2 || kt + NSTG - 2 > kt_hi) asm volatile("s_waitcnt vmcnt(0)" ::: "memory");
        else if (NSTG == 3) asm volatile("s_waitcnt vmcnt(%0)" :: "n"(NDMA) : "memory");
        else asm volatile("s_waitcnt vmcnt(%0)" :: "n"(2 * NDMA) : "memory");
        __syncthreads();
        { const int nb_ = cur == 0 ? NSTG - 1 : cur - 1; if (kt + NSTG - 1 <= kt_hi) FL_DMA(kt + NSTG - 1, nb_); }
        const PG8_LAS unsigned char* Ks = lds + cur * STAGE; const PG8_LAS unsigned char* Vs = Ks + KBYTES;
        cur = (cur + 1 == NSTG) ? 0 : cur + 1;
        const PG8_LAS unsigned char* kp[4]; const PG8_LAS unsigned char* vp4[4];
#pragma unroll
        for (int a = 0; a < 4; ++a) { kp[a] = Ks + koff[a]; vp4[a] = Vs + voff[a]; }
        u64 mw[RB];
        if (SOFTMAX) {
#pragma unroll
            for (int rb = 0; rb < RB; ++rb) mw[rb] = mlds[kt * (16 * RB * 8) + w * 16 * RB + rb * 16 + fr];
        }
        f32x4 s[4][RB];
#pragma unroll
        for (int kb = 0; kb < 4; ++kb)
#pragma unroll
            for (int rb = 0; rb < RB; ++rb) s[kb][rb] = (f32x4){0.f, 0.f, 0.f, 0.f};
        {
            constexpr int GPK = NKS / 4, NGS = 4 * GPK;
            bf16x8 fg[3][4];
#define FL_LDK(G) do { _Pragma("unroll") for (int q4 = 0; q4 < 4; ++q4) { const int ks_ = ((G) % GPK) * 4 + q4; \
                fg[(G) % 3][q4] = *(const PG8_LAS bf16x8*)(kp[ks_ & 3] + ((G) / GPK) * 16 * KCH * 16 + (ks_ >> 2) * 256); } } while (0)
            FL_LDK(0); if (NGS > 1) FL_LDK(1);
#pragma unroll
            for (int g = 0; g < NGS; ++g) {
                if (g + 2 < NGS) FL_LDK(g + 2);
                __builtin_amdgcn_sched_barrier(0);
#pragma unroll
                for (int q4 = 0; q4 < 4; ++q4)
#pragma unroll
                    for (int rb = 0; rb < RB; ++rb) s[g / GPK][rb] = __builtin_amdgcn_mfma_f32_16x16x32_bf16(fg[g % 3][q4], qf[rb][(g % GPK) * 4 + q4], s[g / GPK][rb], 0, 0, 0);
                __builtin_amdgcn_sched_barrier(0);
            }
        }
        bf16x8 pa[RB][2];
#pragma unroll
        for (int rb = 0; rb < RB; ++rb) {
            const int qpos = qpos0 + w * 16 * RB + rb * 16 + fr;
            float p[4][4];
            if (SOFTMAX) {
                const u64 mq = mw[rb] >> (quad * 4);
                const unsigned mlo = (unsigned)mq, mhi = (unsigned)(mq >> 32);
                float tmax = -INFINITY;
#pragma unroll
                for (int kb = 0; kb < 4; ++kb)
#pragma unroll
                    for (int j = 0; j < 4; ++j) {
                        const unsigned wsel = (kb < 2) ? mlo : mhi; const unsigned bitm = 1u << ((kb & 1) * 16 + j);
                        const float v = (wsel & bitm) ? s[kb][rb][j] : -INFINITY;
                        p[kb][j] = v; tmax = fmaxf(tmax, v);
                    }
                tmax = fmaxf(tmax, __shfl_xor(tmax, 16)); tmax = fmaxf(tmax, __shfl_xor(tmax, 32));
                const float tm = tmax * p0;
                if (__ballot(tm > mrun[rb] + 8.f) != 0ull) {
                    const float mnew = fmaxf(mrun[rb], tm); const float msafe = (mnew == -INFINITY) ? 0.f : mnew;
                    const float alpha = __builtin_amdgcn_exp2f(mrun[rb] - msafe);
                    lrun[rb] *= alpha; mrun[rb] = mnew;
#pragma unroll
                    for (int nb = 0; nb < NNB; ++nb) o[nb][rb] *= alpha;
                }
                const float mref = (mrun[rb] == -INFINITY) ? 0.f : mrun[rb];
                float ps = 0.f;
#pragma unroll
                for (int kb = 0; kb < 4; ++kb)
#pragma unroll
                    for (int j = 0; j < 4; ++j) { const float e = __builtin_amdgcn_exp2f(fmaf(p[kb][j], p0, -mref)); p[kb][j] = e; ps += e; }
                lrun[rb] += ps;
            } else {
                const float aq = __builtin_amdgcn_exp2f((float)(qpos - 64 * kt) * p0);
                if (64 * kt + 63 > qpos0 + w * 16 * RB) {
#pragma unroll
                    for (int kb = 0; kb < 4; ++kb)
#pragma unroll
                        for (int j = 0; j < 4; ++j) { const int kpos = 64 * kt + kb * 16 + quad * 4 + j; p[kb][j] = (kpos <= qpos) ? s[kb][rb][j] * (aq * bk[kb][j]) : 0.f; }
                } else {
#pragma unroll
                    for (int kb = 0; kb < 4; ++kb)
#pragma unroll
                        for (int j = 0; j < 4; ++j) p[kb][j] = s[kb][rb][j] * (aq * bk[kb][j]);
                }
            }
#pragma unroll
            for (int i = 0; i < 2; ++i) {
                union { bf16x8 v; unsigned u[4]; } t;
                t.u[0] = cvt_pk_bf16(p[2 * i][0], p[2 * i][1]); t.u[1] = cvt_pk_bf16(p[2 * i][2], p[2 * i][3]);
                t.u[2] = cvt_pk_bf16(p[2 * i + 1][0], p[2 * i + 1][1]); t.u[3] = cvt_pk_bf16(p[2 * i + 1][2], p[2 * i + 1][3]);
                pa[rb][i] = t.v;
            }
        }
        {
            constexpr int GPI = NNB / 4, NGV = 2 * GPI;
            bf16x8 vg[3][4];
#define FL_LDV(G) do { _Pragma("unroll") for (int q4 = 0; q4 < 4; ++q4) { const int nb_ = ((G) % GPI) * 4 + q4, i_ = (G) / GPI; \
                vg[(G) % 3][q4] = *(const PG8_LAS bf16x8*)(vp4[i_] + nb_ * 2048); } } while (0)
            FL_LDV(0); FL_LDV(1);
#pragma unroll
            for (int g = 0; g < NGV; ++g) {
                if (g + 2 < NGV) FL_LDV(g + 2);
                __builtin_amdgcn_sched_barrier(0);
#pragma unroll
                for (int q4 = 0; q4 < 4; ++q4)
#pragma unroll
                    for (int rb = 0; rb < RB; ++rb) o[(g % GPI) * 4 + q4][rb] = __builtin_amdgcn_mfma_f32_16x16x32_bf16(vg[g % 3][q4], pa[rb][g / GPI], o[(g % GPI) * 4 + q4][rb], 0, 0, 0);
                __builtin_amdgcn_sched_barrier(0);
            }
        }
    }
#pragma unroll
    for (int rb = 0; rb < RB; ++rb) {
        const int qrow = w * 16 * RB + rb * 16 + fr;
        float scale = 1.f;
        if (SOFTMAX) { float l = lrun[rb]; l += __shfl_xor(l, 16); l += __shfl_xor(l, 32); scale = 1.f / l; }
        float part = 0.f;
#pragma unroll
        for (int nb = 0; nb < NNB; ++nb) {
            const f32x4 v = o[nb][rb] * scale;
            part += (v[0] * v[0] + v[1] * v[1]) + (v[2] * v[2] + v[3] * v[3]);
            *(uint2*)(Out + (size_t)qrow * ldo + nb * 16 + quad * 4) = pack4(v[0], v[1], v[2], v[3]);
        }
        if (!SOFTMAX) { part += __shfl_xor(part, 16); part += __shfl_xor(part, 32); if (quad == 0) atomicAdd(ssqY + (size_t)qrow * 4, part); }
    }
}

__device__ __forceinline__ unsigned next_unit(unsigned* ctr, unsigned char* smem) {
    volatile unsigned* sh = (volatile unsigned*)(smem + LDS_CTL);
    __syncthreads();
    if (threadIdx.x == 0) *sh = atomicAdd(ctr, 1u);
    __syncthreads();
    return (unsigned)__builtin_amdgcn_readfirstlane((int)*sh);
}

__device__ __forceinline__ void retention_unit(const Args& A, unsigned char* smem, int b, int h, int qb, int dvh) {
    unsigned char* ws = A.ws;
    const bf16_t* RQ = (const bf16_t*)(ws + OFF_RQ); const bf16_t* RKs = (const bf16_t*)(ws + OFF_RKS); const bf16_t* RVt = (const bf16_t*)(ws + OFF_RVT);
    bf16_t* Y = (bf16_t*)A.out; float* ssqY = (float*)(ws + OFF_SSQY);
    const int s0 = 128 * qb, row0 = b * SEQ + s0, qpos0 = NMETA + s0;
    const float l2g = A.l2g[h]; const int cut = (int)(40.f / -l2g);
    int kt_lo = (qpos0 - cut) / 64; if (qpos0 < cut) kt_lo = 0;
    flash_unit<256, 256, 1, false, 2>(RQ + (size_t)row0 * 1024 + h * 256, 1024, RKs + (size_t)b * TP * 1024 + h * 256, 1024, RVt + ((size_t)(b * 4 + h) * 512 + dvh * 256) * TP,
                                      Y + (size_t)row0 * 2048 + h * 512 + dvh * 256, 2048, qpos0, kt_lo, (qpos0 + 127) / 64, nullptr, l2g, ssqY + (size_t)row0 * 4 + h, smem);
}
__device__ __forceinline__ void retention_phase(const Args& A, unsigned char* smem) {
    if (gridDim.x == 256) {
        const int b = blockIdx.x & 7, c = blockIdx.x >> 3, dvh = c & 1, j = c >> 1;
        for (int r = 0; r < 4; ++r) { __syncthreads(); retention_unit(A, smem, b, 3 - r, (r & 1) ? 15 - j : j, dvh); }
    } else {
        unsigned* ctr = (unsigned*)(A.ws + OFF_CTR) + 0;
        for (;;) { const unsigned u = next_unit(ctr, smem); if (u >= 1024u) break;
            const int rest = (int)(u & 63); retention_unit(A, smem, rest >> 3, (rest >> 1) & 3, 15 - (int)(u >> 6), rest & 1); }
    }
}
__device__ __forceinline__ void attention_unit(const Args& A, unsigned char* smem, int b, int h, int qb) {
    unsigned char* ws = A.ws;
    bf16_t* AQ = (bf16_t*)(ws + OFF_AQ); const bf16_t* AKs = (const bf16_t*)(ws + OFF_AKS); const bf16_t* AVt = (const bf16_t*)(ws + OFF_AVT);
    const u64* mask64 = (const u64*)(ws + OFF_MASK);
    const int s0 = 128 * qb, row0 = b * SEQ + s0, qpos0 = NMETA + s0;
    flash_unit<128, 128, 1, true, 3>(AQ + (size_t)row0 * 1024 + h * 128, 1024, AKs + (size_t)b * TP * 1024 + h * 128, 1024, AVt + (size_t)(b * 8 + h) * 128 * TP,
                                     AQ + (size_t)row0 * 1024 + h * 128, 1024, qpos0, 0, (qpos0 + 127) / 64, mask64 + (size_t)row0 * 33, 0.08838834764831845f * 1.4426950408889634f, nullptr, smem);
}
__device__ __forceinline__ void attention_phase(const Args& A, unsigned char* smem) {
    if (gridDim.x == 256) {
        const int b = blockIdx.x & 7, c = blockIdx.x >> 3;
        for (int r = 0; r < 4; ++r) { __syncthreads(); attention_unit(A, smem, b, 2 * r + (c >> 4), (r & 1) ? 15 - (c & 15) : (c & 15)); }
    } else {
        unsigned* ctr = (unsigned*)(A.ws + OFF_CTR) + 2;
        for (;;) { const unsigned u = next_unit(ctr, smem); if (u >= 1024u) break;
            const int bh = (int)(u & 63); attention_unit(A, smem, bh >> 3, bh & 7, 15 - (int)(u >> 6)); }
    }
}

__device__ __forceinline__ void cnt_ge_u32(int& c, unsigned a, unsigned b) { asm volatile("v_cmp_ge_u32 vcc, %1, %2\n\tv_addc_co_u32 %0, vcc, 0, %0, vcc" : "+v"(c) : "v"(a), "v"(b) : "vcc"); }
__device__ __forceinline__ void cnt_gt_u32(int& c, unsigned a, unsigned b) { asm volatile("v_cmp_gt_u32 vcc, %1, %2\n\tv_addc_co_u32 %0, vcc, 0, %0, vcc" : "+v"(c) : "v"(a), "v"(b) : "vcc"); }
__device__ __forceinline__ void cnt_eq_u32(int& c, unsigned a, unsigned b) { asm volatile("v_cmp_eq_u32 vcc, %1, %2\n\tv_addc_co_u32 %0, vcc, 0, %0, vcc" : "+v"(c) : "v"(a), "v"(b) : "vcc"); }
__device__ __forceinline__ void cnt_lt_i32(int& c, int a, int b) { asm volatile("v_cmp_lt_i32 vcc, %1, %2\n\tv_addc_co_u32 %0, vcc, 0, %0, vcc" : "+v"(c) : "v"(a), "v"(b) : "vcc"); }
__device__ __forceinline__ int sel_eq_idx(unsigned a, unsigned b, int idx) { int e; const int huge = 0x7fffffff; asm volatile("v_cmp_eq_u32 vcc, %1, %2\n\tv_cndmask_b32 %0, %3, %4, vcc" : "=v"(e) : "v"(a), "v"(b), "v"(huge), "v"(idx) : "vcc"); return e; }
__device__ __forceinline__ int sel_gt_m1(unsigned a, unsigned b, int e) { int v; const int m1 = -1; asm volatile("v_cmp_gt_u32 vcc, %1, %2\n\tv_cndmask_b32 %0, %3, %4, vcc" : "=v"(v) : "v"(a), "v"(b), "v"(e), "v"(m1) : "vcc"); return v; }
__device__ __forceinline__ void shl_in_le_i32(unsigned& nib, int a, int b) { asm volatile("v_cmp_le_i32 vcc, %1, %2\n\tv_addc_co_u32 %0, vcc, %0, %0, vcc" : "+v"(nib) : "v"(a), "v"(b) : "vcc"); }

template <int NP>
__device__ __forceinline__ int pk_count_ge(const unsigned (&x)[NP], unsigned cand) {
    const unsigned cm1 = (cand - 1u) * 0x00010001u, one = 0x00010001u;
    unsigned c = 0u;
#pragma unroll
    for (int m = 0; m < NP; ++m) {
        unsigned t;
        asm("v_pk_sub_u16 %0, %1, %2 clamp" : "=v"(t) : "v"(x[m]), "v"(cm1));
        asm("v_pk_min_u16 %0, %1, %2" : "=v"(t) : "v"(t), "v"(one));
        asm("v_pk_add_u16 %0, %1, %2" : "=v"(c) : "v"(c), "v"(t));
    }
    int v = (int)((c & 0xFFFFu) + (c >> 16));
    v += __builtin_amdgcn_update_dpp(0, v, 0x111, 0xf, 0xf, true);
    v += __builtin_amdgcn_update_dpp(0, v, 0x112, 0xf, 0xf, true);
    v += __builtin_amdgcn_update_dpp(0, v, 0x114, 0xf, 0xf, true);
    v += __builtin_amdgcn_update_dpp(0, v, 0x118, 0xf, 0xf, true);
    v += __builtin_amdgcn_update_dpp(0, v, 0x142, 0xa, 0xf, false);
    v += __builtin_amdgcn_update_dpp(0, v, 0x143, 0xc, 0xf, false);
    return __builtin_amdgcn_readlane(v, 63);
}

template <int NI>
__device__ __forceinline__ u64 select_query(const unsigned* skq, int lane) {
    unsigned uk[NI];
#pragma unroll
    for (int i = 0; i < NI; ++i) uk[i] = skq[64 * i + lane];
    unsigned hp[NI / 2];
#pragma unroll
    for (int m = 0; m < NI / 2; ++m) hp[m] = (uk[2 * m] >> 16) | (uk[2 * m + 1] & 0xFFFF0000u);
    unsigned T16 = 0u;
    for (int bit = 15; bit >= 0; --bit) {
        const unsigned cand = T16 | (1u << bit);
        if (pk_count_ge<NI / 2>(hp, cand) >= 256) T16 = cand;
    }
    const int cgt_hi = (T16 < 0xFFFFu) ? pk_count_ge<NI / 2>(hp, T16 + 1u) : 0;
    const int need_lo = 256 - cgt_hi;
#pragma unroll
    for (int m = 0; m < NI / 2; ++m) {
        const unsigned a = uk[2 * m], b2 = uk[2 * m + 1];
        const unsigned la = ((a >> 16) == T16) ? (a & 0xFFFFu) : 0u, lb = ((b2 >> 16) == T16) ? (b2 << 16) : 0u;
        hp[m] = la | lb;
    }
    unsigned L16 = 0u;
    for (int bit = 15; bit >= 0; --bit) {
        const unsigned cand = L16 | (1u << bit);
        if (pk_count_ge<NI / 2>(hp, cand) >= need_lo) L16 = cand;
    }
    const unsigned Tq = (T16 << 16) | L16;
    int cgt = 0;
#pragma unroll
    for (int i = 0; i < NI; ++i) cgt += __builtin_popcountll(__ballot(uk[i] > Tq));
    int rem = 256 - cgt;
    u64 myout = 0ull;
    u64 prev = 0xFFFFull << 48;
#pragma unroll
    for (int i = 0; i < NI; ++i) {
        const u64 gt = __ballot(uk[i] > Tq); u64 eq = __ballot(uk[i] == Tq);
        const int ce = __builtin_popcountll(eq);
        if (ce > rem) eq = __ballot(((eq >> lane) & 1ull) && (int)__builtin_amdgcn_mbcnt_hi((unsigned)(eq >> 32), __builtin_amdgcn_mbcnt_lo((unsigned)eq, 0u)) < rem);
        rem -= (ce > rem) ? rem : ce;
        const u64 sel = gt | eq;
        const u64 outw = (prev >> 48) | (sel << 16);
        if (lane == i) myout = outw;
        prev = sel;
    }
    if (lane == NI) myout = prev >> 48;
    return myout;
}

__device__ __forceinline__ void indexer_phase(const Args& A, unsigned char* smem) {
    unsigned char* ws = A.ws; unsigned* ctr = (unsigned*)(ws + OFF_CTR) + 1;
    const bf16_t* IQ = (const bf16_t*)(ws + OFF_IQ); const bf16_t* IK = (const bf16_t*)(ws + OFF_IK); const float* IW = (const float*)(ws + OFF_IW);
    u64* mask64 = (u64*)(ws + OFF_MASK);
    constexpr int SKS = 2052;
    unsigned* sk = (unsigned*)smem;
    const int tid = threadIdx.x, lane = tid & 63, w = __builtin_amdgcn_readfirstlane(tid >> 6), fr = lane & 15, quad = lane >> 4;
    for (;;) {
        const unsigned u = next_unit(ctr, smem); if (u >= 1024u) break;
        const int g = 127 - (int)(u >> 3), b = (int)(u & 7), s0 = 16 * g, row0 = b * SEQ + s0;
        const int nkeys = s0 + 16, ni = (nkeys + 63) >> 6;
        if (g >= 16) {
            { const int nz = 512 * ((ni + 7) >> 3) - nkeys; for (int i = tid; i < 16 * nz; i += 512) { const int r = i / nz, c = nkeys + (i % nz); sk[r * SKS + c] = 0u; } }
            bf16x8 qf[8][2];
#pragma unroll
            for (int h = 0; h < 8; ++h)
#pragma unroll
                for (int ks = 0; ks < 2; ++ks) qf[h][ks] = *(const bf16x8*)(IQ + (size_t)(row0 + fr) * 512 + h * 64 + ks * 32 + quad * 8);
            const float4 w0 = *(const float4*)(IW + (size_t)(row0 + fr) * 8), w1 = *(const float4*)(IW + (size_t)(row0 + fr) * 8 + 4);
            const float wq[8] = {w0.x, w0.y, w0.z, w0.w, w1.x, w1.y, w1.z, w1.w};
            const bf16_t* kbase = IK + (size_t)(b * SEQ + fr) * 64 + quad * 8;
            bf16x8 nk0 = *(const bf16x8*)(kbase + (size_t)(16 * w) * 64), nk1 = *(const bf16x8*)(kbase + (size_t)(16 * w) * 64 + 32);
            for (int kt = w; kt <= g; kt += 8) {
                const bf16x8 kf0 = nk0, kf1 = nk1;
                if (kt + 8 <= g) { nk0 = *(const bf16x8*)(kbase + (size_t)(16 * (kt + 8)) * 64); nk1 = *(const bf16x8*)(kbase + (size_t)(16 * (kt + 8)) * 64 + 32); }
                float sc[4] = {0.f, 0.f, 0.f, 0.f};
#pragma unroll
                for (int h = 0; h < 8; ++h) {
                    f32x4 c = __builtin_amdgcn_mfma_f32_16x16x32_bf16(kf0, qf[h][0], (f32x4){0.f, 0.f, 0.f, 0.f}, 0, 0, 0);
                    c = __builtin_amdgcn_mfma_f32_16x16x32_bf16(kf1, qf[h][1], c, 0, 0, 0);
#pragma unroll
                    for (int j = 0; j < 4; ++j) sc[j] += wq[h] * fmaxf(c[j], 0.f);
                }
                unsigned kk[4];
#pragma unroll
                for (int j = 0; j < 4; ++j) {
                    const int s = 16 * kt + quad * 4 + j;
                    const unsigned bits = __float_as_uint(sc[j] + 0.0f);
                    const unsigned ok = bits ^ ((unsigned)((int)bits >> 31) | 0x80000000u);
                    kk[j] = (s > s0 + fr) ? 0u : ok;
                }
                *(uint4*)(sk + fr * SKS + 16 * kt + quad * 4) = make_uint4(kk[0], kk[1], kk[2], kk[3]);
            }
        }
        __syncthreads();
#ifdef DUPB
#define NQQ 4
#else
#define NQQ 2
#endif
#pragma unroll 1
        for (int qq_ = 0; qq_ < NQQ; ++qq_) {
            const int qq = qq_ & 1; const int q = 2 * w + qq; const int sq = s0 + q;
            u64 myout = 0ull;
            if (g >= 16) {
                const unsigned* skq = sk + q * SKS;
                const int n8 = (ni + 7) >> 3;
                if (n8 == 1) myout = select_query<8>(skq, lane); else if (n8 == 2) myout = select_query<16>(skq, lane);
                else if (n8 == 3) myout = select_query<24>(skq, lane); else myout = select_query<32>(skq, lane);
            } else {
                const int lim = 16 + sq - 64 * lane;
                myout = lim >= 63 ? ~0ull : (lim < 0 ? 0ull : ((2ull << lim) - 1ull));
            }
            if (lane < 33) mask64[(size_t)(row0 + q) * 33 + lane] = myout;
        }
    }
}


__device__ __forceinline__ void meta_down_phase(const Args& A, unsigned char* smem) {
    unsigned char* ws = A.ws;
    const bf16_t* act = (const bf16_t*)(ws + OFF_ACT); const bf16_t* Wd = (const bf16_t*)(ws + OFF_WD1);
    float* hacc = (float*)(ws + OFF_HACC); unsigned* ctr = (unsigned*)(ws + OFF_CTR) + 4;
    const int tid = threadIdx.x, lane = tid & 63, w = __builtin_amdgcn_readfirstlane(tid >> 6), fr = lane & 15, quad = lane >> 4;
    volatile unsigned* sh = (volatile unsigned*)(smem + LDS_CTL + 16);
    bool last = false;
    for (int task = blockIdx.x; task < 256; task += gridDim.x) {
        const int ct = task & 63, ksp = task >> 6;
        f32x4 acc = (f32x4){0.f, 0.f, 0.f, 0.f};
        for (int ks = w; ks < 22; ks += 8) {
            const int kb = ksp * 704 + ks * 32 + quad * 8;
            const bf16x8 af = *(const bf16x8*)(act + (size_t)(MR + fr) * DFF + kb);
            const bf16x8 bfr = *(const bf16x8*)(Wd + (size_t)(16 * ct + fr) * DFF + kb);
            acc = __builtin_amdgcn_mfma_f32_16x16x32_bf16(af, bfr, acc, 0, 0, 0);
        }
#pragma unroll
        for (int j = 0; j < 4; ++j) atomicAdd(hacc + (size_t)(quad * 4 + j) * DM + 16 * ct + fr, acc[j]);
        __threadfence();
        __syncthreads();
        if (tid == 0) { const unsigned old = atomicAdd(ctr, 1u); *sh = (old == 255u) ? 1u : 0u; }
        __syncthreads();
        if (*sh) last = true;
    }
    if (last) {
        __threadfence();
        bf16_t* h1b = (bf16_t*)(ws + OFF_H1B); float* ssq1 = (float*)(ws + OFF_SSQ1);
#pragma unroll
        for (int rr = 0; rr < 2; ++rr) {
            const int m = 2 * w + rr; float s = 0.f;
#pragma unroll
            for (int j = 0; j < 4; ++j) {
                const int c = 4 * (lane + 64 * j);
                const float4 mv = *(const float4*)(A.in[1] + (size_t)m * DM + c);
                float hv[4];
#pragma unroll
                for (int e = 0; e < 4; ++e) hv[e] = __hip_atomic_load(hacc + (size_t)m * DM + c + e, __ATOMIC_RELAXED, __HIP_MEMORY_SCOPE_AGENT);
                const float h0 = mv.x + 0.5f * hv[0], h1 = mv.y + 0.5f * hv[1], h2 = mv.z + 0.5f * hv[2], h3 = mv.w + 0.5f * hv[3];
                s += (h0 * h0 + h1 * h1) + (h2 * h2 + h3 * h3);
                *(uint2*)(h1b + (size_t)(MR + m) * DM + c) = pack4(h0, h1, h2, h3);
            }
            s = wave_sum(s);
            if (lane == 0) ssq1[MR + m] = s;
        }
    }
}
#define LAS __attribute__((address_space(3)))
#define XB_TMO      128
#define XB_XCNT(j)  (256  + 64 * (j))
#define XB_XSUB(j)  (1280 + 64 * (j))
#define XB_XGEN(j)  (2304 + 64 * (j))
#define XB_TOP      3328
#define XB_TOPGEN   3392
#define XCD_BAR_WORDS 3456
#define XB_SPIN_CAP (1u << 18)

__device__ __forceinline__ unsigned xb_ld(unsigned* p)              { return __hip_atomic_load(p, __ATOMIC_RELAXED, __HIP_MEMORY_SCOPE_AGENT); }
__device__ __forceinline__ unsigned xb_add(unsigned* p, unsigned v) { return __hip_atomic_fetch_add(p, v, __ATOMIC_RELAXED, __HIP_MEMORY_SCOPE_AGENT); }
__device__ __forceinline__ unsigned xb_xcc_id() { return (unsigned)__builtin_amdgcn_s_getreg((3 << 11) | 20) & 0xFu; }
#define XB_SPIN(cond, bar) do { unsigned _sp = 0; while (cond) { __builtin_amdgcn_s_sleep(1); \
    if ((++_sp & 255u) == 0u) { if (xb_ld(&(bar)[XB_TMO])) break; if (_sp > XB_SPIN_CAP) { atomicAdd(&(bar)[XB_TMO], 1u); break; } } } } while (0)

struct XcdBarrier {
    unsigned* bar; unsigned x;
    volatile LAS unsigned* st;
};

__device__ __forceinline__ XcdBarrier xcd_barrier_post(unsigned* bar, volatile LAS unsigned* st) {
    XcdBarrier b; b.bar = bar; b.x = xb_xcc_id(); b.st = st;
    if (threadIdx.x == 0) (void)xb_add(&bar[XB_XCNT(b.x)], 1u);
    return b;
}
__device__ __forceinline__ void xcd_barrier_complete(unsigned* bar, unsigned x, unsigned& nloc, unsigned& nx) {
    const unsigned G = gridDim.x * gridDim.y * gridDim.z;
    unsigned sum, cnt, mine, sp = 0u;
    for (;;) {
        sum = 0u; cnt = 0u; mine = 0u;
#pragma unroll
        for (unsigned j = 0; j < 16; ++j) { const unsigned c = xb_ld(&bar[XB_XCNT(j)]); sum += c; cnt += (c > 0u) ? 1u : 0u; mine = (j == x) ? c : mine; }
        if (sum == G) break;
        __builtin_amdgcn_s_sleep(1);
        if ((++sp & 255u) == 0u) { if (xb_ld(&bar[XB_TMO])) break; if (sp > XB_SPIN_CAP) { atomicAdd(&bar[XB_TMO], 1u); break; } }
    }
    nloc = mine > 0u ? mine : 1u; nx = cnt > 0u ? cnt : 1u;
}

__device__ __forceinline__ void xcd_barrier(const XcdBarrier& b) {
    asm volatile("s_waitcnt vmcnt(0)" ::: "memory");
    __syncthreads();
    if (threadIdx.x == 0) {
        unsigned* bar = b.bar;
        __builtin_amdgcn_s_waitcnt(0);
        unsigned nloc = b.st[0], nx = b.st[1];
        if (nloc == 0u) { xcd_barrier_complete(bar, b.x, nloc, nx); b.st[0] = nloc; b.st[1] = nx; }
        const unsigned old = xb_add(&bar[XB_XSUB(b.x)], 1u);
        const unsigned gen = old / nloc;
        if (old + 1u == (gen + 1u) * nloc) {
            __builtin_amdgcn_fence(__ATOMIC_RELEASE, "agent");
            asm volatile("s_waitcnt vmcnt(0)" ::: "memory");
            const unsigned og = xb_add(&bar[XB_TOP], 1u);
            const unsigned tg = og / nx;
            if (og + 1u == (tg + 1u) * nx) xb_add(&bar[XB_TOPGEN], 1u);
            else XB_SPIN(xb_ld(&bar[XB_TOPGEN]) == tg, bar);
            __builtin_amdgcn_fence(__ATOMIC_ACQUIRE, "agent");
            xb_add(&bar[XB_XGEN(b.x)], 1u);
            asm volatile("s_waitcnt vmcnt(0)" ::: "memory");
        } else {
            XB_SPIN(xb_ld(&bar[XB_XGEN(b.x)]) == gen, bar);
            __builtin_amdgcn_fence(__ATOMIC_ACQUIRE, "agent");
            asm volatile("s_waitcnt vmcnt(0)" ::: "memory");
        }
    }
    __syncthreads();
}
#define GEMM_PHASE(EPI, e, Aptr, Bptr, Mrows, Ncols, Kdim) do { pg8::Gemm g_{(const bf16_t*)(Aptr), (const bf16_t*)(Bptr), (Mrows), (Ncols), (Kdim)}; pg8::StaticOrder S_; S_.init((Mrows), (Ncols), (int)gridDim.x, (int)blockIdx.x); \
    pg8::gemm_phase<EPI, pg8::StaticOrder, true, true>((PG8_LAS unsigned char*)smem, g_, S_, e); } while (0)

__global__ void __launch_bounds__(512, 2) mk_fwd(Args A) {
    extern __shared__ __attribute__((aligned(16))) unsigned char smem[];
    unsigned char* ws = A.ws;
    const int lo = A.ph_lo, hi = A.ph_hi;
    volatile LAS unsigned* xst = (volatile LAS unsigned*)((LAS unsigned char*)smem + LDS_CTL + 64);
    if (threadIdx.x < 2) xst[threadIdx.x] = 0u;
    __syncthreads();
    const XcdBarrier xbar = xcd_barrier_post((unsigned*)(ws + OFF_BAR), xst);
#ifndef PHMASK
#define PHMASK 0xFFFFF
#endif
#define IN(k) (((PHMASK >> (k)) & 1) && lo <= (k) && (k) < hi)
#if MK_COOP
#define SEAM(k) do { if (IN(k) && IN((k) + 1)) { if ((k) == 0) cg::this_grid().sync(); else xcd_barrier(xbar); } } while (0)
#else
#define SEAM(k) do { } while (0)
#endif
#ifdef PROBE_PHASE
    unsigned long long pt0 = 0, pt1 = 0;
#define PSTAMP(k) do { if ((k) == PROBE_PHASE) pt0 = __builtin_amdgcn_s_memrealtime(); if ((k) == PROBE_PHASE + 1) pt1 = __builtin_amdgcn_s_memrealtime(); } while (0)
#else
#define PSTAMP(k) do { } while (0)
#endif
    float* ssq0 = (float*)(ws + OFF_SSQ0); float* ssq1 = (float*)(ws + OFF_SSQ1); float* ssq2 = (float*)(ws + OFF_SSQ2); float* ssq3 = (float*)(ws + OFF_SSQ3); float* ssqY = (float*)(ws + OFF_SSQY);
    bf16_t* h1b = (bf16_t*)(ws + OFF_H1B); bf16_t* delta = (bf16_t*)(ws + OFF_DELTA);
    PSTAMP(0);
    if (IN(0)) { p0_prologue(A, smem); }
    SEAM(0);
    PSTAMP(1);
    if (IN(1)) { EpiSwiGLU e{(bf16_t*)(ws + OFF_ACT), ssq0}; GEMM_PHASE(EpiSwiGLU, e, A.out, ws + OFF_W1, MP, 5632, DM); }
    SEAM(1);
    PSTAMP(2);
    if (IN(2)) { meta_down_phase(A, smem); __syncthreads(); EpiResid e{A.in[0], nullptr, nullptr, nullptr, h1b, delta, ssq1, 0.5f}; GEMM_PHASE(EpiResid, e, ws + OFF_ACT, ws + OFF_WD1, MR, DM, DFF); }
    SEAM(2);
    PSTAMP(3);
    if (IN(3)) { EpiRet e{ssq1, (const float2*)(ws + OFF_TAB256), (bf16_t*)(ws + OFF_RQ), (bf16_t*)(ws + OFF_RKS), (bf16_t*)(ws + OFF_RVT)}; GEMM_PHASE(EpiRet, e, h1b, ws + OFF_WINA, MP, 4096, DM); }
    SEAM(3);
    PSTAMP(4);
    if (IN(4)) { retention_phase(A, smem); }
    SEAM(4);
    PSTAMP(5);
    if (IN(5)) { EpiAtt e{ssq1, (const float2*)(ws + OFF_TAB128), (const float2*)(ws + OFF_TAB64), ssqY, (bf16_t*)(ws + OFF_AQ), (bf16_t*)(ws + OFF_AKS), (bf16_t*)(ws + OFF_AVT),
                          (bf16_t*)(ws + OFF_IQ), (bf16_t*)(ws + OFF_IK), (float*)(ws + OFF_IW), (bf16_t*)A.out};
                 GEMM_PHASE(EpiAtt, e, h1b, ws + OFF_WINB, MP, 5888, DM); }
    SEAM(5);
    PSTAMP(6);
    if (IN(6)) { indexer_phase(A, smem); }
    SEAM(6);
    PSTAMP(7);
    if (IN(7)) { attention_phase(A, smem); }
    SEAM(7);
    PSTAMP(8);
    if (IN(8)) { { EpiPlain e{(bf16_t*)(ws + OFF_YR)}; GEMM_PHASE(EpiPlain, e, A.out, ws + OFF_WRO, MR, DM, 2048); }
                 { EpiPlain e{(bf16_t*)(ws + OFF_YA)}; GEMM_PHASE(EpiPlain, e, ws + OFF_AQ, ws + OFF_WAO, MR, DM, DM); } }
    SEAM(8);
    PSTAMP(9);
    if (IN(9)) { EpiGate e{ssq1, (bf16_t*)(ws + OFF_YR), (const bf16_t*)(ws + OFF_YA)}; GEMM_PHASE(EpiGate, e, h1b, ws + OFF_WINC, MR, 2048, DM); }
    SEAM(9);
    PSTAMP(10);
    if (IN(10)) { EpiResid e{A.in[0], delta, nullptr, A.out, h1b, nullptr, ssq2, 1.0f}; GEMM_PHASE(EpiResid, e, ws + OFF_YR, ws + OFF_WMX, MR, DM, DM); }
    SEAM(10);
    PSTAMP(11);
    if (IN(11)) { EpiSwiGLU e{(bf16_t*)(ws + OFF_ACT2), ssq2}; GEMM_PHASE(EpiSwiGLU, e, h1b, ws + OFF_W2, MR, 5632, DM); }
    SEAM(11);
    PSTAMP(12);
    if (IN(12)) { EpiResid e{A.out, nullptr, nullptr, A.out, nullptr, nullptr, ssq3, 0.5f}; GEMM_PHASE(EpiResid, e, ws + OFF_ACT2, ws + OFF_WD2, MR, DM, DFF); }
    SEAM(12);
    PSTAMP(13);
    if (IN(13)) {
        const float* gf = A.in[15];
        const int lane = threadIdx.x & 63, wave = threadIdx.x >> 6;
        for (int row = blockIdx.x * 8 + wave; row < MR; row += gridDim.x * 8) {
            const float r = rstd1024(ssq3, row);
            float4* p = (float4*)(A.out + (size_t)row * DM);
#ifdef PROBE_PHASE
            const float pd = 0.08f * sqrtf((float)(pt1 - pt0) * 1e-5f);
#endif
#pragma unroll
            for (int j = 0; j < 4; ++j) { float4 v = p[lane + 64 * j]; const float4 g = ((const float4*)gf)[lane + 64 * j];
                v.x *= r * g.x; v.y *= r * g.y; v.z *= r * g.z; v.w *= r * g.w;
#ifdef PROBE_PHASE
                if (j == 0 && lane == 0) v.x += pd;
#endif
                p[lane + 64 * j] = v; }
        }
    }
}
constexpr int NPHASE = 14;

extern "C" void kernel_launch(void* const* d_in, const int* in_sizes, int n_in, void* d_out, int out_size, void* d_ws, size_t ws_size, hipStream_t stream) {
    static int grid = 0;
    if (grid == 0) {
        if (n_in != 16 || out_size != MR * DM || ws_size < 256 * MiB) { fprintf(stderr, "kernel_launch: unexpected problem (n_in %d out %d ws %zu)\n", n_in, out_size, ws_size); grid = -1; return; }
        int dev = 0, cus = 0, per_cu = 0;
        hipGetDevice(&dev); hipDeviceGetAttribute(&cus, hipDeviceAttributeMultiprocessorCount, dev);
        if (hipFuncSetAttribute((const void*)mk_fwd, hipFuncAttributeMaxDynamicSharedMemorySize, LDS_BYTES) != hipSuccess) { fprintf(stderr, "kernel_launch: hipFuncSetAttribute failed\n"); grid = -1; return; }
        hipOccupancyMaxActiveBlocksPerMultiprocessor(&per_cu, (const void*)mk_fwd, 512, LDS_BYTES);
        (void)hipGetLastError();
        if (per_cu < 1) per_cu = 1;
        grid = cus * 1;
        fprintf(stderr, "kernel_launch: cus %d per_cu %d grid %d\n", cus, per_cu, grid);
    }
    if (grid < 0) return;
    Args a{};
    for (int i = 0; i < 16; ++i) a.in[i] = (const float*)d_in[i];
    a.out = (float*)d_out; a.ws = (unsigned char*)d_ws;
    for (int h = 0; h < 4; ++h) a.l2g[h] = (float)(std::log1p(-std::ldexp(1.0, -5 - h)) / std::log(2.0));
#if MK_COOP
    if (hipMemsetAsync((char*)d_ws + OFF_BAR, 0, 16384, stream) != hipSuccess) { fprintf(stderr, "kernel_launch: memset failed\n"); return; }
    a.ph_lo = 0; a.ph_hi = NPHASE;
    void* args[] = {&a};
    hipError_t e = hipLaunchCooperativeKernel((const void*)mk_fwd, dim3(grid), dim3(512), args, LDS_BYTES, stream);
    if (e != hipSuccess) fprintf(stderr, "cooperative launch failed: %s (grid %d)\n", hipGetErrorString(e), grid);
#else
    for (int p = 0; p < NPHASE; ++p) { a.ph_lo = p; a.ph_hi = p + 1; hipLaunchKernelGGL(mk_fwd, dim3(grid), dim3(512), LDS_BYTES, stream, a); }
#endif
}
```

```cpp
#include <hip/hip_runtime.h>
#include <hip/hip_cooperative_groups.h>
#include <cstdio>
#include <cstdint>
#include <cmath>
namespace cg = cooperative_groups;
namespace pg8 {
#define PG8_LAS __attribute__((address_space(3)))
typedef unsigned short bf16_t;
typedef short bf16x8 __attribute__((ext_vector_type(8)));
typedef float f32x4 __attribute__((ext_vector_type(4)));
typedef unsigned u32x4 __attribute__((ext_vector_type(4)));
constexpr int BM = 256, BK = 64, HALF = 128, HTB = HALF * BK * 2  , STAGE_BYTES = 8 * HTB, NXCD = 8, WGM = 8;

__host__ __device__ __forceinline__ int lds_byte(int r, int c) { const int st = (r >> 4) * 2 + (c >> 5), rr = r & 15, cc = c & 31, ob = rr * 64 + cc * 2; return st * 1024 + (ob ^ (((ob >> 9) & 1) << 5)); }
__host__ __device__ __forceinline__ void stage_rc(int b, int& R, int& C) { const int st = b / 1024, sb = b % 1024, swz = sb ^ (((sb >> 9) & 1) << 5); R = (st >> 1) * 16 + swz / 64; C = (st & 1) * 32 + (swz % 64) / 2; }
__host__ __device__ __forceinline__ int perm32(int rho) { const int n = rho >> 4, i = rho & 15; return 8 * (i >> 2) + 4 * n + (i & 3); }

struct Unit { int pm, pn; };
struct Gemm { const bf16_t* A; const bf16_t* Bt; int M, N, K; };

struct StaticOrder {
    int nM, nN, nwg, G, c;
    __host__ __device__ void init(int M, int N, int G_, int c_) { nM = M / BM; nN = N / BM; nwg = nM * nN; G = G_; c = c_; }
    __host__ __device__ bool next(int i, Unit& u) const {
        const long L = (long)i * G + c; if (L >= nwg) return false;
        int wgid = (int)L; { const int q = nwg / NXCD, r = nwg % NXCD, xcd = wgid % NXCD, off = wgid / NXCD; wgid = (xcd < r ? xcd * (q + 1) : r * (q + 1) + (xcd - r) * q) + off; }
        const int nig = WGM * nN, gid = wgid / nig, fm = gid * WGM, gsz = (nM - fm) < WGM ? (nM - fm) : WGM;
        u.pm = fm + ((wgid % nig) % gsz); u.pn = (wgid % nig) / gsz; return true;
    }
    __device__ __forceinline__ void a_ready(const Unit&) const {}
    __device__ __forceinline__ void done(const Unit&) const {}
};

__device__ __forceinline__ unsigned cvt_pk_bf16(float lo, float hi) { unsigned r; asm volatile("v_cvt_pk_bf16_f32 %0, %1, %2" : "=v"(r) : "v"(lo), "v"(hi)); return r; }

template <class Epi, class Sched, bool ALIGN_EPI = false, bool SP2 = false>
__device__ __forceinline__ void gemm_phase(PG8_LAS unsigned char* lds, const Gemm g, const Sched& S, const Epi& E) {
    const int tid = threadIdx.x, wid = __builtin_amdgcn_readfirstlane(tid >> 6), lane = tid & 63, wr = wid >> 2, wc = wid & 3, fr = lane & 15, fq = lane >> 4;
    const int K = g.K, nt = K / BK;
    unsigned voffA[2], voffB[2];
#pragma unroll
    for (int i = 0; i < 2; ++i) { int R, C; stage_rc(tid * 16 + i * 8192, R, C); const int Rb = Epi::PERM ? ((R & ~31) + perm32(R & 31)) : R;
        voffA[i] = (unsigned)(R * K + C) * 2u; voffB[i] = (unsigned)(Rb * K + C) * 2u; }
    const size_t kstep = (size_t)(BK * 2);
    const size_t hstep = (size_t)HALF * K * 2;
    const size_t tstep = 2 * hstep;
    const unsigned ldsw = (unsigned)wid * 1024u;
    const int aoff = lds_byte(wr * 64 + fr, fq * 8), boff = lds_byte(wc * 32 + fr, fq * 8);
#define PG8_SA(b, h) (((b) * 2 + (h)) * HTB)
#define PG8_SB(b, h) ((4 + (b) * 2 + (h)) * HTB)
#define PG8_STAGE(bufoff, gbase, voff) do { _Pragma("unroll") for (int _i = 0; _i < 2; ++_i) \
        __builtin_amdgcn_global_load_lds((const unsigned*)((const char*)(gbase) + (voff)[_i]), (PG8_LAS unsigned*)(lds + (bufoff) + ldsw + _i * 8192), 16, 0, 0); } while (0)
#define PG8_LDA(dst, b, h) do { _Pragma("unroll") for (int m = 0; m < 4; ++m) _Pragma("unroll") for (int k = 0; k < 2; ++k) dst[m][k] = *(const PG8_LAS bf16x8*)(lds + PG8_SA(b, h) + aoff + m * 2048 + k * 1024); } while (0)
#define PG8_LDB(dst, b, h) do { _Pragma("unroll") for (int n = 0; n < 2; ++n) _Pragma("unroll") for (int k = 0; k < 2; ++k) dst[n][k] = *(const PG8_LAS bf16x8*)(lds + PG8_SB(b, h) + boff + n * 2048 + k * 1024); } while (0)
#define PG8_MMA(ai, bj, At, Bt) do { __builtin_amdgcn_s_setprio(1); _Pragma("unroll") for (int m = 0; m < 4; ++m) _Pragma("unroll") for (int n = 0; n < 2; ++n) _Pragma("unroll") for (int k = 0; k < 2; ++k) \
        acc[ai][bj][m][n] = __builtin_amdgcn_mfma_f32_16x16x32_bf16(Bt[n][k], At[m][k], acc[ai][bj][m][n], 0, 0, 0); __builtin_amdgcn_s_setprio(0); } while (0)
#define PG8_WAIT_V(n) asm volatile("s_waitcnt vmcnt(" #n ")" ::: "memory")
#define PG8_WAIT_L(n) asm volatile("s_waitcnt lgkmcnt(" #n ")" ::: "memory")
#define PG8_BAR __builtin_amdgcn_s_barrier()
#define PG8_SCHED __builtin_amdgcn_sched_barrier(0)
    Unit cur, nxt; int ui = 0;
    if (!S.next(0, cur)) return;
    f32x4 acc[2][2][4][2];
#pragma unroll
    for (int a = 0; a < 2; ++a)
#pragma unroll
        for (int b = 0; b < 2; ++b)
#pragma unroll
            for (int m = 0; m < 4; ++m)
#pragma unroll
                for (int n = 0; n < 2; ++n) acc[a][b][m][n] = (f32x4){0.f, 0.f, 0.f, 0.f};
    bf16x8 At[4][2], B0[2][2], B1[2][2];
    const char* cA = (const char*)g.A + (size_t)cur.pm * tstep; const char* cB = (const char*)g.Bt + (size_t)cur.pn * tstep;
    S.a_ready(cur);
    if constexpr (SP2) {
        PG8_STAGE(PG8_SB(0, 0), cB, voffB); PG8_STAGE(PG8_SB(0, 1), cB + hstep, voffB); PG8_STAGE(PG8_SA(0, 0), cA, voffA); PG8_STAGE(PG8_SA(0, 1), cA + hstep, voffA);
        if (wr == 1) PG8_BAR;
        PG8_WAIT_V(2); PG8_BAR;
        PG8_STAGE(PG8_SB(1, 0), cB + kstep, voffB); PG8_STAGE(PG8_SA(1, 0), cA + kstep, voffA); PG8_STAGE(PG8_SB(1, 1), cB + hstep + kstep, voffB);
        PG8_WAIT_V(6); PG8_BAR;
    } else {
        PG8_STAGE(PG8_SB(0, 0), cB, voffB); PG8_STAGE(PG8_SA(0, 0), cA, voffA); PG8_STAGE(PG8_SB(0, 1), cB + hstep, voffB); PG8_STAGE(PG8_SA(0, 1), cA + hstep, voffA);
        if (wr == 1) PG8_BAR;
        PG8_WAIT_V(4); PG8_BAR;
        PG8_STAGE(PG8_SB(1, 0), cB + kstep, voffB); PG8_STAGE(PG8_SA(1, 0), cA + kstep, voffA); PG8_STAGE(PG8_SB(1, 1), cB + hstep + kstep, voffB);
        PG8_WAIT_V(6); PG8_BAR;
    }
    for (;;) {
        const bool has_next = S.next(ui + 1, nxt);
        const char* nA = has_next ? (const char*)g.A + (size_t)nxt.pm * tstep : cA; const char* nB = has_next ? (const char*)g.Bt + (size_t)nxt.pn * tstep : cB;
        for (int t = 0; t < nt; t += 2) {
            const bool last = (t == nt - 2);
            const char* a1 = cA + (size_t)(t + 1) * kstep;
            const char* a2 = last ? nA : cA + (size_t)(t + 2) * kstep; const char* b2 = last ? nB : cB + (size_t)(t + 2) * kstep;
            const char* a3 = a2 + kstep; const char* b3 = b2 + kstep;
            if (last && has_next) S.a_ready(nxt);
            if constexpr (SP2) {
            PG8_LDB(B0, 0, 0); PG8_LDB(B1, 0, 1); PG8_SCHED; PG8_LDA(At, 0, 0); PG8_STAGE(PG8_SA(1, 1), a1 + hstep, voffA);
            PG8_WAIT_V(8); PG8_WAIT_L(0); PG8_BAR; PG8_MMA(0, 0, At, B0); PG8_MMA(0, 1, At, B1); PG8_BAR; PG8_SCHED;
            PG8_LDA(At, 0, 1); PG8_STAGE(PG8_SB(0, 0), b2, voffB); PG8_STAGE(PG8_SB(0, 1), b2 + hstep, voffB); PG8_STAGE(PG8_SA(0, 0), a2, voffA);
            PG8_WAIT_V(8); PG8_WAIT_L(0); PG8_BAR; PG8_MMA(1, 0, At, B0); PG8_MMA(1, 1, At, B1); PG8_BAR; PG8_SCHED;
            PG8_LDB(B0, 1, 0); PG8_LDB(B1, 1, 1); PG8_SCHED; PG8_LDA(At, 1, 0); PG8_STAGE(PG8_SA(0, 1), a2 + hstep, voffA);
            PG8_WAIT_V(8); PG8_WAIT_L(0); PG8_BAR; PG8_MMA(0, 0, At, B0); PG8_MMA(0, 1, At, B1); PG8_BAR; PG8_SCHED;
            PG8_LDA(At, 1, 1); PG8_STAGE(PG8_SB(1, 0), b3, voffB); PG8_STAGE(PG8_SB(1, 1), b3 + hstep, voffB); PG8_STAGE(PG8_SA(1, 0), a3, voffA);
            PG8_WAIT_V(8); PG8_WAIT_L(0); PG8_BAR; PG8_MMA(1, 0, At, B0); PG8_MMA(1, 1, At, B1); PG8_BAR; PG8_SCHED;
            } else {
            PG8_LDB(B0, 0, 0); PG8_SCHED; PG8_LDA(At, 0, 0); PG8_STAGE(PG8_SA(1, 1), a1 + hstep, voffA);
            PG8_WAIT_L(8); PG8_BAR; PG8_WAIT_L(0); PG8_MMA(0, 0, At, B0); PG8_BAR; PG8_SCHED;
            PG8_LDB(B1, 0, 1); PG8_STAGE(PG8_SB(0, 0), b2, voffB);
            PG8_BAR; PG8_WAIT_L(0); PG8_MMA(0, 1, At, B1); PG8_BAR;
            PG8_LDA(At, 0, 1); PG8_STAGE(PG8_SA(0, 0), a2, voffA);
            PG8_BAR; PG8_WAIT_L(0); PG8_MMA(1, 0, At, B0); PG8_BAR; PG8_SCHED;
            PG8_STAGE(PG8_SB(0, 1), b2 + hstep, voffB);
            PG8_WAIT_V(6); PG8_BAR; PG8_MMA(1, 1, At, B1); PG8_BAR;
            PG8_LDB(B0, 1, 0); PG8_SCHED; PG8_LDA(At, 1, 0); PG8_STAGE(PG8_SA(0, 1), a2 + hstep, voffA);
            PG8_WAIT_L(8); PG8_BAR; PG8_WAIT_L(0); PG8_MMA(0, 0, At, B0); PG8_BAR; PG8_SCHED;
            PG8_LDB(B1, 1, 1); PG8_STAGE(PG8_SB(1, 0), b3, voffB);
            PG8_BAR; PG8_WAIT_L(0); PG8_MMA(0, 1, At, B1); PG8_BAR;
            PG8_LDA(At, 1, 1); PG8_STAGE(PG8_SA(1, 0), a3, voffA);
            PG8_BAR; PG8_WAIT_L(0); PG8_MMA(1, 0, At, B0); PG8_BAR; PG8_SCHED;
            PG8_STAGE(PG8_SB(1, 1), b3 + hstep, voffB);
            PG8_WAIT_V(6); PG8_BAR; PG8_MMA(1, 1, At, B1); PG8_BAR;
            }
        }
        if constexpr (ALIGN_EPI) { if (wr == 0) PG8_BAR; }
        if constexpr (!Epi::AFTER_DRAIN) { E(acc, cur, wr, wc, fr, fq); S.done(cur); }
        if (!has_next) break;
#pragma unroll
        for (int a = 0; a < 2; ++a)
#pragma unroll
            for (int b = 0; b < 2; ++b)
#pragma unroll
                for (int m = 0; m < 4; ++m)
#pragma unroll
                    for (int n = 0; n < 2; ++n) acc[a][b][m][n] = (f32x4){0.f, 0.f, 0.f, 0.f};
        cur = nxt; cA = nA; cB = nB; ++ui;
        if constexpr (ALIGN_EPI) { if (wr == 1) PG8_BAR; }
    }
    PG8_WAIT_V(0);
    if constexpr (!ALIGN_EPI) { if (wr == 0) PG8_BAR; }
    PG8_BAR;
    if constexpr (Epi::AFTER_DRAIN) { E.fused(acc, cur, wr, wc, fr, fq, lds, wid, lane); S.done(cur); }
#undef PG8_SA
#undef PG8_SB
#undef PG8_STAGE
#undef PG8_LDA
#undef PG8_LDB
#undef PG8_MMA
#undef PG8_WAIT_V
#undef PG8_WAIT_L
#undef PG8_BAR
#undef PG8_SCHED
}
}
#ifndef MK_COOP
#define MK_COOP 1
#endif
using pg8::bf16_t; using pg8::bf16x8; using pg8::f32x4; using pg8::cvt_pk_bf16;
typedef short bf16x4 __attribute__((ext_vector_type(4)));
typedef unsigned long long u64;
typedef unsigned u32x2 __attribute__((ext_vector_type(2)));

constexpr int NB = 8, SEQ = 2048, NMETA = 16, TT = 2064, TP = 2112, DM = 1024, DFF = 2816;
constexpr int MR = NB * SEQ;
constexpr int MP = MR + 256;
constexpr int DIN = 11848;
constexpr int O_RQ = 0, O_RK = 1024, O_RV = 2048, O_RG = 4096, O_AQ = 6144, O_AK = 7168, O_AV = 8192, O_IQ = 9216, O_IK = 9728, O_IW = 9792, O_GR = 9800, O_GA = 10824;
constexpr float EPSN = 1e-6f;
constexpr size_t MiB = 1u << 20;
constexpr size_t WS_ZERO = 0;
constexpr size_t OFF_CTR = 0;
constexpr size_t OFF_SSQ1 = 4096;
constexpr size_t OFF_SSQ2 = OFF_SSQ1 + MP * 4;
constexpr size_t OFF_SSQ3 = OFF_SSQ2 + MR * 4;
constexpr size_t OFF_SSQY = OFF_SSQ3 + MR * 4;
constexpr size_t ZERO_BYTES = OFF_SSQY + (size_t)MR * 16;
constexpr size_t OFF_SSQ0 = 512 * 1024;
constexpr size_t OFF_BAR = 768 * 1024;
constexpr size_t OFF_IW = 1 * MiB;
constexpr size_t OFF_TAB256 = 2 * MiB;
constexpr size_t OFF_TAB128 = OFF_TAB256 + (size_t)TT * 128 * 8;
constexpr size_t OFF_TAB64 = OFF_TAB128 + (size_t)TT * 64 * 8;
constexpr size_t OFF_MASK = 6 * MiB;
constexpr size_t OFF_WINA = 11 * MiB;
constexpr size_t OFF_WINB = 19 * MiB;
constexpr size_t OFF_WINC = OFF_WINB + (size_t)5888 * 1024 * 2;
constexpr size_t OFF_WRO = OFF_WINC + 4 * MiB;
constexpr size_t OFF_WAO = OFF_WRO + 4 * MiB;
constexpr size_t OFF_WMX = OFF_WAO + 2 * MiB;
constexpr size_t OFF_W2 = OFF_WMX + 2 * MiB;
constexpr size_t OFF_WD2 = OFF_W2 + 11 * MiB;
constexpr size_t OFF_H1B = 59 * MiB;
constexpr size_t OFF_DELTA = OFF_H1B + (size_t)MP * 1024 * 2;
constexpr size_t OFF_R = OFF_DELTA + 32 * MiB;
constexpr size_t OFF_W1 = OFF_R;
constexpr size_t OFF_WD1 = OFF_R + 11 * MiB;
constexpr size_t OFF_ACT = OFF_R + 16 * MiB + MiB / 2;
constexpr size_t OFF_RQ = OFF_R;
constexpr size_t OFF_RKS = OFF_R + 32 * MiB;
constexpr size_t OFF_RVT = OFF_R + 65 * MiB;
constexpr size_t OFF_AQ = OFF_R;
constexpr size_t OFF_AKS = OFF_R + 32 * MiB;
constexpr size_t OFF_AVT = OFF_R + 65 * MiB;
constexpr size_t OFF_IQ = OFF_R + 98 * MiB;
constexpr size_t OFF_IK = OFF_R + 114 * MiB;
constexpr size_t OFF_YR = OFF_R + 32 * MiB;
constexpr size_t OFF_YA = OFF_R + 65 * MiB;
constexpr size_t OFF_ACT2 = OFF_R;
static_assert(OFF_ACT + (size_t)MP * DFF * 2 <= 256 * MiB && OFF_RVT + (size_t)8 * 4 * 512 * TP * 2 <= 256 * MiB && OFF_IK + 2 * MiB <= 256 * MiB, "ws map");
static_assert(OFF_WD2 + (size_t)1024 * 2816 * 2 <= OFF_H1B && OFF_MASK + (size_t)MR * 66 * 4 <= OFF_WINA && OFF_TAB64 + (size_t)TT * 32 * 8 <= OFF_MASK && ZERO_BYTES <= OFF_SSQ0, "ws map 2");
constexpr int LDS_BYTES = 135168 + 1024;
constexpr int LDS_CTL = 135168;

struct Args {
    const float* in[16]; float* out; unsigned char* ws; float l2g[4]; int ph_lo, ph_hi;
};
static_assert(sizeof(Args) == 16 * 8 + 16 + 16 + 8, "Args has no padding");

__device__ __forceinline__ float wave_sum(float v) {
#pragma unroll
    for (int o = 1; o < 64; o <<= 1) v += __shfl_xor(v, o);
    return v;
}
__device__ __forceinline__ bf16_t f2bf(float v) { return (bf16_t)(cvt_pk_bf16(v, 0.f) & 0xffffu); }
__device__ __forceinline__ float bf2f(unsigned short b) { return __uint_as_float((unsigned)b << 16); }
__device__ __forceinline__ uint2 pack4(float a, float b, float c, float d) { uint2 r; r.x = cvt_pk_bf16(a, b); r.y = cvt_pk_bf16(c, d); return r; }
__device__ __forceinline__ f32x4 unpack4(uint2 v) { f32x4 r; r[0] = __uint_as_float(v.x << 16); r[1] = __uint_as_float(v.x & 0xffff0000u); r[2] = __uint_as_float(v.y << 16); r[3] = __uint_as_float(v.y & 0xffff0000u); return r; }
__device__ __forceinline__ int vpos(int pos) { return (pos & ~31) | (((pos >> 2) & 3) << 3) | (((pos >> 4) & 1) << 2) | (pos & 3); }
__device__ __forceinline__ float silu_f(float x) { return x * __builtin_amdgcn_rcpf(1.f + __expf(-x)); }
__device__ __forceinline__ float sigm_f(float x) { return __builtin_amdgcn_rcpf(1.f + __expf(-x)); }
__device__ __forceinline__ float rstd1024(const float* ssq, int row) { return rsqrtf(ssq[row] * (1.f / 1024.f) + EPSN); }
#define EPI_ROW(ai, m) (u.pm * 256 + (ai) * 128 + wr * 64 + (m) * 16 + fr)
#define EPI_RSTD(ssqp) float rs_[2][4]; { _Pragma("unroll") for (int ai = 0; ai < 2; ++ai) _Pragma("unroll") for (int m = 0; m < 4; ++m) rs_[ai][m] = (ssqp)[EPI_ROW(ai, m)]; \
    _Pragma("unroll") for (int ai = 0; ai < 2; ++ai) _Pragma("unroll") for (int m = 0; m < 4; ++m) rs_[ai][m] = rsqrtf(rs_[ai][m] * (1.f / 1024.f) + EPSN); }

struct EpiSwiGLU {
    static constexpr bool PERM = false, AFTER_DRAIN = false;
    bf16_t* act; const float* ssq;
    __device__ __forceinline__ void operator()(const f32x4 (&acc)[2][2][4][2], const pg8::Unit& u, int wr, int wc, int fr, int fq) const {
        EPI_RSTD(ssq)
#pragma unroll
        for (int ai = 0; ai < 2; ++ai)
#pragma unroll
            for (int m = 0; m < 4; ++m) {
                const int row = EPI_ROW(ai, m); const float r = rs_[ai][m];
#pragma unroll
                for (int bj = 0; bj < 2; ++bj) {
                    const int f0 = u.pn * 128 + bj * 64 + wc * 16 + fq * 4;
                    const f32x4 g = acc[ai][bj][m][0] * r, uu = acc[ai][bj][m][1] * r;
                    *(uint2*)(act + (size_t)row * DFF + f0) = pack4(silu_f(g[0]) * uu[0], silu_f(g[1]) * uu[1], silu_f(g[2]) * uu[2], silu_f(g[3]) * uu[3]);
                }
            }
    }
};

struct EpiResid {
    static constexpr bool PERM = false, AFTER_DRAIN = false;
    const float* resf; const bf16_t* resd; const float* meta; float* outf; bf16_t* outb; bf16_t* outd; float* ssq; float alpha;
    __device__ __forceinline__ void operator()(const f32x4 (&acc)[2][2][4][2], const pg8::Unit& u, int wr, int wc, int fr, int fq) const {
#pragma unroll
        for (int ai = 0; ai < 2; ++ai)
#pragma unroll
            for (int mh = 0; mh < 2; ++mh) {
                f32x4 res[2][2][2]; uint2 rd[2][2][2];
#pragma unroll
                for (int m2 = 0; m2 < 2; ++m2) {
                    const int row = EPI_ROW(ai, 2 * mh + m2);
#pragma unroll
                    for (int bj = 0; bj < 2; ++bj)
#pragma unroll
                        for (int n = 0; n < 2; ++n) {
                            const int c0 = u.pn * 256 + bj * 128 + wc * 32 + n * 16 + fq * 4;
                            res[m2][bj][n] = (f32x4){0.f, 0.f, 0.f, 0.f}; rd[m2][bj][n] = make_uint2(0u, 0u);
                            if (row < MR) { res[m2][bj][n] = *(const f32x4*)(resf + (size_t)row * DM + c0); if (resd) rd[m2][bj][n] = *(const uint2*)(resd + (size_t)row * DM + c0); }
                            else if (meta && row < MR + NMETA) res[m2][bj][n] = *(const f32x4*)(meta + (size_t)(row - MR) * DM + c0);
                        }
                }
#pragma unroll
                for (int m2 = 0; m2 < 2; ++m2) {
                    const int m = 2 * mh + m2; const int row = EPI_ROW(ai, m);
                    float part = 0.f;
#pragma unroll
                    for (int bj = 0; bj < 2; ++bj)
#pragma unroll
                        for (int n = 0; n < 2; ++n) {
                            const int c0 = u.pn * 256 + bj * 128 + wc * 32 + n * 16 + fq * 4;
                            const f32x4 a = acc[ai][bj][m][n] * alpha;
                            const f32x4 h = res[m2][bj][n] + unpack4(rd[m2][bj][n]) + a;
                            part += (h[0] * h[0] + h[1] * h[1]) + (h[2] * h[2] + h[3] * h[3]);
                            if (outf && row < MR) *(f32x4*)(outf + (size_t)row * DM + c0) = h;
                            if (outb) *(uint2*)(outb + (size_t)row * DM + c0) = pack4(h[0], h[1], h[2], h[3]);
                            if (outd && row < MR) *(uint2*)(outd + (size_t)row * DM + c0) = pack4(a[0], a[1], a[2], a[3]);
                        }
                    part += __shfl_xor(part, 16); part += __shfl_xor(part, 32);
                    if (fq == 0) atomicAdd(ssq + row, part);
                }
            }
    }
};

__device__ __forceinline__ void rope4(const f32x4 x1, const f32x4 x2, const float4 t0, const float4 t1, uint2& o1, uint2& o2) {
    o1 = pack4(x1[0] * t0.x - x2[0] * t0.y, x1[1] * t0.z - x2[1] * t0.w, x1[2] * t1.x - x2[2] * t1.y, x1[3] * t1.z - x2[3] * t1.w);
    o2 = pack4(x2[0] * t0.x + x1[0] * t0.y, x2[1] * t0.z + x1[1] * t0.w, x2[2] * t1.x + x1[2] * t1.y, x2[3] * t1.z + x1[3] * t1.w);
}

struct EpiRet {
    static constexpr bool PERM = false, AFTER_DRAIN = false;
    const float* ssq1; const float2* tab256; bf16_t* RQ; bf16_t* RKs; bf16_t* RVt;
    __device__ __forceinline__ void operator()(const f32x4 (&acc)[2][2][4][2], const pg8::Unit& u, int wr, int wc, int fr, int fq) const {
        EPI_RSTD(ssq1)
        if (u.pn < 8) {
            const int head = u.pn & 3; const float sc = u.pn < 4 ? 1.f : 0.0625f;
#pragma unroll
            for (int ai = 0; ai < 2; ++ai)
#pragma unroll
                for (int mh = 0; mh < 2; ++mh) {
                    float4 tb[2][2][2];
#pragma unroll
                    for (int m2 = 0; m2 < 2; ++m2) {
                        const int row = EPI_ROW(ai, 2 * mh + m2); const int pos = row < MR ? NMETA + (row & 2047) : (row < MR + NMETA ? row - MR : 0);
#pragma unroll
                        for (int bj = 0; bj < 2; ++bj) { const float4* tp = (const float4*)(tab256 + (size_t)pos * 128 + 16 * (4 * bj + wc) + 4 * fq); tb[m2][bj][0] = tp[0]; tb[m2][bj][1] = tp[1]; }
                    }
#pragma unroll
                    for (int m2 = 0; m2 < 2; ++m2) {
                        const int m = 2 * mh + m2; const int row = EPI_ROW(ai, m);
                        const bool real = row < MR; const int b = row >> 11; const int pos = real ? NMETA + (row & 2047) : row - MR;
                        if (row < MR + NMETA && (u.pn >= 4 || real)) {
                            const float r = rs_[ai][m] * sc;
#pragma unroll
                            for (int bj = 0; bj < 2; ++bj) {
                                const int jj0 = 16 * (4 * bj + wc) + 4 * fq; uint2 o1, o2;
                                rope4(acc[ai][bj][m][0] * r, acc[ai][bj][m][1] * r, tb[m2][bj][0], tb[m2][bj][1], o1, o2);
                                if (u.pn < 4) { bf16_t* d = RQ + (size_t)row * 1024 + head * 256 + jj0; *(uint2*)d = o1; *(uint2*)(d + 128) = o2; }
                                else if (real) { bf16_t* d = RKs + ((size_t)b * TP + pos) * 1024 + head * 256 + jj0; *(uint2*)d = o1; *(uint2*)(d + 128) = o2; }
                                else { for (int bb = 0; bb < NB; ++bb) { bf16_t* d = RKs + ((size_t)bb * TP + pos) * 1024 + head * 256 + jj0; *(uint2*)d = o1; *(uint2*)(d + 128) = o2; } }
                            }
                        }
                    }
                }
        } else {
#pragma unroll
            for (int ai = 0; ai < 2; ++ai)
#pragma unroll
                for (int m = 0; m < 4; ++m) {
                    const int row = EPI_ROW(ai, m);
                    if (row < MR + NMETA) {
                        const bool real = row < MR; const int b = row >> 11; const int pos = real ? NMETA + (row & 2047) : row - MR; const float r = rs_[ai][m];
#pragma unroll
                        for (int bj = 0; bj < 2; ++bj)
#pragma unroll
                            for (int n = 0; n < 2; ++n) {
                                const int cin = (u.pn - 8) * 256 + bj * 128 + wc * 32 + n * 16 + fq * 4; const int head = cin >> 9, dv = cin & 511;
                                const f32x4 v = acc[ai][bj][m][n] * r;
                                const bf16_t v0 = f2bf(v[0]), v1 = f2bf(v[1]), v2 = f2bf(v[2]), v3 = f2bf(v[3]);
                                if (real) { bf16_t* d = RVt + ((size_t)(b * 4 + head) * 512 + dv) * TP + vpos(pos); d[0] = v0; d[TP] = v1; d[2 * TP] = v2; d[3 * TP] = v3; }
                                else { for (int bb = 0; bb < NB; ++bb) { bf16_t* d = RVt + ((size_t)(bb * 4 + head) * 512 + dv) * TP + vpos(pos); d[0] = v0; d[TP] = v1; d[2 * TP] = v2; d[3 * TP] = v3; } }
                            }
                    }
                }
        }
    }
};

struct EpiAtt {
    static constexpr bool PERM = false, AFTER_DRAIN = false;
    const float* ssq1; const float2* tab128; const float2* tab64; const float* ssqY;
    bf16_t* AQ; bf16_t* AKs; bf16_t* AVt; bf16_t* IQ; bf16_t* IK; float* IW; bf16_t* Y;
    __device__ __forceinline__ void operator()(const f32x4 (&acc)[2][2][4][2], const pg8::Unit& u, int wr, int wc, int fr, int fq) const {
        EPI_RSTD(ssq1)
        if (u.pn < 8 || u.pn == 12 || u.pn == 13) {
            const bool d128 = u.pn < 8;
#pragma unroll
            for (int ai = 0; ai < 2; ++ai)
#pragma unroll
                for (int mh = 0; mh < 2; ++mh) {
                    float4 tb[2][2];
#pragma unroll
                    for (int m2 = 0; m2 < 2; ++m2) {
                        const int row = EPI_ROW(ai, 2 * mh + m2); const int pos = row < MR ? NMETA + (row & 2047) : (row < MR + NMETA ? row - MR : 0);
                        const float4* tp = d128 ? (const float4*)(tab128 + (size_t)pos * 64 + 16 * wc + 4 * fq) : (const float4*)(tab64 + (size_t)pos * 32 + 16 * (wc & 1) + 4 * fq);
                        tb[m2][0] = tp[0]; tb[m2][1] = tp[1];
                    }
#pragma unroll
                    for (int m2 = 0; m2 < 2; ++m2) {
                        const int m = 2 * mh + m2; const int row = EPI_ROW(ai, m);
                        const bool real = row < MR; const int b = row >> 11; const int pos = real ? NMETA + (row & 2047) : row - MR;
                        if (real || (row < MR + NMETA && u.pn >= 4 && u.pn < 8)) {
                            const float r = rs_[ai][m];
#pragma unroll
                            for (int bj = 0; bj < 2; ++bj) {
                                uint2 o1, o2; rope4(acc[ai][bj][m][0] * r, acc[ai][bj][m][1] * r, tb[m2][0], tb[m2][1], o1, o2);
                                if (d128) {
                                    const int head = 2 * (u.pn & 3) + bj; const int jj0 = 16 * wc + 4 * fq;
                                    if (u.pn < 4) { bf16_t* d = AQ + (size_t)row * 1024 + head * 128 + jj0; *(uint2*)d = o1; *(uint2*)(d + 64) = o2; }
                                    else if (real) { bf16_t* d = AKs + ((size_t)b * TP + pos) * 1024 + head * 128 + jj0; *(uint2*)d = o1; *(uint2*)(d + 64) = o2; }
                                    else { for (int bb = 0; bb < NB; ++bb) { bf16_t* d = AKs + ((size_t)bb * TP + pos) * 1024 + head * 128 + jj0; *(uint2*)d = o1; *(uint2*)(d + 64) = o2; } }
                                } else {
                                    const int head = (u.pn - 12) * 4 + 2 * bj + (wc >> 1); const int jj0 = 16 * (wc & 1) + 4 * fq;
                                    bf16_t* d = IQ + (size_t)row * 512 + head * 64 + jj0; *(uint2*)d = o1; *(uint2*)(d + 32) = o2;
                                }
                            }
                        }
                    }
                }
        } else if (u.pn < 12) {
#pragma unroll
            for (int ai = 0; ai < 2; ++ai)
#pragma unroll
                for (int m = 0; m < 4; ++m) {
                    const int row = EPI_ROW(ai, m);
                    if (row < MR + NMETA) {
                        const bool real = row < MR; const int b = row >> 11; const int pos = real ? NMETA + (row & 2047) : row - MR; const float r = rs_[ai][m];
#pragma unroll
                        for (int bj = 0; bj < 2; ++bj)
#pragma unroll
                            for (int n = 0; n < 2; ++n) {
                                const int cin = (u.pn - 8) * 256 + bj * 128 + wc * 32 + n * 16 + fq * 4; const int head = cin >> 7, dd = cin & 127;
                                const f32x4 v = acc[ai][bj][m][n] * r;
                                const bf16_t v0 = f2bf(v[0]), v1 = f2bf(v[1]), v2 = f2bf(v[2]), v3 = f2bf(v[3]);
                                if (real) { bf16_t* d = AVt + ((size_t)(b * 8 + head) * 128 + dd) * TP + vpos(pos); d[0] = v0; d[TP] = v1; d[2 * TP] = v2; d[3 * TP] = v3; }
                                else { for (int bb = 0; bb < NB; ++bb) { bf16_t* d = AVt + ((size_t)(bb * 8 + head) * 128 + dd) * TP + vpos(pos); d[0] = v0; d[TP] = v1; d[2 * TP] = v2; d[3 * TP] = v3; } }
                            }
                    }
                }
        } else if (u.pn == 14) {
#pragma unroll
            for (int ai = 0; ai < 2; ++ai) {
                float4 tb[4][2];
                if (wc < 2) {
#pragma unroll
                    for (int m = 0; m < 4; ++m) { const int row = EPI_ROW(ai, m); const int pos = row < MR ? NMETA + (row & 2047) : 0;
                        const float4* tp = (const float4*)(tab64 + (size_t)pos * 32 + 16 * wc + 4 * fq); tb[m][0] = tp[0]; tb[m][1] = tp[1]; }
                }
#pragma unroll
                for (int m = 0; m < 4; ++m) {
                    const int row = EPI_ROW(ai, m);
                    if (row < MR) {
                        const float r = rs_[ai][m];
                        if (wc < 2) {
                            uint2 o1, o2; rope4(acc[ai][0][m][0] * r, acc[ai][0][m][1] * r, tb[m][0], tb[m][1], o1, o2);
                            bf16_t* d = IK + (size_t)row * 64 + 16 * wc + 4 * fq; *(uint2*)d = o1; *(uint2*)(d + 32) = o2;
                        } else if (wc == 2 && fq < 2) {
                            *(f32x4*)(IW + (size_t)row * 8 + 4 * fq) = acc[ai][0][m][0] * r;
                        }
                    }
                }
            }
        } else {
            const int head = (u.pn - 15) >> 1;
#pragma unroll
            for (int ai = 0; ai < 2; ++ai)
#pragma unroll
                for (int mh = 0; mh < 2; ++mh) {
                    uint2 yv[2][2][2]; float ysq[2];
#pragma unroll
                    for (int m2 = 0; m2 < 2; ++m2) {
                        const int row = EPI_ROW(ai, 2 * mh + m2); const int rr = row < MR ? row : 0;
                        ysq[m2] = ssqY[(size_t)rr * 4 + head];
#pragma unroll
                        for (int bj = 0; bj < 2; ++bj)
#pragma unroll
                            for (int n = 0; n < 2; ++n) yv[m2][bj][n] = *(const uint2*)(Y + (size_t)rr * 2048 + (u.pn - 15) * 256 + bj * 128 + wc * 32 + n * 16 + fq * 4);
                    }
#pragma unroll
                    for (int m2 = 0; m2 < 2; ++m2) {
                        const int m = 2 * mh + m2; const int row = EPI_ROW(ai, m);
                        if (row < MR) {
                            const float r = rs_[ai][m]; const float ys = rsqrtf(ysq[m2] * (1.f / 512.f) + EPSN);
#pragma unroll
                            for (int bj = 0; bj < 2; ++bj)
#pragma unroll
                                for (int n = 0; n < 2; ++n) {
                                    const int cin = (u.pn - 15) * 256 + bj * 128 + wc * 32 + n * 16 + fq * 4;
                                    const f32x4 y = unpack4(yv[m2][bj][n]); const f32x4 g = acc[ai][bj][m][n] * r;
                                    *(uint2*)(Y + (size_t)row * 2048 + cin) = pack4(silu_f(g[0]) * y[0] * ys, silu_f(g[1]) * y[1] * ys, silu_f(g[2]) * y[2] * ys, silu_f(g[3]) * y[3] * ys);
                                }
                        }
                    }
                }
        }
    }
};

struct EpiPlain {
    static constexpr bool PERM = false, AFTER_DRAIN = false;
    bf16_t* out;
    __device__ __forceinline__ void operator()(const f32x4 (&acc)[2][2][4][2], const pg8::Unit& u, int wr, int wc, int fr, int fq) const {
#pragma unroll
        for (int ai = 0; ai < 2; ++ai)
#pragma unroll
            for (int m = 0; m < 4; ++m) {
                const int row = EPI_ROW(ai, m);
#pragma unroll
                for (int bj = 0; bj < 2; ++bj)
#pragma unroll
                    for (int n = 0; n < 2; ++n) {
                        const int c0 = u.pn * 256 + bj * 128 + wc * 32 + n * 16 + fq * 4; const f32x4 a = acc[ai][bj][m][n];
                        *(uint2*)(out + (size_t)row * DM + c0) = pack4(a[0], a[1], a[2], a[3]);
                    }
            }
    }
};

struct EpiGate {
    static constexpr bool PERM = false, AFTER_DRAIN = false;
    const float* ssq1; bf16_t* yr; const bf16_t* ya;
    __device__ __forceinline__ void operator()(const f32x4 (&acc)[2][2][4][2], const pg8::Unit& u, int wr, int wc, int fr, int fq) const {
        EPI_RSTD(ssq1)
#pragma unroll
        for (int ai = 0; ai < 2; ++ai) {
            uint2 av[4][2], cv[4][2];
#pragma unroll
            for (int m = 0; m < 4; ++m)
#pragma unroll
                for (int bj = 0; bj < 2; ++bj) { const size_t o = (size_t)EPI_ROW(ai, m) * DM + u.pn * 128 + bj * 64 + wc * 16 + fq * 4; av[m][bj] = *(const uint2*)(yr + o); cv[m][bj] = *(const uint2*)(ya + o); }
#pragma unroll
            for (int m = 0; m < 4; ++m) {
                const float r = rs_[ai][m];
#pragma unroll
                for (int bj = 0; bj < 2; ++bj) {
                    const size_t o = (size_t)EPI_ROW(ai, m) * DM + u.pn * 128 + bj * 64 + wc * 16 + fq * 4;
                    const f32x4 gr = acc[ai][bj][m][0] * r, ga = acc[ai][bj][m][1] * r; const f32x4 a = unpack4(av[m][bj]), c = unpack4(cv[m][bj]);
                    *(uint2*)(yr + o) = pack4(sigm_f(gr[0]) * a[0] + sigm_f(ga[0]) * c[0], sigm_f(gr[1]) * a[1] + sigm_f(ga[1]) * c[1],
                                              sigm_f(gr[2]) * a[2] + sigm_f(ga[2]) * c[2], sigm_f(gr[3]) * a[3] + sigm_f(ga[3]) * c[3]);
                }
            }
        }
    }
};
template <class Map>
__device__ __forceinline__ void convert_w(int K, int N, bf16_t* Wt, int Nd, const float* gain, Map map, unsigned char* smem) {
    bf16_t* tile = (bf16_t*)smem;
    const int tid = threadIdx.x; const int ntk = K / 256, nt = (Nd / 64) * ntk;
    for (int t = blockIdx.x; t < nt; t += gridDim.x) {
        const int n0 = (t / ntk) * 64, k0 = (t % ntk) * 256;
        const int kr = tid >> 4, nq = tid & 15;
        const float* W = nullptr; const int src = map(n0 + 4 * nq, W);
        float4 v[8];
#pragma unroll
        for (int p = 0; p < 8; ++p) { v[p] = make_float4(0.f, 0.f, 0.f, 0.f); if (src >= 0) v[p] = *(const float4*)(W + (size_t)(k0 + kr + 32 * p) * N + src); }
#pragma unroll
        for (int p = 0; p < 8; ++p) {
            const int kl = kr + 32 * p; const float g = gain ? gain[k0 + kl] : 1.f;
            bf16_t* tl = tile + (kl >> 6) * (64 * 72) + (kl & 63);
            tl[(4 * nq + 0) * 72] = f2bf(v[p].x * g); tl[(4 * nq + 1) * 72] = f2bf(v[p].y * g); tl[(4 * nq + 2) * 72] = f2bf(v[p].z * g); tl[(4 * nq + 3) * 72] = f2bf(v[p].w * g);
        }
        __syncthreads();
        const int nl = tid >> 3, kc = tid & 7;
#pragma unroll
        for (int q = 0; q < 4; ++q) *(uint4*)(Wt + (size_t)(n0 + nl) * K + k0 + 64 * q + 8 * kc) = *(const uint4*)(tile + q * (64 * 72) + nl * 72 + 8 * kc);
        __syncthreads();
    }
}
__device__ __forceinline__ int rope_nat(int c, int dbits) {
    const int g = c >> 5, hi = (c >> 4) & 1, i = c & 15; return (hi << (dbits - 1)) + 16 * g + i;
}

__device__ __forceinline__ void p0_prologue(const Args& A, unsigned char* smem) {
    unsigned char* ws = A.ws;
    const int tid = threadIdx.x, lane = tid & 63, wave = tid >> 6;
    const size_t gtid = (size_t)blockIdx.x * 512 + tid, gsz = (size_t)gridDim.x * 512;
    for (size_t i = gtid; i < ZERO_BYTES / 16; i += gsz) ((uint4*)(ws + WS_ZERO))[i] = make_uint4(0, 0, 0, 0);
    {
        bf16_t* xb = (bf16_t*)A.out; float* ssq0 = (float*)(ws + OFF_SSQ0);
        const int gw = blockIdx.x * 8 + wave, ngw = gridDim.x * 8;
        for (int row = gw; row < MP; row += ngw) {
            const float* src = row < MR ? A.in[0] + (size_t)row * DM : (row < MR + NMETA ? A.in[1] + (size_t)(row - MR) * DM : nullptr);
            float s = 0.f;
#pragma unroll
            for (int j = 0; j < 4; ++j) {
                float4 v = make_float4(0.f, 0.f, 0.f, 0.f);
                if (src) v = ((const float4*)src)[lane + 64 * j];
                s += (v.x * v.x + v.y * v.y) + (v.z * v.z + v.w * v.w);
                *(uint2*)(xb + (size_t)row * DM + 4 * (lane + 64 * j)) = pack4(v.x, v.y, v.z, v.w);
            }
            s = wave_sum(s);
            if (lane == 0) ssq0[row] = s;
        }
    }
    {
        float2* t256 = (float2*)(ws + OFF_TAB256); float2* t128 = (float2*)(ws + OFF_TAB128); float2* t64 = (float2*)(ws + OFF_TAB64);
        for (size_t i = gtid; i < (size_t)TT * 128; i += gsz) {
            const int pos = (int)(i >> 7), j = (int)(i & 127);
            const float inv = exp2f(-(float)j * (13.287712379549449f / 128.f));
            const float ang = (float)pos * inv;
            const double a = (double)ang; const double k = __builtin_rint(a * 0.15915494309189535);
            const double rr = a - k * 6.283185307179586; const double x = rr * 0.25, x2 = x * x;
            double s = x * (1.0 - x2 * (1.0 / 6.0) * (1.0 - x2 * (1.0 / 20.0) * (1.0 - x2 * (1.0 / 42.0) * (1.0 - x2 * (1.0 / 72.0) * (1.0 - x2 * (1.0 / 110.0) * (1.0 - x2 * (1.0 / 156.0)))))));
            double c = 1.0 - x2 * 0.5 * (1.0 - x2 * (1.0 / 12.0) * (1.0 - x2 * (1.0 / 30.0) * (1.0 - x2 * (1.0 / 56.0) * (1.0 - x2 * (1.0 / 90.0) * (1.0 - x2 * (1.0 / 132.0) * (1.0 - x2 * (1.0 / 182.0)))))));
            const double s2 = 2.0 * s * c, c2 = c * c - s * s; const double s4 = 2.0 * s2 * c2, c4 = c2 * c2 - s2 * s2;
            const float2 o = make_float2((float)c4, (float)s4);
            t256[i] = o;
            if ((j & 1) == 0) t128[(size_t)pos * 64 + (j >> 1)] = o;
            if ((j & 3) == 0) t64[(size_t)pos * 32 + (j >> 2)] = o;
        }
    }
    const float* w_in = A.in[7];
    convert_w(DM, DFF, (bf16_t*)(ws + OFF_W1), 5632, A.in[2], [&](int n, const float*& W) { W = ((n >> 4) & 1) ? A.in[4] : A.in[3]; return 16 * (n >> 5) + (n & 15); }, smem);
    convert_w(DFF, DM, (bf16_t*)(ws + OFF_WD1), 1024, nullptr, [&](int n, const float*& W) { W = A.in[5]; return n; }, smem);
    convert_w(DM, DIN, (bf16_t*)(ws + OFF_WINA), 4096, A.in[6], [&](int n, const float*& W) { W = w_in;
        if (n < 2048) return (n < 1024 ? O_RQ : O_RK) + ((n & 1023) >> 8) * 256 + rope_nat(n & 255, 8);
        return O_RV + (n - 2048); }, smem);
    convert_w(DM, DIN, (bf16_t*)(ws + OFF_WINB), 5888, A.in[6], [&](int n, const float*& W) { W = w_in;
        if (n < 2048) return (n < 1024 ? O_AQ : O_AK) + ((n & 1023) >> 7) * 128 + rope_nat(n & 127, 7);
        if (n < 3072) return O_AV + (n - 2048);
        if (n < 3584) return O_IQ + ((n - 3072) >> 6) * 64 + rope_nat((n - 3072) & 63, 6);
        if (n < 3648) return O_IK + rope_nat(n - 3584, 6);
        if (n < 3656) return O_IW + (n - 3648);
        if (n < 3840) return -1;
        return O_RG + (n - 3840); }, smem);
    convert_w(DM, DIN, (bf16_t*)(ws + OFF_WINC), 2048, A.in[6], [&](int n, const float*& W) { W = w_in; return (((n >> 4) & 1) ? O_GA : O_GR) + 16 * (n >> 5) + (n & 15); }, smem);
    convert_w(2048, DM, (bf16_t*)(ws + OFF_WRO), 1024, nullptr, [&](int n, const float*& W) { W = A.in[8]; return n; }, smem);
    convert_w(DM, DM, (bf16_t*)(ws + OFF_WAO), 1024, nullptr, [&](int n, const float*& W) { W = A.in[9]; return n; }, smem);
    convert_w(DM, DM, (bf16_t*)(ws + OFF_WMX), 1024, nullptr, [&](int n, const float*& W) { W = A.in[10]; return n; }, smem);
    convert_w(DM, DFF, (bf16_t*)(ws + OFF_W2), 5632, A.in[11], [&](int n, const float*& W) { W = ((n >> 4) & 1) ? A.in[13] : A.in[12]; return 16 * (n >> 5) + (n & 15); }, smem);
    convert_w(DFF, DM, (bf16_t*)(ws + OFF_WD2), 1024, nullptr, [&](int n, const float*& W) { W = A.in[14]; return n; }, smem);
}

template <int DQK, int DV, int RB, bool SOFTMAX, int NSTG>
__device__ __forceinline__ void flash_unit(const bf16_t* __restrict__ Q, int ldq, const bf16_t* __restrict__ Kb, int ldk, const bf16_t* __restrict__ Vt,
                                           bf16_t* Out, int ldo, int qpos0, int kt_lo, int kt_hi, const u64* __restrict__ mask64, float p0, float* ssqY, unsigned char* smem) {
    constexpr int KCH = DQK / 8, NKD = KCH / 8, NVD = DV / 64, NKS = DQK / 32, NNB = DV / 16;
    constexpr int KBYTES = 64 * DQK * 2, STAGE = KBYTES + DV * 64 * 2;
    const int tid = threadIdx.x, lane = tid & 63, w = __builtin_amdgcn_readfirstlane(tid >> 6), fr = lane & 15, quad = lane >> 4;
    bf16x8 qf[RB][NKS];
#pragma unroll
    for (int rb = 0; rb < RB; ++rb)
#pragma unroll
        for (int ks = 0; ks < NKS; ++ks) qf[rb][ks] = *(const bf16x8*)(Q + (size_t)(w * 16 * RB + rb * 16 + fr) * ldq + ks * 32 + quad * 8);
    f32x4 o[NNB][RB];
#pragma unroll
    for (int nb = 0; nb < NNB; ++nb)
#pragma unroll
        for (int rb = 0; rb < RB; ++rb) o[nb][rb] = (f32x4){0.f, 0.f, 0.f, 0.f};
    float mrun[RB], lrun[RB];
#pragma unroll
    for (int rb = 0; rb < RB; ++rb) { mrun[rb] = -INFINITY; lrun[rb] = 0.f; }
    PG8_LAS unsigned char* lds = (PG8_LAS unsigned char*)smem;
    int koff[4], voff[4];
    float bk[4][4];
#pragma unroll
    for (int kb = 0; kb < 4; ++kb)
#pragma unroll
        for (int j = 0; j < 4; ++j) bk[kb][j] = SOFTMAX ? 1.f : __builtin_amdgcn_exp2f(-(float)(kb * 16 + quad * 4 + j) * p0);
#pragma unroll
    for (int a = 0; a < 4; ++a) { koff[a] = (fr * KCH + ((a * 4) ^ quad ^ fr)) * 16; voff[a] = (fr * 8 + (((a & 1) * 4) ^ quad ^ ((fr >> 1) & 7))) * 16; }
#define FL_DMA(KT, BUF) do { \
    _Pragma("unroll") for (int i = 0; i < NKD; ++i) { const int gi = (i * 8 + w) * 64 + lane, r = gi / KCH, cc = (gi % KCH) ^ (r & 15); int t = 64 * (KT) + r; t = t < TT ? t : TT - 1; \
        __builtin_amdgcn_global_load_lds((const unsigned*)(Kb + (size_t)t * ldk + cc * 8), (PG8_LAS unsigned*)(lds + (BUF) * STAGE + (i * 8 + w) * 1024), 16, 0, 0); } \
    _Pragma("unroll") for (int i = 0; i < NVD; ++i) { const int gi = (i * 8 + w) * 64 + lane, r = gi >> 3, cc = (gi & 7) ^ ((r >> 1) & 7); int t = 64 * (KT) + 8 * cc; t = t < 2080 ? t : 2072; \
        __builtin_amdgcn_global_load_lds((const unsigned*)(Vt + (size_t)r * TP + t), (PG8_LAS unsigned*)(lds + (BUF) * STAGE + KBYTES + (i * 8 + w) * 1024), 16, 0, 0); } } while (0)
    constexpr int NDMA = NKD + NVD;
    PG8_LAS u64* mlds = (PG8_LAS u64*)(lds + NSTG * STAGE);
    if (SOFTMAX) {
        constexpr int NR = 16 * RB * 8;
        for (int i = tid; i < NR * 33; i += 512) { const int r = i / 33, c = i % 33; mlds[c * NR + r] = mask64[(size_t)r * 33 + c]; }
    }
    FL_DMA(kt_lo, 0);
#pragma unroll
    for (int p = 1; p < NSTG - 1; ++p) if (kt_lo + p <= kt_hi) FL_DMA(kt_lo + p, p);
    int cur = 0;
    for (int kt = kt_lo; kt <= kt_hi; ++kt) {
        if (NSTG == 2 || kt + NSTG - 2 > kt_hi) asm volatile("s_waitcnt vmcnt(0)" ::: "memory");
        else if (NSTG == 3) asm volatile("s_waitcnt vmcnt(%0)" :: "n"(NDMA) : "memory");
        else asm volatile("s_waitcnt vmcnt(%0)" :: "n"(2 * NDMA) : "memory");
        __syncthreads();
        { const int nb_ = cur == 0 ? NSTG - 1 : cur - 1; if (kt + NSTG - 1 <= kt_hi) FL_DMA(kt + NSTG - 1, nb_); }
        const PG8_LAS unsigned char* Ks = lds + cur * STAGE; const PG8_LAS unsigned char* Vs = Ks + KBYTES;
        cur = (cur + 1 == NSTG) ? 0 : cur + 1;
        const PG8_LAS unsigned char* kp[4]; const PG8_LAS unsigned char* vp4[4];
#pragma unroll
        for (int a = 0; a < 4; ++a) { kp[a] = Ks + koff[a]; vp4[a] = Vs + voff[a]; }
        u64 mw[RB];
        if (SOFTMAX) {
#pragma unroll
            for (int rb = 0; rb < RB; ++rb) mw[rb] = mlds[kt * (16 * RB * 8) + w * 16 * RB + rb * 16 + fr];
        }
        f32x4 s[4][RB];
#pragma unroll
        for (int kb = 0; kb < 4; ++kb)
#pragma unroll
            for (int rb = 0; rb < RB; ++rb) s[kb][rb] = (f32x4){0.f, 0.f, 0.f, 0.f};
        {
            constexpr int GPK = NKS / 4, NGS = 4 * GPK;
            bf16x8 fg[3][4];
#define FL_LDK(G) do { _Pragma("unroll") for (int q4 = 0; q4 < 4; ++q4) { const int ks_ = ((G) % GPK) * 4 + q4; \
                fg[(G) % 3][q4] = *(const PG8_LAS bf16x8*)(kp[ks_ & 3] + ((G) / GPK) * 16 * KCH * 16 + (ks_ >> 2) * 256); } } while (0)
            FL_LDK(0); if (NGS > 1) FL_LDK(1);
#pragma unroll
            for (int g = 0; g < NGS; ++g) {
                if (g + 2 < NGS) FL_LDK(g + 2);
                __builtin_amdgcn_sched_barrier(0);
#pragma unroll
                for (int q4 = 0; q4 < 4; ++q4)
#pragma unroll
                    for (int rb = 0; rb < RB; ++rb) s[g / GPK][rb] = __builtin_amdgcn_mfma_f32_16x16x32_bf16(fg[g % 3][q4], qf[rb][(g % GPK) * 4 + q4], s[g / GPK][rb], 0, 0, 0);
                __builtin_amdgcn_sched_barrier(0);
            }
        }
        bf16x8 pa[RB][2];
#pragma unroll
        for (int rb = 0; rb < RB; ++rb) {
            const int qpos = qpos0 + w * 16 * RB + rb * 16 + fr;
            float p[4][4];
            if (SOFTMAX) {
                const u64 mq = mw[rb] >> (quad * 4);
                const unsigned mlo = (unsigned)mq, mhi = (unsigned)(mq >> 32);
                float tmax = -INFINITY;
#pragma unroll
                for (int kb = 0; kb < 4; ++kb)
#pragma unroll
                    for (int j = 0; j < 4; ++j) {
                        const unsigned wsel = (kb < 2) ? mlo : mhi; const unsigned bitm = 1u << ((kb & 1) * 16 + j);
                        const float v = (wsel & bitm) ? s[kb][rb][j] : -INFINITY;
                        p[kb][j] = v; tmax = fmaxf(tmax, v);
                    }
                tmax = fmaxf(tmax, __shfl_xor(tmax, 16)); tmax = fmaxf(tmax, __shfl_xor(tmax, 32));
                const float tm = tmax * p0;
                if (__ballot(tm > mrun[rb] + 8.f) != 0ull) {
                    const float mnew = fmaxf(mrun[rb], tm); const float msafe = (mnew == -INFINITY) ? 0.f : mnew;
                    const float alpha = __builtin_amdgcn_exp2f(mrun[rb] - msafe);
                    lrun[rb] *= alpha; mrun[rb] = mnew;
#pragma unroll
                    for (int nb = 0; nb < NNB; ++nb) o[nb][rb] *= alpha;
                }
                const float mref = (mrun[rb] == -INFINITY) ? 0.f : mrun[rb];
                float ps = 0.f;
#pragma unroll
                for (int kb = 0; kb < 4; ++kb)
#pragma unroll
                    for (int j = 0; j < 4; ++j) { const float e = __builtin_amdgcn_exp2f(fmaf(p[kb][j], p0, -mref)); p[kb][j] = e; ps += e; }
                lrun[rb] += ps;
            } else {
                const float aq = __builtin_amdgcn_exp2f((float)(qpos - 64 * kt) * p0);
                if (64 * kt + 63 > qpos0 + w * 16 * RB) {
#pragma unroll
                    for (int kb = 0; kb < 4; ++kb)
#pragma unroll
                        for (int j = 0; j < 4; ++j) { const int kpos = 64 * kt + kb * 16 + quad * 4 + j; p[kb][j] = (kpos <= qpos) ? s[kb][rb][j] * (aq * bk[kb][j]) : 0.f; }
                } else {
#pragma unroll
                    for (int kb = 0; kb < 4; ++kb)
#pragma unroll
                        for (int j = 0; j < 4; ++j) p[kb][j] = s[kb][rb][j] * (aq * bk[kb][j]);
                }
            }
#pragma unroll
            for (int i = 0; i < 2; ++i) {
                union { bf16x8 v; unsigned u[4]; } t;
                t.u[0] = cvt_pk_bf16(p[2 * i][0], p[2 * i][1]); t.u[1] = cvt_pk_bf16(p[2 * i][2], p[2 * i][3]);
                t.u[2] = cvt_pk_bf16(p[2 * i + 1][0], p[2 * i + 1][1]); t.u[3] = cvt_pk_bf16(p[2 * i + 1][2], p[2 * i + 1][3]);
                pa[rb][i] = t.v;
            }
        }
        {
            constexpr int GPI = NNB / 4, NGV = 2 * GPI;
            bf16x8 vg[3][4];
#define FL_LDV(G) do { _Pragma("unroll") for (int q4 = 0; q4 < 4; ++q4) { const int nb_ = ((G) % GPI) * 4 + q4, i_ = (G) / GPI; \
                vg[(G) % 3][q4] = *(const PG8_LAS bf16x8*)(vp4[i_] + nb_ * 2048); } } while (0)
            FL_LDV(0); FL_LDV(1);
#pragma unroll
            for (int g = 0; g < NGV; ++g) {
                if (g + 2 < NGV) FL_LDV(g + 2);
                __builtin_amdgcn_sched_barrier(0);
#pragma unroll
                for (int q4 = 0; q4 < 4; ++q4)
#pragma unroll
                    for (int rb = 0; rb < RB; ++rb) o[(g % GPI) * 4 + q4][rb] = __builtin_amdgcn_mfma_f32_16x16x32_bf16(vg[g % 3][q4], pa[rb][g / GPI], o[(g % GPI) * 4 + q4][rb], 0, 0, 0);
                __builtin_amdgcn_sched_barrier(0);
            }
        }
    }
#pragma unroll
    for (int rb = 0; rb < RB; ++rb) {
        const int qrow = w * 16 * RB + rb * 16 + fr;
        float scale = 1.f;
        if (SOFTMAX) { float l = lrun[rb]; l += __shfl_xor(l, 16); l += __shfl_xor(l, 32); scale = 1.f / l; }
        float part = 0.f;
#pragma unroll
        for (int nb = 0; nb < NNB; ++nb) {
            const f32x4 v = o[nb][rb] * scale;
            part += (v[0] * v[0] + v[1] * v[1]) + (v[2] * v[2] + v[3] * v[3]);
            *(uint2*)(Out + (size_t)qrow * ldo + nb * 16 + quad * 4) = pack4(v[0], v[1], v[2], v[3]);
        }
        if (!SOFTMAX) { part += __shfl_xor(part, 16); part += __shfl_xor(part, 32); if (quad == 0) atomicAdd(ssqY + (size_t)qrow * 4, part); }
    }
}

__device__ __forceinline__ unsigned next_unit(unsigned* ctr, unsigned char* smem) {
    volatile unsigned* sh = (volatile unsigned*)(smem + LDS_CTL);
    __syncthreads();
    if (threadIdx.x == 0) *sh = atomicAdd(ctr, 1u);
    __syncthreads();
    return (unsigned)__builtin_amdgcn_readfirstlane((int)*sh);
}

__device__ __forceinline__ void retention_unit(const Args& A, unsigned char* smem, int b, int h, int qb, int dvh) {
    unsigned char* ws = A.ws;
    const bf16_t* RQ = (const bf16_t*)(ws + OFF_RQ); const bf16_t* RKs = (const bf16_t*)(ws + OFF_RKS); const bf16_t* RVt = (const bf16_t*)(ws + OFF_RVT);
    bf16_t* Y = (bf16_t*)A.out; float* ssqY = (float*)(ws + OFF_SSQY);
    const int s0 = 128 * qb, row0 = b * SEQ + s0, qpos0 = NMETA + s0;
    const float l2g = A.l2g[h]; const int cut = (int)(40.f / -l2g);
    int kt_lo = (qpos0 - cut) / 64; if (qpos0 < cut) kt_lo = 0;
    flash_unit<256, 256, 1, false, 2>(RQ + (size_t)row0 * 1024 + h * 256, 1024, RKs + (size_t)b * TP * 1024 + h * 256, 1024, RVt + ((size_t)(b * 4 + h) * 512 + dvh * 256) * TP,
                                      Y + (size_t)row0 * 2048 + h * 512 + dvh * 256, 2048, qpos0, kt_lo, (qpos0 + 127) / 64, nullptr, l2g, ssqY + (size_t)row0 * 4 + h, smem);
}
__device__ __forceinline__ void retention_phase(const Args& A, unsigned char* smem) {
    if (gridDim.x == 256) {
        const int b = blockIdx.x & 7, c = blockIdx.x >> 3, dvh = c & 1, j = c >> 1;
        for (int r = 0; r < 4; ++r) { __syncthreads(); retention_unit(A, smem, b, 3 - r, (r & 1) ? 15 - j : j, dvh); }
    } else {
        unsigned* ctr = (unsigned*)(A.ws + OFF_CTR) + 0;
        for (;;) { const unsigned u = next_unit(ctr, smem); if (u >= 1024u) break;
            const int rest = (int)(u & 63); retention_unit(A, smem, rest >> 3, (rest >> 1) & 3, 15 - (int)(u >> 6), rest & 1); }
    }
}
__device__ __forceinline__ void attention_unit(const Args& A, unsigned char* smem, int b, int h, int qb) {
    unsigned char* ws = A.ws;
    bf16_t* AQ = (bf16_t*)(ws + OFF_AQ); const bf16_t* AKs = (const bf16_t*)(ws + OFF_AKS); const bf16_t* AVt = (const bf16_t*)(ws + OFF_AVT);
    const u64* mask64 = (const u64*)(ws + OFF_MASK);
    const int s0 = 128 * qb, row0 = b * SEQ + s0, qpos0 = NMETA + s0;
    flash_unit<128, 128, 1, true, 3>(AQ + (size_t)row0 * 1024 + h * 128, 1024, AKs + (size_t)b * TP * 1024 + h * 128, 1024, AVt + (size_t)(b * 8 + h) * 128 * TP,
                                     AQ + (size_t)row0 * 1024 + h * 128, 1024, qpos0, 0, (qpos0 + 127) / 64, mask64 + (size_t)row0 * 33, 0.08838834764831845f * 1.4426950408889634f, nullptr, smem);
}
__device__ __forceinline__ void attention_phase(const Args& A, unsigned char* smem) {
    if (gridDim.x == 256) {
        const int b = blockIdx.x & 7, c = blockIdx.x >> 3;
        for (int r = 0; r < 4; ++r) { __syncthreads(); attention_unit(A, smem, b, 2 * r + (c >> 4), (r & 1) ? 15 - (c & 15) : (c & 15)); }
    } else {
        unsigned* ctr = (unsigned*)(A.ws + OFF_CTR) + 2;
        for (;;) { const unsigned u = next_unit(ctr, smem); if (u >= 1024u) break;
            const int bh = (int)(u & 63); attention_unit(A, smem, bh >> 3, bh & 7, 15 - (int)(u >> 6)); }
    }
}

__device__ __forceinline__ void cnt_ge_u32(int& c, unsigned a, unsigned b) { asm volatile("v_cmp_ge_u32 vcc, %1, %2\n\tv_addc_co_u32 %0, vcc, 0, %0, vcc" : "+v"(c) : "v"(a), "v"(b) : "vcc"); }
__device__ __forceinline__ void cnt_gt_u32(int& c, unsigned a, unsigned b) { asm volatile("v_cmp_gt_u32 vcc, %1, %2\n\tv_addc_co_u32 %0, vcc, 0, %0, vcc" : "+v"(c) : "v"(a), "v"(b) : "vcc"); }
__device__ __forceinline__ void cnt_eq_u32(int& c, unsigned a, unsigned b) { asm volatile("v_cmp_eq_u32 vcc, %1, %2\n\tv_addc_co_u32 %0, vcc, 0, %0, vcc" : "+v"(c) : "v"(a), "v"(b) : "vcc"); }
__device__ __forceinline__ void cnt_lt_i32(int& c, int a, int b) { asm volatile("v_cmp_lt_i32 vcc, %1, %2\n\tv_addc_co_u32 %0, vcc, 0, %0, vcc" : "+v"(c) : "v"(a), "v"(b) : "vcc"); }
__device__ __forceinline__ int sel_eq_idx(unsigned a, unsigned b, int idx) { int e; const int huge = 0x7fffffff; asm volatile("v_cmp_eq_u32 vcc, %1, %2\n\tv_cndmask_b32 %0, %3, %4, vcc" : "=v"(e) : "v"(a), "v"(b), "v"(huge), "v"(idx) : "vcc"); return e; }
__device__ __forceinline__ int sel_gt_m1(unsigned a, unsigned b, int e) { int v; const int m1 = -1; asm volatile("v_cmp_gt_u32 vcc, %1, %2\n\tv_cndmask_b32 %0, %3, %4, vcc" : "=v"(v) : "v"(a), "v"(b), "v"(e), "v"(m1) : "vcc"); return v; }
__device__ __forceinline__ void shl_in_le_i32(unsigned& nib, int a, int b) { asm volatile("v_cmp_le_i32 vcc, %1, %2\n\tv_addc_co_u32 %0, vcc, %0, %0, vcc" : "+v"(nib) : "v"(a), "v"(b) : "vcc"); }

template <int NP>
__device__ __forceinline__ int pk_count_ge(const unsigned (&x)[NP], unsigned cand) {
    const unsigned cm1 = (cand - 1u) * 0x00010001u, one = 0x00010001u;
    unsigned c = 0u;
#pragma unroll
    for (int m = 0; m < NP; ++m) {
        unsigned t;
        asm("v_pk_sub_u16 %0, %1, %2 clamp" : "=v"(t) : "v"(x[m]), "v"(cm1));
        asm("v_pk_min_u16 %0, %1, %2" : "=v"(t) : "v"(t), "v"(one));
        asm("v_pk_add_u16 %0, %1, %2" : "=v"(c) : "v"(c), "v"(t));
    }
    int v = (int)((c & 0xFFFFu) + (c >> 16));
    v += __builtin_amdgcn_update_dpp(0, v, 0x111, 0xf, 0xf, true);
    v += __builtin_amdgcn_update_dpp(0, v, 0x112, 0xf, 0xf, true);
    v += __builtin_amdgcn_update_dpp(0, v, 0x114, 0xf, 0xf, true);
    v += __builtin_amdgcn_update_dpp(0, v, 0x118, 0xf, 0xf, true);
    v += __builtin_amdgcn_update_dpp(0, v, 0x142, 0xa, 0xf, false);
    v += __builtin_amdgcn_update_dpp(0, v, 0x143, 0xc, 0xf, false);
    return __builtin_amdgcn_readlane(v, 63);
}

template <int NI>
__device__ __forceinline__ u64 select_query(const unsigned* skq, int lane) {
    unsigned uk[NI];
#pragma unroll
    for (int i = 0; i < NI; ++i) uk[i] = skq[64 * i + lane];
    unsigned hp[NI / 2];
#pragma unroll
    for (int m = 0; m < NI / 2; ++m) hp[m] = (uk[2 * m] >> 16) | (uk[2 * m + 1] & 0xFFFF0000u);
    unsigned T16 = 0u;
    for (int bit = 15; bit >= 0; --bit) {
        const unsigned cand = T16 | (1u << bit);
        if (pk_count_ge<NI / 2>(hp, cand) >= 256) T16 = cand;
    }
    const int cgt_hi = (T16 < 0xFFFFu) ? pk_count_ge<NI / 2>(hp, T16 + 1u) : 0;
    const int need_lo = 256 - cgt_hi;
#pragma unroll
    for (int m = 0; m < NI / 2; ++m) {
        const unsigned a = uk[2 * m], b2 = uk[2 * m + 1];
        const unsigned la = ((a >> 16) == T16) ? (a & 0xFFFFu) : 0u, lb = ((b2 >> 16) == T16) ? (b2 << 16) : 0u;
        hp[m] = la | lb;
    }
    unsigned L16 = 0u;
    for (int bit = 15; bit >= 0; --bit) {
        const unsigned cand = L16 | (1u << bit);
        if (pk_count_ge<NI / 2>(hp, cand) >= need_lo) L16 = cand;
    }
    const unsigned Tq = (T16 << 16) | L16;
    int cgt = 0;
#pragma unroll
    for (int i = 0; i < NI; ++i) cgt += __builtin_popcountll(__ballot(uk[i] > Tq));
    int rem = 256 - cgt;
    u64 myout = 0ull;
    u64 prev = 0xFFFFull << 48;
#pragma unroll
    for (int i = 0; i < NI; ++i) {
        const u64 gt = __ballot(uk[i] > Tq); u64 eq = __ballot(uk[i] == Tq);
        const int ce = __builtin_popcountll(eq);
        if (ce > rem) eq = __ballot(((eq >> lane) & 1ull) && (int)__builtin_amdgcn_mbcnt_hi((unsigned)(eq >> 32), __builtin_amdgcn_mbcnt_lo((unsigned)eq, 0u)) < rem);
        rem -= (ce > rem) ? rem : ce;
        const u64 sel = gt | eq;
        const u64 outw = (prev >> 48) | (sel << 16);
        if (lane == i) myout = outw;
        prev = sel;
    }
    if (lane == NI) myout = prev >> 48;
    return myout;
}

__device__ __forceinline__ void indexer_phase(const Args& A, unsigned char* smem) {
    unsigned char* ws = A.ws; unsigned* ctr = (unsigned*)(ws + OFF_CTR) + 1;
    const bf16_t* IQ = (const bf16_t*)(ws + OFF_IQ); const bf16_t* IK = (const bf16_t*)(ws + OFF_IK); const float* IW = (const float*)(ws + OFF_IW);
    u64* mask64 = (u64*)(ws + OFF_MASK);
    constexpr int SKS = 2052;
    unsigned* sk = (unsigned*)smem;
    const int tid = threadIdx.x, lane = tid & 63, w = __builtin_amdgcn_readfirstlane(tid >> 6), fr = lane & 15, quad = lane >> 4;
    for (;;) {
        const unsigned u = next_unit(ctr, smem); if (u >= 1024u) break;
        const int g = 127 - (int)(u >> 3), b = (int)(u & 7), s0 = 16 * g, row0 = b * SEQ + s0;
        const int nkeys = s0 + 16, ni = (nkeys + 63) >> 6;
        if (g >= 16) {
            { const int nz = 512 * ((ni + 7) >> 3) - nkeys; for (int i = tid; i < 16 * nz; i += 512) { const int r = i / nz, c = nkeys + (i % nz); sk[r * SKS + c] = 0u; } }
            bf16x8 qf[8][2];
#pragma unroll
            for (int h = 0; h < 8; ++h)
#pragma unroll
                for (int ks = 0; ks < 2; ++ks) qf[h][ks] = *(const bf16x8*)(IQ + (size_t)(row0 + fr) * 512 + h * 64 + ks * 32 + quad * 8);
            const float4 w0 = *(const float4*)(IW + (size_t)(row0 + fr) * 8), w1 = *(const float4*)(IW + (size_t)(row0 + fr) * 8 + 4);
            const float wq[8] = {w0.x, w0.y, w0.z, w0.w, w1.x, w1.y, w1.z, w1.w};
            const bf16_t* kbase = IK + (size_t)(b * SEQ + fr) * 64 + quad * 8;
            bf16x8 nk0 = *(const bf16x8*)(kbase + (size_t)(16 * w) * 64), nk1 = *(const bf16x8*)(kbase + (size_t)(16 * w) * 64 + 32);
            for (int kt = w; kt <= g; kt += 8) {
                const bf16x8 kf0 = nk0, kf1 = nk1;
                if (kt + 8 <= g) { nk0 = *(const bf16x8*)(kbase + (size_t)(16 * (kt + 8)) * 64); nk1 = *(const bf16x8*)(kbase + (size_t)(16 * (kt + 8)) * 64 + 32); }
                float sc[4] = {0.f, 0.f, 0.f, 0.f};
#pragma unroll
                for (int h = 0; h < 8; ++h) {
                    f32x4 c = __builtin_amdgcn_mfma_f32_16x16x32_bf16(kf0, qf[h][0], (f32x4){0.f, 0.f, 0.f, 0.f}, 0, 0, 0);
                    c = __builtin_amdgcn_mfma_f32_16x16x32_bf16(kf1, qf[h][1], c, 0, 0, 0);
#pragma unroll
                    for (int j = 0; j < 4; ++j) sc[j] += wq[h] * fmaxf(c[j], 0.f);
                }
                unsigned kk[4];
#pragma unroll
                for (int j = 0; j < 4; ++j) {
                    const int s = 16 * kt + quad * 4 + j;
                    const unsigned bits = __float_as_uint(sc[j] + 0.0f);
                    const unsigned ok = bits ^ ((unsigned)((int)bits >> 31) | 0x80000000u);
                    kk[j] = (s > s0 + fr) ? 0u : ok;
                }
                *(uint4*)(sk + fr * SKS + 16 * kt + quad * 4) = make_uint4(kk[0], kk[1], kk[2], kk[3]);
            }
        }
        __syncthreads();
#ifdef DUPB
#define NQQ 4
#else
#define NQQ 2
#endif
#pragma unroll 1
        for (int qq_ = 0; qq_ < NQQ; ++qq_) {
            const int qq = qq_ & 1; const int q = 2 * w + qq; const int sq = s0 + q;
            u64 myout = 0ull;
            if (g >= 16) {
                const unsigned* skq = sk + q * SKS;
                const int n8 = (ni + 7) >> 3;
                if (n8 == 1) myout = select_query<8>(skq, lane); else if (n8 == 2) myout = select_query<16>(skq, lane);
                else if (n8 == 3) myout = select_query<24>(skq, lane); else myout = select_query<32>(skq, lane);
            } else {
                const int lim = 16 + sq - 64 * lane;
                myout = lim >= 63 ? ~0ull : (lim < 0 ? 0ull : ((2ull << lim) - 1ull));
            }
            if (lane < 33) mask64[(size_t)(row0 + q) * 33 + lane] = myout;
        }
    }
}

#define LAS __attribute__((address_space(3)))
#define XB_TMO      128
#define XB_XCNT(j)  (256  + 64 * (j))
#define XB_XSUB(j)  (1280 + 64 * (j))
#define XB_XGEN(j)  (2304 + 64 * (j))
#define XB_TOP      3328
#define XB_TOPGEN   3392
#define XCD_BAR_WORDS 3456
#define XB_SPIN_CAP (1u << 18)

__device__ __forceinline__ unsigned xb_ld(unsigned* p)              { return __hip_atomic_load(p, __ATOMIC_RELAXED, __HIP_MEMORY_SCOPE_AGENT); }
__device__ __forceinline__ unsigned xb_add(unsigned* p, unsigned v) { return __hip_atomic_fetch_add(p, v, __ATOMIC_RELAXED, __HIP_MEMORY_SCOPE_AGENT); }
__device__ __forceinline__ unsigned xb_xcc_id() { return (unsigned)__builtin_amdgcn_s_getreg((3 << 11) | 20) & 0xFu; }
#define XB_SPIN(cond, bar) do { unsigned _sp = 0; while (cond) { __builtin_amdgcn_s_sleep(1); \
    if ((++_sp & 255u) == 0u) { if (xb_ld(&(bar)[XB_TMO])) break; if (_sp > XB_SPIN_CAP) { atomicAdd(&(bar)[XB_TMO], 1u); break; } } } } while (0)

struct XcdBarrier {
    unsigned* bar; unsigned x;
    volatile LAS unsigned* st;
};

__device__ __forceinline__ XcdBarrier xcd_barrier_post(unsigned* bar, volatile LAS unsigned* st) {
    XcdBarrier b; b.bar = bar; b.x = xb_xcc_id(); b.st = st;
    if (threadIdx.x == 0) (void)xb_add(&bar[XB_XCNT(b.x)], 1u);
    return b;
}
__device__ __forceinline__ void xcd_barrier_complete(unsigned* bar, unsigned x, unsigned& nloc, unsigned& nx) {
    const unsigned G = gridDim.x * gridDim.y * gridDim.z;
    unsigned sum, cnt, mine, sp = 0u;
    for (;;) {
        sum = 0u; cnt = 0u; mine = 0u;
#pragma unroll
        for (unsigned j = 0; j < 16; ++j) { const unsigned c = xb_ld(&bar[XB_XCNT(j)]); sum += c; cnt += (c > 0u) ? 1u : 0u; mine = (j == x) ? c : mine; }
        if (sum == G) break;
        __builtin_amdgcn_s_sleep(1);
        if ((++sp & 255u) == 0u) { if (xb_ld(&bar[XB_TMO])) break; if (sp > XB_SPIN_CAP) { atomicAdd(&bar[XB_TMO], 1u); break; } }
    }
    nloc = mine > 0u ? mine : 1u; nx = cnt > 0u ? cnt : 1u;
}

__device__ __forceinline__ void xcd_barrier(const XcdBarrier& b) {
    asm volatile("s_waitcnt vmcnt(0)" ::: "memory");
    __syncthreads();
    if (threadIdx.x == 0) {
        unsigned* bar = b.bar;
        __builtin_amdgcn_s_waitcnt(0);
        unsigned nloc = b.st[0], nx = b.st[1];
        if (nloc == 0u) { xcd_barrier_complete(bar, b.x, nloc, nx); b.st[0] = nloc; b.st[1] = nx; }
        const unsigned old = xb_add(&bar[XB_XSUB(b.x)], 1u);
        const unsigned gen = old / nloc;
        if (old + 1u == (gen + 1u) * nloc) {
            __builtin_amdgcn_fence(__ATOMIC_RELEASE, "agent");
            asm volatile("s_waitcnt vmcnt(0)" ::: "memory");
            const unsigned og = xb_add(&bar[XB_TOP], 1u);
            const unsigned tg = og / nx;
            if (og + 1u == (tg + 1u) * nx) xb_add(&bar[XB_TOPGEN], 1u);
            else XB_SPIN(xb_ld(&bar[XB_TOPGEN]) == tg, bar);
            __builtin_amdgcn_fence(__ATOMIC_ACQUIRE, "agent");
            xb_add(&bar[XB_XGEN(b.x)], 1u);
            asm volatile("s_waitcnt vmcnt(0)" ::: "memory");
        } else {
            XB_SPIN(xb_ld(&bar[XB_XGEN(b.x)]) == gen, bar);
            __builtin_amdgcn_fence(__ATOMIC_ACQUIRE, "agent");
            asm volatile("s_waitcnt vmcnt(0)" ::: "memory");
        }
    }
    __syncthreads();
}
#define GEMM_PHASE(EPI, e, Aptr, Bptr, Mrows, Ncols, Kdim) do { pg8::Gemm g_{(const bf16_t*)(Aptr), (const bf16_t*)(Bptr), (Mrows), (Ncols), (Kdim)}; pg8::StaticOrder S_; S_.init((Mrows), (Ncols), (int)gridDim.x, (int)blockIdx.x); \
    pg8::gemm_phase<EPI, pg8::StaticOrder, true, true>((PG8_LAS unsigned char*)smem, g_, S_, e); } while (0)

__global__ void __launch_bounds__(512, 2) mk_fwd(Args A) {
    extern __shared__ __attribute__((aligned(16))) unsigned char smem[];
    unsigned char* ws = A.ws;
    const int lo = A.ph_lo, hi = A.ph_hi;
    volatile LAS unsigned* xst = (volatile LAS unsigned*)((LAS unsigned char*)smem + LDS_CTL + 64);
    if (threadIdx.x < 2) xst[threadIdx.x] = 0u;
    __syncthreads();
    const XcdBarrier xbar = xcd_barrier_post((unsigned*)(ws + OFF_BAR), xst);
#ifndef PHMASK
#define PHMASK 0xFFFFF
#endif
#define IN(k) (((PHMASK >> (k)) & 1) && lo <= (k) && (k) < hi)
#if MK_COOP
#define SEAM(k) do { if (IN(k) && IN((k) + 1)) { if ((k) == 0) cg::this_grid().sync(); else xcd_barrier(xbar); } } while (0)
#else
#define SEAM(k) do { } while (0)
#endif
#ifdef PROBE_PHASE
    unsigned long long pt0 = 0, pt1 = 0;
#define PSTAMP(k) do { if ((k) == PROBE_PHASE) pt0 = __builtin_amdgcn_s_memrealtime(); if ((k) == PROBE_PHASE + 1) pt1 = __builtin_amdgcn_s_memrealtime(); } while (0)
#else
#define PSTAMP(k) do { } while (0)
#endif
    float* ssq0 = (float*)(ws + OFF_SSQ0); float* ssq1 = (float*)(ws + OFF_SSQ1); float* ssq2 = (float*)(ws + OFF_SSQ2); float* ssq3 = (float*)(ws + OFF_SSQ3); float* ssqY = (float*)(ws + OFF_SSQY);
    bf16_t* h1b = (bf16_t*)(ws + OFF_H1B); bf16_t* delta = (bf16_t*)(ws + OFF_DELTA);
    PSTAMP(0);
    if (IN(0)) { p0_prologue(A, smem); }
    SEAM(0);
    PSTAMP(1);
    if (IN(1)) { EpiSwiGLU e{(bf16_t*)(ws + OFF_ACT), ssq0}; GEMM_PHASE(EpiSwiGLU, e, A.out, ws + OFF_W1, MP, 5632, DM); }
    SEAM(1);
    PSTAMP(2);
    if (IN(2)) { EpiResid e{A.in[0], nullptr, A.in[1], nullptr, h1b, delta, ssq1, 0.5f}; GEMM_PHASE(EpiResid, e, ws + OFF_ACT, ws + OFF_WD1, MP, DM, DFF); }
    SEAM(2);
    PSTAMP(3);
    if (IN(3)) { EpiRet e{ssq1, (const float2*)(ws + OFF_TAB256), (bf16_t*)(ws + OFF_RQ), (bf16_t*)(ws + OFF_RKS), (bf16_t*)(ws + OFF_RVT)}; GEMM_PHASE(EpiRet, e, h1b, ws + OFF_WINA, MP, 4096, DM); }
    SEAM(3);
    PSTAMP(4);
    if (IN(4)) { retention_phase(A, smem); }
    SEAM(4);
    PSTAMP(5);
    if (IN(5)) { EpiAtt e{ssq1, (const float2*)(ws + OFF_TAB128), (const float2*)(ws + OFF_TAB64), ssqY, (bf16_t*)(ws + OFF_AQ), (bf16_t*)(ws + OFF_AKS), (bf16_t*)(ws + OFF_AVT),
                          (bf16_t*)(ws + OFF_IQ), (bf16_t*)(ws + OFF_IK), (float*)(ws + OFF_IW), (bf16_t*)A.out};
                 GEMM_PHASE(EpiAtt, e, h1b, ws + OFF_WINB, MP, 5888, DM); }
    SEAM(5);
    PSTAMP(6);
    if (IN(6)) { indexer_phase(A, smem); }
    SEAM(6);
    PSTAMP(7);
    if (IN(7)) { attention_phase(A, smem); }
    SEAM(7);
    PSTAMP(8);
    if (IN(8)) { { EpiPlain e{(bf16_t*)(ws + OFF_YR)}; GEMM_PHASE(EpiPlain, e, A.out, ws + OFF_WRO, MR, DM, 2048); }
                 { EpiPlain e{(bf16_t*)(ws + OFF_YA)}; GEMM_PHASE(EpiPlain, e, ws + OFF_AQ, ws + OFF_WAO, MR, DM, DM); } }
    SEAM(8);
    PSTAMP(9);
    if (IN(9)) { EpiGate e{ssq1, (bf16_t*)(ws + OFF_YR), (const bf16_t*)(ws + OFF_YA)}; GEMM_PHASE(EpiGate, e, h1b, ws + OFF_WINC, MR, 2048, DM); }
    SEAM(9);
    PSTAMP(10);
    if (IN(10)) { EpiResid e{A.in[0], delta, nullptr, A.out, h1b, nullptr, ssq2, 1.0f}; GEMM_PHASE(EpiResid, e, ws + OFF_YR, ws + OFF_WMX, MR, DM, DM); }
    SEAM(10);
    PSTAMP(11);
    if (IN(11)) { EpiSwiGLU e{(bf16_t*)(ws + OFF_ACT2), ssq2}; GEMM_PHASE(EpiSwiGLU, e, h1b, ws + OFF_W2, MR, 5632, DM); }
    SEAM(11);
    PSTAMP(12);
    if (IN(12)) { EpiResid e{A.out, nullptr, nullptr, A.out, nullptr, nullptr, ssq3, 0.5f}; GEMM_PHASE(EpiResid, e, ws + OFF_ACT2, ws + OFF_WD2, MR, DM, DFF); }
    SEAM(12);
    PSTAMP(13);
    if (IN(13)) {
        const float* gf = A.in[15];
        const int lane = threadIdx.x & 63, wave = threadIdx.x >> 6;
        for (int row = blockIdx.x * 8 + wave; row < MR; row += gridDim.x * 8) {
            const float r = rstd1024(ssq3, row);
            float4* p = (float4*)(A.out + (size_t)row * DM);
#ifdef PROBE_PHASE
            const float pd = 0.08f * sqrtf((float)(pt1 - pt0) * 1e-5f);
#endif
#pragma unroll
            for (int j = 0; j < 4; ++j) { float4 v = p[lane + 64 * j]; const float4 g = ((const float4*)gf)[lane + 64 * j];
                v.x *= r * g.x; v.y *= r * g.y; v.z *= r * g.z; v.w *= r * g.w;
#ifdef PROBE_PHASE
                if (j == 0 && lane == 0) v.x += pd;
#endif
                p[lane + 64 * j] = v; }
        }
    }
}
constexpr int NPHASE = 14;

extern "C" void kernel_launch(void* const* d_in, const int* in_sizes, int n_in, void* d_out, int out_size, void* d_ws, size_t ws_size, hipStream_t stream) {
    static int grid = 0;
    if (grid == 0) {
        if (n_in != 16 || out_size != MR * DM || ws_size < 256 * MiB) { fprintf(stderr, "kernel_launch: unexpected problem (n_in %d out %d ws %zu)\n", n_in, out_size, ws_size); grid = -1; return; }
        int dev = 0, cus = 0, per_cu = 0;
        hipGetDevice(&dev); hipDeviceGetAttribute(&cus, hipDeviceAttributeMultiprocessorCount, dev);
        if (hipFuncSetAttribute((const void*)mk_fwd, hipFuncAttributeMaxDynamicSharedMemorySize, LDS_BYTES) != hipSuccess) { fprintf(stderr, "kernel_launch: hipFuncSetAttribute failed\n"); grid = -1; return; }
        hipOccupancyMaxActiveBlocksPerMultiprocessor(&per_cu, (const void*)mk_fwd, 512, LDS_BYTES);
        (void)hipGetLastError();
        if (per_cu < 1) per_cu = 1;
        grid = cus * 1;
        fprintf(stderr, "kernel_launch: cus %d per_cu %d grid %d\n", cus, per_cu, grid);
    }
    if (grid < 0) return;
    Args a{};
    for (int i = 0; i < 16; ++i) a.in[i] = (const float*)d_in[i];
    a.out = (float*)d_out; a.ws = (unsigned char*)d_ws;
    for (int h = 0; h < 4; ++h) a.l2g[h] = (float)(std::log1p(-std::ldexp(1.0, -5 - h)) / std::log(2.0));
#if MK_COOP
    if (hipMemsetAsync((char*)d_ws + OFF_BAR, 0, 16384, stream) != hipSuccess) { fprintf(stderr, "kernel_launch: memset failed\n"); return; }
    a.ph_lo = 0; a.ph_hi = NPHASE;
    void* args[] = {&a};
    hipError_t e = hipLaunchCooperativeKernel((const void*)mk_fwd, dim3(grid), dim3(512), args, LDS_BYTES, stream);
    if (e != hipSuccess) fprintf(stderr, "cooperative launch failed: %s (grid %d)\n", hipGetErrorString(e), grid);
#else
    for (int p = 0; p < NPHASE; ++p) { a.ph_lo = p; a.ph_hi = p + 1; hipLaunchKernelGGL(mk_fwd, dim3(grid), dim3(512), LDS_BYTES, stream, a); }
#endif
}
```

```cpp
#include <hip/hip_runtime.h>
#include <hip/hip_cooperative_groups.h>
#include <cstdio>
#include <cstdint>
#include <cmath>
namespace cg = cooperative_groups;
namespace pg8 {
#define PG8_LAS __attribute__((address_space(3)))
typedef unsigned short bf16_t;
typedef short bf16x8 __attribute__((ext_vector_type(8)));
typedef float f32x4 __attribute__((ext_vector_type(4)));
typedef unsigned u32x4 __attribute__((ext_vector_type(4)));
constexpr int BM = 256, BK = 64, HALF = 128, HTB = HALF * BK * 2  , STAGE_BYTES = 8 * HTB, NXCD = 8, WGM = 8;

__host__ __device__ __forceinline__ int lds_byte(int r, int c) { const int st = (r >> 4) * 2 + (c >> 5), rr = r & 15, cc = c & 31, ob = rr * 64 + cc * 2; return st * 1024 + (ob ^ (((ob >> 9) & 1) << 5)); }
__host__ __device__ __forceinline__ void stage_rc(int b, int& R, int& C) { const int st = b / 1024, sb = b % 1024, swz = sb ^ (((sb >> 9) & 1) << 5); R = (st >> 1) * 16 + swz / 64; C = (st & 1) * 32 + (swz % 64) / 2; }
__host__ __device__ __forceinline__ int perm32(int rho) { const int n = rho >> 4, i = rho & 15; return 8 * (i >> 2) + 4 * n + (i & 3); }

struct Unit { int pm, pn; };
struct Gemm { const bf16_t* A; const bf16_t* Bt; int M, N, K; };

struct StaticOrder {
    int nM, nN, nwg, G, c;
    __host__ __device__ void init(int M, int N, int G_, int c_) { nM = M / BM; nN = N / BM; nwg = nM * nN; G = G_; c = c_; }
    __host__ __device__ bool next(int i, Unit& u) const {
        const long L = (long)i * G + c; if (L >= nwg) return false;
        int wgid = (int)L; { const int q = nwg / NXCD, r = nwg % NXCD, xcd = wgid % NXCD, off = wgid / NXCD; wgid = (xcd < r ? xcd * (q + 1) : r * (q + 1) + (xcd - r) * q) + off; }
        const int nig = WGM * nN, gid = wgid / nig, fm = gid * WGM, gsz = (nM - fm) < WGM ? (nM - fm) : WGM;
        u.pm = fm + ((wgid % nig) % gsz); u.pn = (wgid % nig) / gsz; return true;
    }
    __device__ __forceinline__ void a_ready(const Unit&) const {}
    __device__ __forceinline__ void done(const Unit&) const {}
};

__device__ __forceinline__ unsigned cvt_pk_bf16(float lo, float hi) { unsigned r; asm volatile("v_cvt_pk_bf16_f32 %0, %1, %2" : "=v"(r) : "v"(lo), "v"(hi)); return r; }

template <class Epi, class Sched, bool ALIGN_EPI = false, bool SP2 = false>
__device__ __forceinline__ void gemm_phase(PG8_LAS unsigned char* lds, const Gemm g, const Sched& S, const Epi& E) {
    const int tid = threadIdx.x, wid = __builtin_amdgcn_readfirstlane(tid >> 6), lane = tid & 63, wr = wid >> 2, wc = wid & 3, fr = lane & 15, fq = lane >> 4;
    const int K = g.K, nt = K / BK;
    unsigned voffA[2], voffB[2];
#pragma unroll
    for (int i = 0; i < 2; ++i) { int R, C; stage_rc(tid * 16 + i * 8192, R, C); const int Rb = Epi::PERM ? ((R & ~31) + perm32(R & 31)) : R;
        voffA[i] = (unsigned)(R * K + C) * 2u; voffB[i] = (unsigned)(Rb * K + C) * 2u; }
    const size_t kstep = (size_t)(BK * 2);
    const size_t hstep = (size_t)HALF * K * 2;
    const size_t tstep = 2 * hstep;
    const unsigned ldsw = (unsigned)wid * 1024u;
    const int aoff = lds_byte(wr * 64 + fr, fq * 8), boff = lds_byte(wc * 32 + fr, fq * 8);
#define PG8_SA(b, h) (((b) * 2 + (h)) * HTB)
#define PG8_SB(b, h) ((4 + (b) * 2 + (h)) * HTB)
#define PG8_STAGE(bufoff, gbase, voff) do { _Pragma("unroll") for (int _i = 0; _i < 2; ++_i) \
        __builtin_amdgcn_global_load_lds((const unsigned*)((const char*)(gbase) + (voff)[_i]), (PG8_LAS unsigned*)(lds + (bufoff) + ldsw + _i * 8192), 16, 0, 0); } while (0)
#define PG8_LDA(dst, b, h) do { _Pragma("unroll") for (int m = 0; m < 4; ++m) _Pragma("unroll") for (int k = 0; k < 2; ++k) dst[m][k] = *(const PG8_LAS bf16x8*)(lds + PG8_SA(b, h) + aoff + m * 2048 + k * 1024); } while (0)
#define PG8_LDB(dst, b, h) do { _Pragma("unroll") for (int n = 0; n < 2; ++n) _Pragma("unroll") for (int k = 0; k < 2; ++k) dst[n][k] = *(const PG8_LAS bf16x8*)(lds + PG8_SB(b, h) + boff + n * 2048 + k * 1024); } while (0)
#define PG8_MMA(ai, bj, At, Bt) do { __builtin_amdgcn_s_setprio(1); _Pragma("unroll") for (int m = 0; m < 4; ++m) _Pragma("unroll") for (int n = 0; n < 2; ++n) _Pragma("unroll") for (int k = 0; k < 2; ++k) \
        acc[ai][bj][m][n] = __builtin_amdgcn_mfma_f32_16x16x32_bf16(Bt[n][k], At[m][k], acc[ai][bj][m][n], 0, 0, 0); __builtin_amdgcn_s_setprio(0); } while (0)
#define PG8_WAIT_V(n) asm volatile("s_waitcnt vmcnt(" #n ")" ::: "memory")
#define PG8_WAIT_L(n) asm volatile("s_waitcnt lgkmcnt(" #n ")" ::: "memory")
#define PG8_BAR __builtin_amdgcn_s_barrier()
#define PG8_SCHED __builtin_amdgcn_sched_barrier(0)
    Unit cur, nxt; int ui = 0;
    if (!S.next(0, cur)) return;
    f32x4 acc[2][2][4][2];
#pragma unroll
    for (int a = 0; a < 2; ++a)
#pragma unroll
        for (int b = 0; b < 2; ++b)
#pragma unroll
            for (int m = 0; m < 4; ++m)
#pragma unroll
                for (int n = 0; n < 2; ++n) acc[a][b][m][n] = (f32x4){0.f, 0.f, 0.f, 0.f};
    bf16x8 At[4][2], B0[2][2], B1[2][2];
    const char* cA = (const char*)g.A + (size_t)cur.pm * tstep; const char* cB = (const char*)g.Bt + (size_t)cur.pn * tstep;
    S.a_ready(cur);
    if constexpr (SP2) {
        PG8_STAGE(PG8_SB(0, 0), cB, voffB); PG8_STAGE(PG8_SB(0, 1), cB + hstep, voffB); PG8_STAGE(PG8_SA(0, 0), cA, voffA); PG8_STAGE(PG8_SA(0, 1), cA + hstep, voffA);
        if (wr == 1) PG8_BAR;
        PG8_WAIT_V(2); PG8_BAR;
        PG8_STAGE(PG8_SB(1, 0), cB + kstep, voffB); PG8_STAGE(PG8_SA(1, 0), cA + kstep, voffA); PG8_STAGE(PG8_SB(1, 1), cB + hstep + kstep, voffB);
        PG8_WAIT_V(6); PG8_BAR;
    } else {
        PG8_STAGE(PG8_SB(0, 0), cB, voffB); PG8_STAGE(PG8_SA(0, 0), cA, voffA); PG8_STAGE(PG8_SB(0, 1), cB + hstep, voffB); PG8_STAGE(PG8_SA(0, 1), cA + hstep, voffA);
        if (wr == 1) PG8_BAR;
        PG8_WAIT_V(4); PG8_BAR;
        PG8_STAGE(PG8_SB(1, 0), cB + kstep, voffB); PG8_STAGE(PG8_SA(1, 0), cA + kstep, voffA); PG8_STAGE(PG8_SB(1, 1), cB + hstep + kstep, voffB);
        PG8_WAIT_V(6); PG8_BAR;
    }
    for (;;) {
        const bool has_next = S.next(ui + 1, nxt);
        const char* nA = has_next ? (const char*)g.A + (size_t)nxt.pm * tstep : cA; const char* nB = has_next ? (const char*)g.Bt + (size_t)nxt.pn * tstep : cB;
        for (int t = 0; t < nt; t += 2) {
            const bool last = (t == nt - 2);
            const char* a1 = cA + (size_t)(t + 1) * kstep;
            const char* a2 = last ? nA : cA + (size_t)(t + 2) * kstep; const char* b2 = last ? nB : cB + (size_t)(t + 2) * kstep;
            const char* a3 = a2 + kstep; const char* b3 = b2 + kstep;
            if (last && has_next) S.a_ready(nxt);
            if constexpr (SP2) {
            PG8_LDB(B0, 0, 0); PG8_LDB(B1, 0, 1); PG8_SCHED; PG8_LDA(At, 0, 0); PG8_STAGE(PG8_SA(1, 1), a1 + hstep, voffA);
            PG8_WAIT_V(8); PG8_WAIT_L(0); PG8_BAR; PG8_MMA(0, 0, At, B0); PG8_MMA(0, 1, At, B1); PG8_BAR; PG8_SCHED;
            PG8_LDA(At, 0, 1); PG8_STAGE(PG8_SB(0, 0), b2, voffB); PG8_STAGE(PG8_SB(0, 1), b2 + hstep, voffB); PG8_STAGE(PG8_SA(0, 0), a2, voffA);
            PG8_WAIT_V(8); PG8_WAIT_L(0); PG8_BAR; PG8_MMA(1, 0, At, B0); PG8_MMA(1, 1, At, B1); PG8_BAR; PG8_SCHED;
            PG8_LDB(B0, 1, 0); PG8_LDB(B1, 1, 1); PG8_SCHED; PG8_LDA(At, 1, 0); PG8_STAGE(PG8_SA(0, 1), a2 + hstep, voffA);
            PG8_WAIT_V(8); PG8_WAIT_L(0); PG8_BAR; PG8_MMA(0, 0, At, B0); PG8_MMA(0, 1, At, B1); PG8_BAR; PG8_SCHED;
            PG8_LDA(At, 1, 1); PG8_STAGE(PG8_SB(1, 0), b3, voffB); PG8_STAGE(PG8_SB(1, 1), b3 + hstep, voffB); PG8_STAGE(PG8_SA(1, 0), a3, voffA);
            PG8_WAIT_V(8); PG8_WAIT_L(0); PG8_BAR; PG8_MMA(1, 0, At, B0); PG8_MMA(1, 1, At, B1); PG8_BAR; PG8_SCHED;
            } else {
            PG8_LDB(B0, 0, 0); PG8_SCHED; PG8_LDA(At, 0, 0); PG8_STAGE(PG8_SA(1, 1), a1 + hstep, voffA);
            PG8_WAIT_L(8); PG8_BAR; PG8_WAIT_L(0); PG8_MMA(0, 0, At, B0); PG8_BAR; PG8_SCHED;
            PG8_LDB(B1, 0, 1); PG8_STAGE(PG8_SB(0, 0), b2, voffB);
            PG8_BAR; PG8_WAIT_L(0); PG8_MMA(0, 1, At, B1); PG8_BAR;
            PG8_LDA(At, 0, 1); PG8_STAGE(PG8_SA(0, 0), a2, voffA);
            PG8_BAR; PG8_WAIT_L(0); PG8_MMA(1, 0, At, B0); PG8_BAR; PG8_SCHED;
            PG8_STAGE(PG8_SB(0, 1), b2 + hstep, voffB);
            PG8_WAIT_V(6); PG8_BAR; PG8_MMA(1, 1, At, B1); PG8_BAR;
            PG8_LDB(B0, 1, 0); PG8_SCHED; PG8_LDA(At, 1, 0); PG8_STAGE(PG8_SA(0, 1), a2 + hstep, voffA);
            PG8_WAIT_L(8); PG8_BAR; PG8_WAIT_L(0); PG8_MMA(0, 0, At, B0); PG8_BAR; PG8_SCHED;
            PG8_LDB(B1, 1, 1); PG8_STAGE(PG8_SB(1, 0), b3, voffB);
            PG8_BAR; PG8_WAIT_L(0); PG8_MMA(0, 1, At, B1); PG8_BAR;
            PG8_LDA(At, 1, 1); PG8_STAGE(PG8_SA(1, 0), a3, voffA);
            PG8_BAR; PG8_WAIT_L(0); PG8_MMA(1, 0, At, B0); PG8_BAR; PG8_SCHED;
            PG8_STAGE(PG8_SB(1, 1), b3 + hstep, voffB);
            PG8_WAIT_V(6); PG8_BAR; PG8_MMA(1, 1, At, B1); PG8_BAR;
            }
        }
        if constexpr (ALIGN_EPI) { if (wr == 0) PG8_BAR; }
        if constexpr (!Epi::AFTER_DRAIN) { E(acc, cur, wr, wc, fr, fq); S.done(cur); }
        if (!has_next) break;
#pragma unroll
        for (int a = 0; a < 2; ++a)
#pragma unroll
            for (int b = 0; b < 2; ++b)
#pragma unroll
                for (int m = 0; m < 4; ++m)
#pragma unroll
                    for (int n = 0; n < 2; ++n) acc[a][b][m][n] = (f32x4){0.f, 0.f, 0.f, 0.f};
        cur = nxt; cA = nA; cB = nB; ++ui;
        if constexpr (ALIGN_EPI) { if (wr == 1) PG8_BAR; }
    }
    PG8_WAIT_V(0);
    if constexpr (!ALIGN_EPI) { if (wr == 0) PG8_BAR; }
    PG8_BAR;
    if constexpr (Epi::AFTER_DRAIN) { E.fused(acc, cur, wr, wc, fr, fq, lds, wid, lane); S.done(cur); }
#undef PG8_SA
#undef PG8_SB
#undef PG8_STAGE
#undef PG8_LDA
#undef PG8_LDB
#undef PG8_MMA
#undef PG8_WAIT_V
#undef PG8_WAIT_L
#undef PG8_BAR
#undef PG8_SCHED
}
}
#ifndef MK_COOP
#define MK_COOP 1
#endif
using pg8::bf16_t; using pg8::bf16x8; using pg8::f32x4; using pg8::cvt_pk_bf16;
typedef short bf16x4 __attribute__((ext_vector_type(4)));
typedef unsigned long long u64;
typedef unsigned u32x2 __attribute__((ext_vector_type(2)));

constexpr int NB = 8, SEQ = 2048, NMETA = 16, TT = 2112, TP = 2112, DM = 1024, DFF = 2816;
constexpr int SPOS0 = 48;
constexpr int MR = NB * SEQ;
constexpr int MP = MR + 256;
constexpr int DIN = 11848;
constexpr int O_RQ = 0, O_RK = 1024, O_RV = 2048, O_RG = 4096, O_AQ = 6144, O_AK = 7168, O_AV = 8192, O_IQ = 9216, O_IK = 9728, O_IW = 9792, O_GR = 9800, O_GA = 10824;
constexpr float EPSN = 1e-6f;
constexpr size_t MiB = 1u << 20;
constexpr size_t WS_ZERO = 0;
constexpr size_t OFF_CTR = 0;
constexpr size_t OFF_SSQ1 = 4096;
constexpr size_t OFF_SSQ2 = OFF_SSQ1 + MP * 4;
constexpr size_t OFF_SSQ3 = OFF_SSQ2 + MR * 4;
constexpr size_t OFF_SSQY = OFF_SSQ3 + MR * 4;
constexpr size_t ZERO_BYTES = OFF_SSQY + (size_t)MR * 16;
constexpr size_t OFF_SSQ0 = 512 * 1024;
constexpr size_t OFF_BAR = 768 * 1024;
constexpr size_t OFF_IW = 1 * MiB;
constexpr size_t OFF_TAB256 = 2 * MiB;
constexpr size_t OFF_TAB128 = OFF_TAB256 + (size_t)2064 * 128 * 8;
constexpr size_t OFF_TAB64 = OFF_TAB128 + (size_t)2064 * 64 * 8;
constexpr size_t OFF_MASK = 6 * MiB;
constexpr size_t OFF_WINA = 11 * MiB;
constexpr size_t OFF_WINB = 19 * MiB;
constexpr size_t OFF_WINC = OFF_WINB + (size_t)5888 * 1024 * 2;
constexpr size_t OFF_WRO = OFF_WINC + 4 * MiB;
constexpr size_t OFF_WAO = OFF_WRO + 4 * MiB;
constexpr size_t OFF_WMX = OFF_WAO + 2 * MiB;
constexpr size_t OFF_W2 = OFF_WMX + 2 * MiB;
constexpr size_t OFF_WD2 = OFF_W2 + 11 * MiB;
constexpr size_t OFF_H1B = 59 * MiB;
constexpr size_t OFF_DELTA = OFF_H1B + (size_t)MP * 1024 * 2;
constexpr size_t OFF_R = OFF_DELTA + 32 * MiB;
constexpr size_t OFF_W1 = OFF_R;
constexpr size_t OFF_WD1 = OFF_R + 11 * MiB;
constexpr size_t OFF_ACT = OFF_R + 16 * MiB + MiB / 2;
constexpr size_t OFF_RQ = OFF_R;
constexpr size_t OFF_RKS = OFF_R + 32 * MiB;
constexpr size_t OFF_RVT = OFF_R + 65 * MiB;
constexpr size_t OFF_AQ = OFF_R;
constexpr size_t OFF_AKS = OFF_R + 32 * MiB;
constexpr size_t OFF_AVT = OFF_R + 65 * MiB;
constexpr size_t OFF_IQ = OFF_R + 98 * MiB;
constexpr size_t OFF_IK = OFF_R + 114 * MiB;
constexpr size_t OFF_YR = OFF_R + 32 * MiB;
constexpr size_t OFF_YA = OFF_R + 65 * MiB;
constexpr size_t OFF_ACT2 = OFF_R;
static_assert(OFF_ACT + (size_t)MP * DFF * 2 <= 256 * MiB && OFF_RVT + (size_t)8 * 4 * 512 * TP * 2 <= 256 * MiB && OFF_IK + 2 * MiB <= 256 * MiB, "ws map");
static_assert(OFF_WD2 + (size_t)1024 * 2816 * 2 <= OFF_H1B && OFF_MASK + (size_t)MR * 66 * 4 <= OFF_WINA && OFF_TAB64 + (size_t)2064 * 32 * 8 <= OFF_MASK && ZERO_BYTES <= OFF_SSQ0, "ws map 2");
constexpr int LDS_BYTES = 135168 + 1024;
constexpr int LDS_CTL = 135168;

struct Args {
    const float* in[16]; float* out; unsigned char* ws; float l2g[4]; int ph_lo, ph_hi;
};
static_assert(sizeof(Args) == 16 * 8 + 16 + 16 + 8, "Args has no padding");

__device__ __forceinline__ float wave_sum(float v) {
#pragma unroll
    for (int o = 1; o < 64; o <<= 1) v += __shfl_xor(v, o);
    return v;
}
__device__ __forceinline__ bf16_t f2bf(float v) { return (bf16_t)(cvt_pk_bf16(v, 0.f) & 0xffffu); }
__device__ __forceinline__ float bf2f(unsigned short b) { return __uint_as_float((unsigned)b << 16); }
__device__ __forceinline__ uint2 pack4(float a, float b, float c, float d) { uint2 r; r.x = cvt_pk_bf16(a, b); r.y = cvt_pk_bf16(c, d); return r; }
__device__ __forceinline__ f32x4 unpack4(uint2 v) { f32x4 r; r[0] = __uint_as_float(v.x << 16); r[1] = __uint_as_float(v.x & 0xffff0000u); r[2] = __uint_as_float(v.y << 16); r[3] = __uint_as_float(v.y & 0xffff0000u); return r; }
__device__ __forceinline__ int vpos(int pos) { return (pos & ~31) | (((pos >> 2) & 3) << 3) | (((pos >> 4) & 1) << 2) | (pos & 3); }
__device__ __forceinline__ float silu_f(float x) { return x * __builtin_amdgcn_rcpf(1.f + __expf(-x)); }
__device__ __forceinline__ float sigm_f(float x) { return __builtin_amdgcn_rcpf(1.f + __expf(-x)); }
__device__ __forceinline__ float rstd1024(const float* ssq, int row) { return rsqrtf(ssq[row] * (1.f / 1024.f) + EPSN); }
#define EPI_ROW(ai, m) (u.pm * 256 + (ai) * 128 + wr * 64 + (m) * 16 + fr)
#define EPI_RSTD(ssqp) float rs_[2][4]; { _Pragma("unroll") for (int ai = 0; ai < 2; ++ai) _Pragma("unroll") for (int m = 0; m < 4; ++m) rs_[ai][m] = (ssqp)[EPI_ROW(ai, m)]; \
    _Pragma("unroll") for (int ai = 0; ai < 2; ++ai) _Pragma("unroll") for (int m = 0; m < 4; ++m) rs_[ai][m] = rsqrtf(rs_[ai][m] * (1.f / 1024.f) + EPSN); }

struct EpiSwiGLU {
    static constexpr bool PERM = false, AFTER_DRAIN = false;
    bf16_t* act; const float* ssq;
    __device__ __forceinline__ void operator()(const f32x4 (&acc)[2][2][4][2], const pg8::Unit& u, int wr, int wc, int fr, int fq) const {
        EPI_RSTD(ssq)
#pragma unroll
        for (int ai = 0; ai < 2; ++ai)
#pragma unroll
            for (int m = 0; m < 4; ++m) {
                const int row = EPI_ROW(ai, m); const float r = rs_[ai][m];
#pragma unroll
                for (int bj = 0; bj < 2; ++bj) {
                    const int f0 = u.pn * 128 + bj * 64 + wc * 16 + fq * 4;
                    const f32x4 g = acc[ai][bj][m][0] * r, uu = acc[ai][bj][m][1] * r;
                    *(uint2*)(act + (size_t)row * DFF + f0) = pack4(silu_f(g[0]) * uu[0], silu_f(g[1]) * uu[1], silu_f(g[2]) * uu[2], silu_f(g[3]) * uu[3]);
                }
            }
    }
};

struct EpiResid {
    static constexpr bool PERM = false, AFTER_DRAIN = false;
    const float* resf; const bf16_t* resd; const float* meta; float* outf; bf16_t* outb; bf16_t* outd; float* ssq; float alpha;
    __device__ __forceinline__ void operator()(const f32x4 (&acc)[2][2][4][2], const pg8::Unit& u, int wr, int wc, int fr, int fq) const {
#pragma unroll
        for (int ai = 0; ai < 2; ++ai)
#pragma unroll
            for (int mh = 0; mh < 2; ++mh) {
                f32x4 res[2][2][2]; uint2 rd[2][2][2];
#pragma unroll
                for (int m2 = 0; m2 < 2; ++m2) {
                    const int row = EPI_ROW(ai, 2 * mh + m2);
#pragma unroll
                    for (int bj = 0; bj < 2; ++bj)
#pragma unroll
                        for (int n = 0; n < 2; ++n) {
                            const int c0 = u.pn * 256 + bj * 128 + wc * 32 + n * 16 + fq * 4;
                            res[m2][bj][n] = (f32x4){0.f, 0.f, 0.f, 0.f}; rd[m2][bj][n] = make_uint2(0u, 0u);
                            if (row < MR) { res[m2][bj][n] = *(const f32x4*)(resf + (size_t)row * DM + c0); if (resd) rd[m2][bj][n] = *(const uint2*)(resd + (size_t)row * DM + c0); }
                            else if (meta && row < MR + NMETA) res[m2][bj][n] = *(const f32x4*)(meta + (size_t)(row - MR) * DM + c0);
                        }
                }
#pragma unroll
                for (int m2 = 0; m2 < 2; ++m2) {
                    const int m = 2 * mh + m2; const int row = EPI_ROW(ai, m);
                    float part = 0.f;
#pragma unroll
                    for (int bj = 0; bj < 2; ++bj)
#pragma unroll
                        for (int n = 0; n < 2; ++n) {
                            const int c0 = u.pn * 256 + bj * 128 + wc * 32 + n * 16 + fq * 4;
                            const f32x4 a = acc[ai][bj][m][n] * alpha;
                            const f32x4 h = res[m2][bj][n] + unpack4(rd[m2][bj][n]) + a;
                            part += (h[0] * h[0] + h[1] * h[1]) + (h[2] * h[2] + h[3] * h[3]);
                            if (outf && row < MR) *(f32x4*)(outf + (size_t)row * DM + c0) = h;
                            if (outb) *(uint2*)(outb + (size_t)row * DM + c0) = pack4(h[0], h[1], h[2], h[3]);
                            if (outd && row < MR) *(uint2*)(outd + (size_t)row * DM + c0) = pack4(a[0], a[1], a[2], a[3]);
                        }
                    part += __shfl_xor(part, 16); part += __shfl_xor(part, 32);
                    if (fq == 0) atomicAdd(ssq + row, part);
                }
            }
    }
};

__device__ __forceinline__ void rope4(const f32x4 x1, const f32x4 x2, const float4 t0, const float4 t1, uint2& o1, uint2& o2) {
    o1 = pack4(x1[0] * t0.x - x2[0] * t0.y, x1[1] * t0.z - x2[1] * t0.w, x1[2] * t1.x - x2[2] * t1.y, x1[3] * t1.z - x2[3] * t1.w);
    o2 = pack4(x2[0] * t0.x + x1[0] * t0.y, x2[1] * t0.z + x1[1] * t0.w, x2[2] * t1.x + x1[2] * t1.y, x2[3] * t1.z + x1[3] * t1.w);
}

struct EpiRet {
    static constexpr bool PERM = false, AFTER_DRAIN = false;
    const float* ssq1; const float2* tab256; bf16_t* RQ; bf16_t* RKs; bf16_t* RVt;
    __device__ __forceinline__ void operator()(const f32x4 (&acc)[2][2][4][2], const pg8::Unit& u, int wr, int wc, int fr, int fq) const {
        EPI_RSTD(ssq1)
        if (u.pn < 8) {
            const int head = u.pn & 3; const float sc = u.pn < 4 ? 1.f : 0.0625f;
#pragma unroll
            for (int ai = 0; ai < 2; ++ai)
#pragma unroll
                for (int mh = 0; mh < 2; ++mh) {
                    float4 tb[2][2][2];
#pragma unroll
                    for (int m2 = 0; m2 < 2; ++m2) {
                        const int row = EPI_ROW(ai, 2 * mh + m2); const int pos = row < MR ? NMETA + (row & 2047) : (row < MR + NMETA ? row - MR : 0);
#pragma unroll
                        for (int bj = 0; bj < 2; ++bj) { const float4* tp = (const float4*)(tab256 + (size_t)pos * 128 + 16 * (4 * bj + wc) + 4 * fq); tb[m2][bj][0] = tp[0]; tb[m2][bj][1] = tp[1]; }
                    }
#pragma unroll
                    for (int m2 = 0; m2 < 2; ++m2) {
                        const int m = 2 * mh + m2; const int row = EPI_ROW(ai, m);
                        const bool real = row < MR; const int b = row >> 11; const int pos = real ? NMETA + (row & 2047) : row - MR;
                        if (row < MR + NMETA && (u.pn >= 4 || real)) {
                            const float r = rs_[ai][m] * sc;
#pragma unroll
                            for (int bj = 0; bj < 2; ++bj) {
                                const int jj0 = 16 * (4 * bj + wc) + 4 * fq; uint2 o1, o2;
                                rope4(acc[ai][bj][m][0] * r, acc[ai][bj][m][1] * r, tb[m2][bj][0], tb[m2][bj][1], o1, o2);
                                if (u.pn < 4) { bf16_t* d = RQ + (size_t)row * 1024 + head * 256 + jj0; *(uint2*)d = o1; *(uint2*)(d + 128) = o2; }
                                else if (real) { bf16_t* d = RKs + ((size_t)b * TP + SPOS0 + pos) * 1024 + head * 256 + jj0; *(uint2*)d = o1; *(uint2*)(d + 128) = o2; }
                                else { for (int bb = 0; bb < NB; ++bb) { bf16_t* d = RKs + ((size_t)bb * TP + SPOS0 + pos) * 1024 + head * 256 + jj0; *(uint2*)d = o1; *(uint2*)(d + 128) = o2; } }
                            }
                        }
                    }
                }
        } else {
#pragma unroll
            for (int ai = 0; ai < 2; ++ai)
#pragma unroll
                for (int m = 0; m < 4; ++m) {
                    const int row = EPI_ROW(ai, m);
                    if (row < MR + NMETA) {
                        const bool real = row < MR; const int b = row >> 11; const int pos = real ? NMETA + (row & 2047) : row - MR; const float r = rs_[ai][m];
#pragma unroll
                        for (int bj = 0; bj < 2; ++bj)
#pragma unroll
                            for (int n = 0; n < 2; ++n) {
                                const int cin = (u.pn - 8) * 256 + bj * 128 + wc * 32 + n * 16 + fq * 4; const int head = cin >> 9, dv = cin & 511;
                                const f32x4 v = acc[ai][bj][m][n] * r;
                                const bf16_t v0 = f2bf(v[0]), v1 = f2bf(v[1]), v2 = f2bf(v[2]), v3 = f2bf(v[3]);
                                if (real) { bf16_t* d = RVt + ((size_t)(b * 4 + head) * 512 + dv) * TP + vpos(SPOS0 + pos); d[0] = v0; d[TP] = v1; d[2 * TP] = v2; d[3 * TP] = v3; }
                                else { for (int bb = 0; bb < NB; ++bb) { bf16_t* d = RVt + ((size_t)(bb * 4 + head) * 512 + dv) * TP + vpos(SPOS0 + pos); d[0] = v0; d[TP] = v1; d[2 * TP] = v2; d[3 * TP] = v3; } }
                            }
                    }
                }
        }
    }
};

struct EpiAtt {
    static constexpr bool PERM = false, AFTER_DRAIN = false;
    const float* ssq1; const float2* tab128; const float2* tab64; const float* ssqY;
    bf16_t* AQ; bf16_t* AKs; bf16_t* AVt; bf16_t* IQ; bf16_t* IK; float* IW; bf16_t* Y;
    __device__ __forceinline__ void operator()(const f32x4 (&acc)[2][2][4][2], const pg8::Unit& u, int wr, int wc, int fr, int fq) const {
        EPI_RSTD(ssq1)
        if (u.pn < 8 || u.pn == 12 || u.pn == 13) {
            const bool d128 = u.pn < 8;
#pragma unroll
            for (int ai = 0; ai < 2; ++ai)
#pragma unroll
                for (int mh = 0; mh < 2; ++mh) {
                    float4 tb[2][2];
#pragma unroll
                    for (int m2 = 0; m2 < 2; ++m2) {
                        const int row = EPI_ROW(ai, 2 * mh + m2); const int pos = row < MR ? NMETA + (row & 2047) : (row < MR + NMETA ? row - MR : 0);
                        const float4* tp = d128 ? (const float4*)(tab128 + (size_t)pos * 64 + 16 * wc + 4 * fq) : (const float4*)(tab64 + (size_t)pos * 32 + 16 * (wc & 1) + 4 * fq);
                        tb[m2][0] = tp[0]; tb[m2][1] = tp[1];
                    }
#pragma unroll
                    for (int m2 = 0; m2 < 2; ++m2) {
                        const int m = 2 * mh + m2; const int row = EPI_ROW(ai, m);
                        const bool real = row < MR; const int b = row >> 11; const int pos = real ? NMETA + (row & 2047) : row - MR;
                        if (real || (row < MR + NMETA && u.pn >= 4 && u.pn < 8)) {
                            const float r = rs_[ai][m];
#pragma unroll
                            for (int bj = 0; bj < 2; ++bj) {
                                uint2 o1, o2; rope4(acc[ai][bj][m][0] * r, acc[ai][bj][m][1] * r, tb[m2][0], tb[m2][1], o1, o2);
                                if (d128) {
                                    const int head = 2 * (u.pn & 3) + bj; const int jj0 = 16 * wc + 4 * fq;
                                    if (u.pn < 4) { bf16_t* d = AQ + (size_t)row * 1024 + head * 128 + jj0; *(uint2*)d = o1; *(uint2*)(d + 64) = o2; }
                                    else if (real) { bf16_t* d = AKs + ((size_t)b * TP + SPOS0 + pos) * 1024 + head * 128 + jj0; *(uint2*)d = o1; *(uint2*)(d + 64) = o2; }
                                    else { for (int bb = 0; bb < NB; ++bb) { bf16_t* d = AKs + ((size_t)bb * TP + SPOS0 + pos) * 1024 + head * 128 + jj0; *(uint2*)d = o1; *(uint2*)(d + 64) = o2; } }
                                } else {
                                    const int head = (u.pn - 12) * 4 + 2 * bj + (wc >> 1); const int jj0 = 16 * (wc & 1) + 4 * fq;
                                    bf16_t* d = IQ + (size_t)row * 512 + head * 64 + jj0; *(uint2*)d = o1; *(uint2*)(d + 32) = o2;
                                }
                            }
                        }
                    }
                }
        } else if (u.pn < 12) {
#pragma unroll
            for (int ai = 0; ai < 2; ++ai)
#pragma unroll
                for (int m = 0; m < 4; ++m) {
                    const int row = EPI_ROW(ai, m);
                    if (row < MR + NMETA) {
                        const bool real = row < MR; const int b = row >> 11; const int pos = real ? NMETA + (row & 2047) : row - MR; const float r = rs_[ai][m];
#pragma unroll
                        for (int bj = 0; bj < 2; ++bj)
#pragma unroll
                            for (int n = 0; n < 2; ++n) {
                                const int cin = (u.pn - 8) * 256 + bj * 128 + wc * 32 + n * 16 + fq * 4; const int head = cin >> 7, dd = cin & 127;
                                const f32x4 v = acc[ai][bj][m][n] * r;
                                const bf16_t v0 = f2bf(v[0]), v1 = f2bf(v[1]), v2 = f2bf(v[2]), v3 = f2bf(v[3]);
                                if (real) { bf16_t* d = AVt + ((size_t)(b * 8 + head) * 128 + dd) * TP + vpos(SPOS0 + pos); d[0] = v0; d[TP] = v1; d[2 * TP] = v2; d[3 * TP] = v3; }
                                else { for (int bb = 0; bb < NB; ++bb) { bf16_t* d = AVt + ((size_t)(bb * 8 + head) * 128 + dd) * TP + vpos(SPOS0 + pos); d[0] = v0; d[TP] = v1; d[2 * TP] = v2; d[3 * TP] = v3; } }
                            }
                    }
                }
        } else if (u.pn == 14) {
#pragma unroll
            for (int ai = 0; ai < 2; ++ai) {
                float4 tb[4][2];
                if (wc < 2) {
#pragma unroll
                    for (int m = 0; m < 4; ++m) { const int row = EPI_ROW(ai, m); const int pos = row < MR ? NMETA + (row & 2047) : 0;
                        const float4* tp = (const float4*)(tab64 + (size_t)pos * 32 + 16 * wc + 4 * fq); tb[m][0] = tp[0]; tb[m][1] = tp[1]; }
                }
#pragma unroll
                for (int m = 0; m < 4; ++m) {
                    const int row = EPI_ROW(ai, m);
                    if (row < MR) {
                        const float r = rs_[ai][m];
                        if (wc < 2) {
                            uint2 o1, o2; rope4(acc[ai][0][m][0] * r, acc[ai][0][m][1] * r, tb[m][0], tb[m][1], o1, o2);
                            bf16_t* d = IK + (size_t)row * 64 + 16 * wc + 4 * fq; *(uint2*)d = o1; *(uint2*)(d + 32) = o2;
                        } else if (wc == 2 && fq < 2) {
                            *(f32x4*)(IW + (size_t)row * 8 + 4 * fq) = acc[ai][0][m][0] * r;
                        }
                    }
                }
            }
        } else {
            const int head = (u.pn - 15) >> 1;
#pragma unroll
            for (int ai = 0; ai < 2; ++ai)
#pragma unroll
                for (int mh = 0; mh < 2; ++mh) {
                    uint2 yv[2][2][2]; float ysq[2];
#pragma unroll
                    for (int m2 = 0; m2 < 2; ++m2) {
                        const int row = EPI_ROW(ai, 2 * mh + m2); const int rr = row < MR ? row : 0;
                        ysq[m2] = ssqY[(size_t)rr * 4 + head];
#pragma unroll
                        for (int bj = 0; bj < 2; ++bj)
#pragma unroll
                            for (int n = 0; n < 2; ++n) yv[m2][bj][n] = *(const uint2*)(Y + (size_t)rr * 2048 + (u.pn - 15) * 256 + bj * 128 + wc * 32 + n * 16 + fq * 4);
                    }
#pragma unroll
                    for (int m2 = 0; m2 < 2; ++m2) {
                        const int m = 2 * mh + m2; const int row = EPI_ROW(ai, m);
                        if (row < MR) {
                            const float r = rs_[ai][m]; const float ys = rsqrtf(ysq[m2] * (1.f / 512.f) + EPSN);
#pragma unroll
                            for (int bj = 0; bj < 2; ++bj)
#pragma unroll
                                for (int n = 0; n < 2; ++n) {
                                    const int cin = (u.pn - 15) * 256 + bj * 128 + wc * 32 + n * 16 + fq * 4;
                                    const f32x4 y = unpack4(yv[m2][bj][n]); const f32x4 g = acc[ai][bj][m][n] * r;
                                    *(uint2*)(Y + (size_t)row * 2048 + cin) = pack4(silu_f(g[0]) * y[0] * ys, silu_f(g[1]) * y[1] * ys, silu_f(g[2]) * y[2] * ys, silu_f(g[3]) * y[3] * ys);
                                }
                        }
                    }
                }
        }
    }
};

struct EpiPlain {
    static constexpr bool PERM = false, AFTER_DRAIN = false;
    bf16_t* out;
    __device__ __forceinline__ void operator()(const f32x4 (&acc)[2][2][4][2], const pg8::Unit& u, int wr, int wc, int fr, int fq) const {
#pragma unroll
        for (int ai = 0; ai < 2; ++ai)
#pragma unroll
            for (int m = 0; m < 4; ++m) {
                const int row = EPI_ROW(ai, m);
#pragma unroll
                for (int bj = 0; bj < 2; ++bj)
#pragma unroll
                    for (int n = 0; n < 2; ++n) {
                        const int c0 = u.pn * 256 + bj * 128 + wc * 32 + n * 16 + fq * 4; const f32x4 a = acc[ai][bj][m][n];
                        *(uint2*)(out + (size_t)row * DM + c0) = pack4(a[0], a[1], a[2], a[3]);
                    }
            }
    }
};

struct EpiGate {
    static constexpr bool PERM = false, AFTER_DRAIN = false;
    const float* ssq1; bf16_t* yr; const bf16_t* ya;
    __device__ __forceinline__ void operator()(const f32x4 (&acc)[2][2][4][2], const pg8::Unit& u, int wr, int wc, int fr, int fq) const {
        EPI_RSTD(ssq1)
#pragma unroll
        for (int ai = 0; ai < 2; ++ai) {
            uint2 av[4][2], cv[4][2];
#pragma unroll
            for (int m = 0; m < 4; ++m)
#pragma unroll
                for (int bj = 0; bj < 2; ++bj) { const size_t o = (size_t)EPI_ROW(ai, m) * DM + u.pn * 128 + bj * 64 + wc * 16 + fq * 4; av[m][bj] = *(const uint2*)(yr + o); cv[m][bj] = *(const uint2*)(ya + o); }
#pragma unroll
            for (int m = 0; m < 4; ++m) {
                const float r = rs_[ai][m];
#pragma unroll
                for (int bj = 0; bj < 2; ++bj) {
                    const size_t o = (size_t)EPI_ROW(ai, m) * DM + u.pn * 128 + bj * 64 + wc * 16 + fq * 4;
                    const f32x4 gr = acc[ai][bj][m][0] * r, ga = acc[ai][bj][m][1] * r; const f32x4 a = unpack4(av[m][bj]), c = unpack4(cv[m][bj]);
                    *(uint2*)(yr + o) = pack4(sigm_f(gr[0]) * a[0] + sigm_f(ga[0]) * c[0], sigm_f(gr[1]) * a[1] + sigm_f(ga[1]) * c[1],
                                              sigm_f(gr[2]) * a[2] + sigm_f(ga[2]) * c[2], sigm_f(gr[3]) * a[3] + sigm_f(ga[3]) * c[3]);
                }
            }
        }
    }
};
template <class Map>
__device__ __forceinline__ void convert_w(int K, int N, bf16_t* Wt, int Nd, const float* gain, Map map, unsigned char* smem) {
    bf16_t* tile = (bf16_t*)smem;
    const int tid = threadIdx.x; const int ntk = K / 256, nt = (Nd / 64) * ntk;
    for (int t = blockIdx.x; t < nt; t += gridDim.x) {
        const int n0 = (t / ntk) * 64, k0 = (t % ntk) * 256;
        const int kr = tid >> 4, nq = tid & 15;
        const float* W = nullptr; const int src = map(n0 + 4 * nq, W);
        float4 v[8];
#pragma unroll
        for (int p = 0; p < 8; ++p) { v[p] = make_float4(0.f, 0.f, 0.f, 0.f); if (src >= 0) v[p] = *(const float4*)(W + (size_t)(k0 + kr + 32 * p) * N + src); }
#pragma unroll
        for (int p = 0; p < 8; ++p) {
            const int kl = kr + 32 * p; const float g = gain ? gain[k0 + kl] : 1.f;
            bf16_t* tl = tile + (kl >> 6) * (64 * 72) + (kl & 63);
            tl[(4 * nq + 0) * 72] = f2bf(v[p].x * g); tl[(4 * nq + 1) * 72] = f2bf(v[p].y * g); tl[(4 * nq + 2) * 72] = f2bf(v[p].z * g); tl[(4 * nq + 3) * 72] = f2bf(v[p].w * g);
        }
        __syncthreads();
        const int nl = tid >> 3, kc = tid & 7;
#pragma unroll
        for (int q = 0; q < 4; ++q) *(uint4*)(Wt + (size_t)(n0 + nl) * K + k0 + 64 * q + 8 * kc) = *(const uint4*)(tile + q * (64 * 72) + nl * 72 + 8 * kc);
        __syncthreads();
    }
}
__device__ __forceinline__ int rope_nat(int c, int dbits) {
    const int g = c >> 5, hi = (c >> 4) & 1, i = c & 15; return (hi << (dbits - 1)) + 16 * g + i;
}

__device__ __forceinline__ void p0_prologue(const Args& A, unsigned char* smem) {
    unsigned char* ws = A.ws;
    const int tid = threadIdx.x, lane = tid & 63, wave = tid >> 6;
    const size_t gtid = (size_t)blockIdx.x * 512 + tid, gsz = (size_t)gridDim.x * 512;
    for (size_t i = gtid; i < ZERO_BYTES / 16; i += gsz) ((uint4*)(ws + WS_ZERO))[i] = make_uint4(0, 0, 0, 0);
    {
        bf16_t* xb = (bf16_t*)A.out; float* ssq0 = (float*)(ws + OFF_SSQ0);
        const int gw = blockIdx.x * 8 + wave, ngw = gridDim.x * 8;
        for (int row = gw; row < MP; row += ngw) {
            const float* src = row < MR ? A.in[0] + (size_t)row * DM : (row < MR + NMETA ? A.in[1] + (size_t)(row - MR) * DM : nullptr);
            float s = 0.f;
#pragma unroll
            for (int j = 0; j < 4; ++j) {
                float4 v = make_float4(0.f, 0.f, 0.f, 0.f);
                if (src) v = ((const float4*)src)[lane + 64 * j];
                s += (v.x * v.x + v.y * v.y) + (v.z * v.z + v.w * v.w);
                *(uint2*)(xb + (size_t)row * DM + 4 * (lane + 64 * j)) = pack4(v.x, v.y, v.z, v.w);
            }
            s = wave_sum(s);
            if (lane == 0) ssq0[row] = s;
        }
    }
    {
        float2* t256 = (float2*)(ws + OFF_TAB256); float2* t128 = (float2*)(ws + OFF_TAB128); float2* t64 = (float2*)(ws + OFF_TAB64);
        for (size_t i = gtid; i < (size_t)2064 * 128; i += gsz) {
            const int pos = (int)(i >> 7), j = (int)(i & 127);
            const float inv = exp2f(-(float)j * (13.287712379549449f / 128.f));
            const float ang = (float)pos * inv;
            const double a = (double)ang; const double k = __builtin_rint(a * 0.15915494309189535);
            const double rr = a - k * 6.283185307179586; const double x = rr * 0.25, x2 = x * x;
            double s = x * (1.0 - x2 * (1.0 / 6.0) * (1.0 - x2 * (1.0 / 20.0) * (1.0 - x2 * (1.0 / 42.0) * (1.0 - x2 * (1.0 / 72.0) * (1.0 - x2 * (1.0 / 110.0) * (1.0 - x2 * (1.0 / 156.0)))))));
            double c = 1.0 - x2 * 0.5 * (1.0 - x2 * (1.0 / 12.0) * (1.0 - x2 * (1.0 / 30.0) * (1.0 - x2 * (1.0 / 56.0) * (1.0 - x2 * (1.0 / 90.0) * (1.0 - x2 * (1.0 / 132.0) * (1.0 - x2 * (1.0 / 182.0)))))));
            const double s2 = 2.0 * s * c, c2 = c * c - s * s; const double s4 = 2.0 * s2 * c2, c4 = c2 * c2 - s2 * s2;
            const float2 o = make_float2((float)c4, (float)s4);
            t256[i] = o;
            if ((j & 1) == 0) t128[(size_t)pos * 64 + (j >> 1)] = o;
            if ((j & 3) == 0) t64[(size_t)pos * 32 + (j >> 2)] = o;
        }
    }
    const float* w_in = A.in[7];
    convert_w(DM, DFF, (bf16_t*)(ws + OFF_W1), 5632, A.in[2], [&](int n, const float*& W) { W = ((n >> 4) & 1) ? A.in[4] : A.in[3]; return 16 * (n >> 5) + (n & 15); }, smem);
    convert_w(DFF, DM, (bf16_t*)(ws + OFF_WD1), 1024, nullptr, [&](int n, const float*& W) { W = A.in[5]; return n; }, smem);
    convert_w(DM, DIN, (bf16_t*)(ws + OFF_WINA), 4096, A.in[6], [&](int n, const float*& W) { W = w_in;
        if (n < 2048) return (n < 1024 ? O_RQ : O_RK) + ((n & 1023) >> 8) * 256 + rope_nat(n & 255, 8);
        return O_RV + (n - 2048); }, smem);
    convert_w(DM, DIN, (bf16_t*)(ws + OFF_WINB), 5888, A.in[6], [&](int n, const float*& W) { W = w_in;
        if (n < 2048) return (n < 1024 ? O_AQ : O_AK) + ((n & 1023) >> 7) * 128 + rope_nat(n & 127, 7);
        if (n < 3072) return O_AV + (n - 2048);
        if (n < 3584) return O_IQ + ((n - 3072) >> 6) * 64 + rope_nat((n - 3072) & 63, 6);
        if (n < 3648) return O_IK + rope_nat(n - 3584, 6);
        if (n < 3656) return O_IW + (n - 3648);
        if (n < 3840) return -1;
        return O_RG + (n - 3840); }, smem);
    convert_w(DM, DIN, (bf16_t*)(ws + OFF_WINC), 2048, A.in[6], [&](int n, const float*& W) { W = w_in; return (((n >> 4) & 1) ? O_GA : O_GR) + 16 * (n >> 5) + (n & 15); }, smem);
    convert_w(2048, DM, (bf16_t*)(ws + OFF_WRO), 1024, nullptr, [&](int n, const float*& W) { W = A.in[8]; return n; }, smem);
    convert_w(DM, DM, (bf16_t*)(ws + OFF_WAO), 1024, nullptr, [&](int n, const float*& W) { W = A.in[9]; return n; }, smem);
    convert_w(DM, DM, (bf16_t*)(ws + OFF_WMX), 1024, nullptr, [&](int n, const float*& W) { W = A.in[10]; return n; }, smem);
    convert_w(DM, DFF, (bf16_t*)(ws + OFF_W2), 5632, A.in[11], [&](int n, const float*& W) { W = ((n >> 4) & 1) ? A.in[13] : A.in[12]; return 16 * (n >> 5) + (n & 15); }, smem);
    convert_w(DFF, DM, (bf16_t*)(ws + OFF_WD2), 1024, nullptr, [&](int n, const float*& W) { W = A.in[14]; return n; }, smem);
}

template <int DQK, int DV, int RB, bool SOFTMAX, int NSTG>
__device__ __forceinline__ void flash_unit(const bf16_t* __restrict__ Q, int ldq, const bf16_t* __restrict__ Kb, int ldk, const bf16_t* __restrict__ Vt,
                                           bf16_t* Out, int ldo, int qpos0, int kt_lo, int kt_hi, const u64* __restrict__ mask64, float p0, float* ssqY, unsigned char* smem) {
    constexpr int KCH = DQK / 8, NKD = KCH / 8, NVD = DV / 64, NKS = DQK / 32, NNB = DV / 16;
    constexpr int KBYTES = 64 * DQK * 2, STAGE = KBYTES + DV * 64 * 2;
    const int tid = threadIdx.x, lane = tid & 63, w = __builtin_amdgcn_readfirstlane(tid >> 6), fr = lane & 15, quad = lane >> 4;
    bf16x8 qf[RB][NKS];
#pragma unroll
    for (int rb = 0; rb < RB; ++rb)
#pragma unroll
        for (int ks = 0; ks < NKS; ++ks) qf[rb][ks] = *(const bf16x8*)(Q + (size_t)(w * 16 * RB + rb * 16 + fr) * ldq + ks * 32 + quad * 8);
    f32x4 o[NNB][RB];
#pragma unroll
    for (int nb = 0; nb < NNB; ++nb)
#pragma unroll
        for (int rb = 0; rb < RB; ++rb) o[nb][rb] = (f32x4){0.f, 0.f, 0.f, 0.f};
    float mrun[RB], lrun[RB];
#pragma unroll
    for (int rb = 0; rb < RB; ++rb) { mrun[rb] = -INFINITY; lrun[rb] = 0.f; }
    PG8_LAS unsigned char* lds = (PG8_LAS unsigned char*)smem;
    int koff[4], voff[4];
    float bk[4][4];
#pragma unroll
    for (int kb = 0; kb < 4; ++kb)
#pragma unroll
        for (int j = 0; j < 4; ++j) bk[kb][j] = SOFTMAX ? 1.f : __builtin_amdgcn_exp2f(-(float)(kb * 16 + quad * 4 + j) * p0);
#pragma unroll
    for (int a = 0; a < 4; ++a) { koff[a] = (fr * KCH + ((a * 4) ^ quad ^ fr)) * 16; voff[a] = (fr * 8 + (((a & 1) * 4) ^ quad ^ ((fr >> 1) & 7))) * 16; }
#define FL_DMA(KT, BUF) do { \
    _Pragma("unroll") for (int i = 0; i < NKD; ++i) { const int gi = (i * 8 + w) * 64 + lane, r = gi / KCH, cc = (gi % KCH) ^ (r & 15); int t = 64 * (KT) + r; t = t < TT ? t : TT - 1; \
        __builtin_amdgcn_global_load_lds((const unsigned*)(Kb + (size_t)t * ldk + cc * 8), (PG8_LAS unsigned*)(lds + (BUF) * STAGE + (i * 8 + w) * 1024), 16, 0, 0); } \
    _Pragma("unroll") for (int i = 0; i < NVD; ++i) { const int gi = (i * 8 + w) * 64 + lane, r = gi >> 3, cc = (gi & 7) ^ ((r >> 1) & 7); int t = 64 * (KT) + 8 * cc; t = t < TP ? t : TP - 8; \
        __builtin_amdgcn_global_load_lds((const unsigned*)(Vt + (size_t)r * TP + t), (PG8_LAS unsigned*)(lds + (BUF) * STAGE + KBYTES + (i * 8 + w) * 1024), 16, 0, 0); } } while (0)
    constexpr int NDMA = NKD + NVD;
    PG8_LAS u64* mlds = (PG8_LAS u64*)(lds + NSTG * STAGE);
    if (SOFTMAX) {
        constexpr int NR = 16 * RB * 8;
        for (int i = tid; i < NR * 33; i += 512) { const int r = i / 33, c = i % 33; mlds[c * NR + r] = mask64[(size_t)r * 33 + c]; }
    }
    FL_DMA(kt_lo, 0);
#pragma unroll
    for (int p = 1; p < NSTG - 1; ++p) if (kt_lo + p <= kt_hi) FL_DMA(kt_lo + p, p);
    int cur = 0;
    for (int kt = kt_lo; kt <= kt_hi; ++kt) {
        if (NSTG == 2 || kt + NSTG - 2 > kt_hi) asm volatile("s_waitcnt vmcnt(0)" ::: "memory");
        else if (NSTG == 3) asm volatile("s_waitcnt vmcnt(%0)" :: "n"(NDMA) : "memory");
        else asm volatile("s_waitcnt vmcnt(%0)" :: "n"(2 * NDMA) : "memory");
        __syncthreads();
        { const int nb_ = cur == 0 ? NSTG - 1 : cur - 1; if (kt + NSTG - 1 <= kt_hi) FL_DMA(kt + NSTG - 1, nb_); }
        const PG8_LAS unsigned char* Ks = lds + cur * STAGE; const PG8_LAS unsigned char* Vs = Ks + KBYTES;
        cur = (cur + 1 == NSTG) ? 0 : cur + 1;
        const PG8_LAS unsigned char* kp[4]; const PG8_LAS unsigned char* vp4[4];
#pragma unroll
        for (int a = 0; a < 4; ++a) { kp[a] = Ks + koff[a]; vp4[a] = Vs + voff[a]; }
        u64 mw[RB];
        if (SOFTMAX) {
#pragma unroll
            for (int rb = 0; rb < RB; ++rb) mw[rb] = mlds[kt * (16 * RB * 8) + w * 16 * RB + rb * 16 + fr];
        }
        f32x4 s[4][RB];
#pragma unroll
        for (int kb = 0; kb < 4; ++kb)
#pragma unroll
            for (int rb = 0; rb < RB; ++rb) s[kb][rb] = (f32x4){0.f, 0.f, 0.f, 0.f};
        {
            constexpr int GPK = NKS / 4, NGS = 4 * GPK;
            bf16x8 fg[3][4];
#define FL_LDK(G) do { _Pragma("unroll") for (int q4 = 0; q4 < 4; ++q4) { const int ks_ = ((G) % GPK) * 4 + q4; \
                fg[(G) % 3][q4] = *(const PG8_LAS bf16x8*)(kp[ks_ & 3] + ((G) / GPK) * 16 * KCH * 16 + (ks_ >> 2) * 256); } } while (0)
            FL_LDK(0); if (NGS > 1) FL_LDK(1);
#pragma unroll
            for (int g = 0; g < NGS; ++g) {
                if (g + 2 < NGS) FL_LDK(g + 2);
                __builtin_amdgcn_sched_barrier(0);
#pragma unroll
                for (int q4 = 0; q4 < 4; ++q4)
#pragma unroll
                    for (int rb = 0; rb < RB; ++rb) s[g / GPK][rb] = __builtin_amdgcn_mfma_f32_16x16x32_bf16(fg[g % 3][q4], qf[rb][(g % GPK) * 4 + q4], s[g / GPK][rb], 0, 0, 0);
                __builtin_amdgcn_sched_barrier(0);
            }
        }
        bf16x8 pa[RB][2];
#pragma unroll
        for (int rb = 0; rb < RB; ++rb) {
            const int qpos = qpos0 + w * 16 * RB + rb * 16 + fr;
            float p[4][4];
            if (SOFTMAX) {
                const u64 mq = mw[rb] >> (quad * 4);
                const unsigned mlo = (unsigned)mq, mhi = (unsigned)(mq >> 32);
                float tmax = -INFINITY;
#pragma unroll
                for (int kb = 0; kb < 4; ++kb)
#pragma unroll
                    for (int j = 0; j < 4; ++j) {
                        const unsigned wsel = (kb < 2) ? mlo : mhi; const unsigned bitm = 1u << ((kb & 1) * 16 + j);
                        const float v = (wsel & bitm) ? s[kb][rb][j] : -INFINITY;
                        p[kb][j] = v; tmax = fmaxf(tmax, v);
                    }
                tmax = fmaxf(tmax, __shfl_xor(tmax, 16)); tmax = fmaxf(tmax, __shfl_xor(tmax, 32));
                const float tm = tmax * p0;
                if (__ballot(tm > mrun[rb] + 8.f) != 0ull) {
                    const float mnew = fmaxf(mrun[rb], tm); const float msafe = (mnew == -INFINITY) ? 0.f : mnew;
                    const float alpha = __builtin_amdgcn_exp2f(mrun[rb] - msafe);
                    lrun[rb] *= alpha; mrun[rb] = mnew;
#pragma unroll
                    for (int nb = 0; nb < NNB; ++nb) o[nb][rb] *= alpha;
                }
                const float mref = (mrun[rb] == -INFINITY) ? 0.f : mrun[rb];
                float ps = 0.f;
#pragma unroll
                for (int kb = 0; kb < 4; ++kb)
#pragma unroll
                    for (int j = 0; j < 4; ++j) { const float e = __builtin_amdgcn_exp2f(fmaf(p[kb][j], p0, -mref)); p[kb][j] = e; ps += e; }
                lrun[rb] += ps;
            } else {
                const float aq = __builtin_amdgcn_exp2f((float)(qpos - 64 * kt) * p0);
                if (64 * kt + 63 > qpos0 + w * 16 * RB) {
#pragma unroll
                    for (int kb = 0; kb < 4; ++kb)
#pragma unroll
                        for (int j = 0; j < 4; ++j) { const int kpos = 64 * kt + kb * 16 + quad * 4 + j; p[kb][j] = (kpos <= qpos) ? s[kb][rb][j] * (aq * bk[kb][j]) : 0.f; }
                } else {
#pragma unroll
                    for (int kb = 0; kb < 4; ++kb)
#pragma unroll
                        for (int j = 0; j < 4; ++j) p[kb][j] = s[kb][rb][j] * (aq * bk[kb][j]);
                }
                if (kt == 0) {
#pragma unroll
                    for (int kb = 0; kb < 3; ++kb)
#pragma unroll
                        for (int j = 0; j < 4; ++j) p[kb][j] = 0.f;
                }
            }
#pragma unroll
            for (int i = 0; i < 2; ++i) {
                union { bf16x8 v; unsigned u[4]; } t;
                t.u[0] = cvt_pk_bf16(p[2 * i][0], p[2 * i][1]); t.u[1] = cvt_pk_bf16(p[2 * i][2], p[2 * i][3]);
                t.u[2] = cvt_pk_bf16(p[2 * i + 1][0], p[2 * i + 1][1]); t.u[3] = cvt_pk_bf16(p[2 * i + 1][2], p[2 * i + 1][3]);
                pa[rb][i] = t.v;
            }
        }
        {
            constexpr int GPI = NNB / 4, NGV = 2 * GPI;
            bf16x8 vg[3][4];
#define FL_LDV(G) do { _Pragma("unroll") for (int q4 = 0; q4 < 4; ++q4) { const int nb_ = ((G) % GPI) * 4 + q4, i_ = (G) / GPI; \
                vg[(G) % 3][q4] = *(const PG8_LAS bf16x8*)(vp4[i_] + nb_ * 2048); } } while (0)
            FL_LDV(0); FL_LDV(1);
#pragma unroll
            for (int g = 0; g < NGV; ++g) {
                if (g + 2 < NGV) FL_LDV(g + 2);
                __builtin_amdgcn_sched_barrier(0);
#pragma unroll
                for (int q4 = 0; q4 < 4; ++q4)
#pragma unroll
                    for (int rb = 0; rb < RB; ++rb) o[(g % GPI) * 4 + q4][rb] = __builtin_amdgcn_mfma_f32_16x16x32_bf16(vg[g % 3][q4], pa[rb][g / GPI], o[(g % GPI) * 4 + q4][rb], 0, 0, 0);
                __builtin_amdgcn_sched_barrier(0);
            }
        }
    }
#pragma unroll
    for (int rb = 0; rb < RB; ++rb) {
        const int qrow = w * 16 * RB + rb * 16 + fr;
        float scale = 1.f;
        if (SOFTMAX) { float l = lrun[rb]; l += __shfl_xor(l, 16); l += __shfl_xor(l, 32); scale = 1.f / l; }
        float part = 0.f;
#pragma unroll
        for (int nb = 0; nb < NNB; ++nb) {
            const f32x4 v = o[nb][rb] * scale;
            part += (v[0] * v[0] + v[1] * v[1]) + (v[2] * v[2] + v[3] * v[3]);
            *(uint2*)(Out + (size_t)qrow * ldo + nb * 16 + quad * 4) = pack4(v[0], v[1], v[2], v[3]);
        }
        if (!SOFTMAX) { part += __shfl_xor(part, 16); part += __shfl_xor(part, 32); if (quad == 0) atomicAdd(ssqY + (size_t)qrow * 4, part); }
    }
}

__device__ __forceinline__ unsigned next_unit(unsigned* ctr, unsigned char* smem) {
    volatile unsigned* sh = (volatile unsigned*)(smem + LDS_CTL);
    __syncthreads();
    if (threadIdx.x == 0) *sh = atomicAdd(ctr, 1u);
    __syncthreads();
    return (unsigned)__builtin_amdgcn_readfirstlane((int)*sh);
}

__device__ __forceinline__ void retention_unit(const Args& A, unsigned char* smem, int b, int h, int qb, int dvh) {
    unsigned char* ws = A.ws;
    const bf16_t* RQ = (const bf16_t*)(ws + OFF_RQ); const bf16_t* RKs = (const bf16_t*)(ws + OFF_RKS); const bf16_t* RVt = (const bf16_t*)(ws + OFF_RVT);
    bf16_t* Y = (bf16_t*)A.out; float* ssqY = (float*)(ws + OFF_SSQY);
    const int s0 = 128 * qb, row0 = b * SEQ + s0, qpos0 = SPOS0 + NMETA + s0;
    const float l2g = A.l2g[h]; const int cut = (int)(40.f / -l2g);
    int kt_lo = (qpos0 - cut) / 64; if (qpos0 < cut) kt_lo = 0;
    flash_unit<256, 256, 1, false, 2>(RQ + (size_t)row0 * 1024 + h * 256, 1024, RKs + (size_t)b * TP * 1024 + h * 256, 1024, RVt + ((size_t)(b * 4 + h) * 512 + dvh * 256) * TP,
                                      Y + (size_t)row0 * 2048 + h * 512 + dvh * 256, 2048, qpos0, kt_lo, (qpos0 + 127) / 64, nullptr, l2g, ssqY + (size_t)row0 * 4 + h, smem);
}
__device__ __forceinline__ void retention_phase(const Args& A, unsigned char* smem) {
    if (gridDim.x == 256) {
        const int b = blockIdx.x & 7, c = blockIdx.x >> 3, dvh = c & 1, j = c >> 1;
        for (int r = 0; r < 4; ++r) { __syncthreads(); retention_unit(A, smem, b, 3 - r, (r & 1) ? 15 - j : j, dvh); }
    } else {
        unsigned* ctr = (unsigned*)(A.ws + OFF_CTR) + 0;
        for (;;) { const unsigned u = next_unit(ctr, smem); if (u >= 1024u) break;
            const int rest = (int)(u & 63); retention_unit(A, smem, rest >> 3, (rest >> 1) & 3, 15 - (int)(u >> 6), rest & 1); }
    }
}
__device__ __forceinline__ void attention_unit(const Args& A, unsigned char* smem, int b, int h, int qb) {
    unsigned char* ws = A.ws;
    bf16_t* AQ = (bf16_t*)(ws + OFF_AQ); const bf16_t* AKs = (const bf16_t*)(ws + OFF_AKS); const bf16_t* AVt = (const bf16_t*)(ws + OFF_AVT);
    const u64* mask64 = (const u64*)(ws + OFF_MASK);
    const int s0 = 128 * qb, row0 = b * SEQ + s0, qpos0 = SPOS0 + NMETA + s0;
    flash_unit<128, 128, 1, true, 3>(AQ + (size_t)row0 * 1024 + h * 128, 1024, AKs + (size_t)b * TP * 1024 + h * 128, 1024, AVt + (size_t)(b * 8 + h) * 128 * TP,
                                     AQ + (size_t)row0 * 1024 + h * 128, 1024, qpos0, 0, (qpos0 + 127) / 64, mask64 + (size_t)row0 * 33, 0.08838834764831845f * 1.4426950408889634f, nullptr, smem);
}
__device__ __forceinline__ void attention_phase(const Args& A, unsigned char* smem) {
    if (gridDim.x == 256) {
        const int b = blockIdx.x & 7, c = blockIdx.x >> 3;
        for (int r = 0; r < 4; ++r) { __syncthreads(); attention_unit(A, smem, b, 2 * r + (c >> 4), (r & 1) ? 15 - (c & 15) : (c & 15)); }
    } else {
        unsigned* ctr = (unsigned*)(A.ws + OFF_CTR) + 2;
        for (;;) { const unsigned u = next_unit(ctr, smem); if (u >= 1024u) break;
            const int bh = (int)(u & 63); attention_unit(A, smem, bh >> 3, bh & 7, 15 - (int)(u >> 6)); }
    }
}

__device__ __forceinline__ void cnt_ge_u32(int& c, unsigned a, unsigned b) { asm volatile("v_cmp_ge_u32 vcc, %1, %2\n\tv_addc_co_u32 %0, vcc, 0, %0, vcc" : "+v"(c) : "v"(a), "v"(b) : "vcc"); }
__device__ __forceinline__ void cnt_gt_u32(int& c, unsigned a, unsigned b) { asm volatile("v_cmp_gt_u32 vcc, %1, %2\n\tv_addc_co_u32 %0, vcc, 0, %0, vcc" : "+v"(c) : "v"(a), "v"(b) : "vcc"); }
__device__ __forceinline__ void cnt_eq_u32(int& c, unsigned a, unsigned b) { asm volatile("v_cmp_eq_u32 vcc, %1, %2\n\tv_addc_co_u32 %0, vcc, 0, %0, vcc" : "+v"(c) : "v"(a), "v"(b) : "vcc"); }
__device__ __forceinline__ void cnt_lt_i32(int& c, int a, int b) { asm volatile("v_cmp_lt_i32 vcc, %1, %2\n\tv_addc_co_u32 %0, vcc, 0, %0, vcc" : "+v"(c) : "v"(a), "v"(b) : "vcc"); }
__device__ __forceinline__ int sel_eq_idx(unsigned a, unsigned b, int idx) { int e; const int huge = 0x7fffffff; asm volatile("v_cmp_eq_u32 vcc, %1, %2\n\tv_cndmask_b32 %0, %3, %4, vcc" : "=v"(e) : "v"(a), "v"(b), "v"(huge), "v"(idx) : "vcc"); return e; }
__device__ __forceinline__ int sel_gt_m1(unsigned a, unsigned b, int e) { int v; const int m1 = -1; asm volatile("v_cmp_gt_u32 vcc, %1, %2\n\tv_cndmask_b32 %0, %3, %4, vcc" : "=v"(v) : "v"(a), "v"(b), "v"(e), "v"(m1) : "vcc"); return v; }
__device__ __forceinline__ void shl_in_le_i32(unsigned& nib, int a, int b) { asm volatile("v_cmp_le_i32 vcc, %1, %2\n\tv_addc_co_u32 %0, vcc, %0, %0, vcc" : "+v"(nib) : "v"(a), "v"(b) : "vcc"); }

template <int NP>
__device__ __forceinline__ int pk_count_ge(const unsigned (&x)[NP], unsigned cand) {
    const unsigned cm1 = (cand - 1u) * 0x00010001u, one = 0x00010001u;
    unsigned c = 0u;
#pragma unroll
    for (int m = 0; m < NP; ++m) {
        unsigned t;
        asm("v_pk_sub_u16 %0, %1, %2 clamp" : "=v"(t) : "v"(x[m]), "v"(cm1));
        asm("v_pk_min_u16 %0, %1, %2" : "=v"(t) : "v"(t), "v"(one));
        asm("v_pk_add_u16 %0, %1, %2" : "=v"(c) : "v"(c), "v"(t));
    }
    int v = (int)((c & 0xFFFFu) + (c >> 16));
    v += __builtin_amdgcn_update_dpp(0, v, 0x111, 0xf, 0xf, true);
    v += __builtin_amdgcn_update_dpp(0, v, 0x112, 0xf, 0xf, true);
    v += __builtin_amdgcn_update_dpp(0, v, 0x114, 0xf, 0xf, true);
    v += __builtin_amdgcn_update_dpp(0, v, 0x118, 0xf, 0xf, true);
    v += __builtin_amdgcn_update_dpp(0, v, 0x142, 0xa, 0xf, false);
    v += __builtin_amdgcn_update_dpp(0, v, 0x143, 0xc, 0xf, false);
    return __builtin_amdgcn_readlane(v, 63);
}

template <int NI>
__device__ __forceinline__ u64 select_query(const unsigned* skq, int lane) {
    unsigned uk[NI];
#pragma unroll
    for (int i = 0; i < NI; ++i) uk[i] = skq[64 * i + lane];
    unsigned hp[NI / 2];
#pragma unroll
    for (int m = 0; m < NI / 2; ++m) hp[m] = (uk[2 * m] >> 16) | (uk[2 * m + 1] & 0xFFFF0000u);
    unsigned T16 = 0u;
    for (int bit = 15; bit >= 0; --bit) {
        const unsigned cand = T16 | (1u << bit);
        if (pk_count_ge<NI / 2>(hp, cand) >= 256) T16 = cand;
    }
    const int cgt_hi = (T16 < 0xFFFFu) ? pk_count_ge<NI / 2>(hp, T16 + 1u) : 0;
    const int need_lo = 256 - cgt_hi;
#pragma unroll
    for (int m = 0; m < NI / 2; ++m) {
        const unsigned a = uk[2 * m], b2 = uk[2 * m + 1];
        const unsigned la = ((a >> 16) == T16) ? (a & 0xFFFFu) : 0u, lb = ((b2 >> 16) == T16) ? (b2 << 16) : 0u;
        hp[m] = la | lb;
    }
    unsigned L16 = 0u;
    for (int bit = 15; bit >= 0; --bit) {
        const unsigned cand = L16 | (1u << bit);
        if (pk_count_ge<NI / 2>(hp, cand) >= need_lo) L16 = cand;
    }
    const unsigned Tq = (T16 << 16) | L16;
    int cgt = 0;
#pragma unroll
    for (int i = 0; i < NI; ++i) cgt += __builtin_popcountll(__ballot(uk[i] > Tq));
    int rem = 256 - cgt;
    u64 myout = (lane == 0) ? (0xFFFFull << 48) : 0ull;
#pragma unroll
    for (int i = 0; i < NI; ++i) {
        const u64 gt = __ballot(uk[i] > Tq); u64 eq = __ballot(uk[i] == Tq);
        const int ce = __builtin_popcountll(eq);
        if (ce > rem) eq = __ballot(((eq >> lane) & 1ull) && (int)__builtin_amdgcn_mbcnt_hi((unsigned)(eq >> 32), __builtin_amdgcn_mbcnt_lo((unsigned)eq, 0u)) < rem);
        rem -= (ce > rem) ? rem : ce;
        const u64 sel = gt | eq;
        if (lane == i + 1) myout = sel;
    }
    return myout;
}

__device__ __forceinline__ void indexer_phase(const Args& A, unsigned char* smem) {
    unsigned char* ws = A.ws; unsigned* ctr = (unsigned*)(ws + OFF_CTR) + 1;
    const bf16_t* IQ = (const bf16_t*)(ws + OFF_IQ); const bf16_t* IK = (const bf16_t*)(ws + OFF_IK); const float* IW = (const float*)(ws + OFF_IW);
    u64* mask64 = (u64*)(ws + OFF_MASK);
    constexpr int SKS = 2052;
    unsigned* sk = (unsigned*)smem;
    const int tid = threadIdx.x, lane = tid & 63, w = __builtin_amdgcn_readfirstlane(tid >> 6), fr = lane & 15, quad = lane >> 4;
    for (;;) {
        const unsigned u = next_unit(ctr, smem); if (u >= 1024u) break;
        const int g = 127 - (int)(u >> 3), b = (int)(u & 7), s0 = 16 * g, row0 = b * SEQ + s0;
        const int nkeys = s0 + 16, ni = (nkeys + 63) >> 6;
        if (g >= 16) {
            { const int nz = 512 * ((ni + 7) >> 3) - nkeys; for (int i = tid; i < 16 * nz; i += 512) { const int r = i / nz, c = nkeys + (i % nz); sk[r * SKS + c] = 0u; } }
            bf16x8 qf[8][2];
#pragma unroll
            for (int h = 0; h < 8; ++h)
#pragma unroll
                for (int ks = 0; ks < 2; ++ks) qf[h][ks] = *(const bf16x8*)(IQ + (size_t)(row0 + fr) * 512 + h * 64 + ks * 32 + quad * 8);
            const float4 w0 = *(const float4*)(IW + (size_t)(row0 + fr) * 8), w1 = *(const float4*)(IW + (size_t)(row0 + fr) * 8 + 4);
            const float wq[8] = {w0.x, w0.y, w0.z, w0.w, w1.x, w1.y, w1.z, w1.w};
            const bf16_t* kbase = IK + (size_t)(b * SEQ + fr) * 64 + quad * 8;
            bf16x8 nk0 = *(const bf16x8*)(kbase + (size_t)(16 * w) * 64), nk1 = *(const bf16x8*)(kbase + (size_t)(16 * w) * 64 + 32);
            for (int kt = w; kt <= g; kt += 8) {
                const bf16x8 kf0 = nk0, kf1 = nk1;
                if (kt + 8 <= g) { nk0 = *(const bf16x8*)(kbase + (size_t)(16 * (kt + 8)) * 64); nk1 = *(const bf16x8*)(kbase + (size_t)(16 * (kt + 8)) * 64 + 32); }
                float sc[4] = {0.f, 0.f, 0.f, 0.f};
#pragma unroll
                for (int h = 0; h < 8; ++h) {
                    f32x4 c = __builtin_amdgcn_mfma_f32_16x16x32_bf16(kf0, qf[h][0], (f32x4){0.f, 0.f, 0.f, 0.f}, 0, 0, 0);
                    c = __builtin_amdgcn_mfma_f32_16x16x32_bf16(kf1, qf[h][1], c, 0, 0, 0);
#pragma unroll
                    for (int j = 0; j < 4; ++j) sc[j] += wq[h] * fmaxf(c[j], 0.f);
                }
                unsigned kk[4];
#pragma unroll
                for (int j = 0; j < 4; ++j) {
                    const int s = 16 * kt + quad * 4 + j;
                    const unsigned bits = __float_as_uint(sc[j] + 0.0f);
                    const unsigned ok = bits ^ ((unsigned)((int)bits >> 31) | 0x80000000u);
                    kk[j] = (s > s0 + fr) ? 0u : ok;
                }
                *(uint4*)(sk + fr * SKS + 16 * kt + quad * 4) = make_uint4(kk[0], kk[1], kk[2], kk[3]);
            }
        }
        __syncthreads();
#ifdef DUPB
#define NQQ 4
#else
#define NQQ 2
#endif
#pragma unroll 1
        for (int qq_ = 0; qq_ < NQQ; ++qq_) {
            const int qq = qq_ & 1; const int q = 2 * w + qq; const int sq = s0 + q;
            u64 myout = 0ull;
            if (g >= 16) {
                const unsigned* skq = sk + q * SKS;
                const int n8 = (ni + 7) >> 3;
                if (n8 == 1) myout = select_query<8>(skq, lane); else if (n8 == 2) myout = select_query<16>(skq, lane);
                else if (n8 == 3) myout = select_query<24>(skq, lane); else myout = select_query<32>(skq, lane);
            } else {
                const int lim = sq - 64 * (lane - 1);
                myout = lane == 0 ? (0xFFFFull << 48) : (lim >= 63 ? ~0ull : (lim < 0 ? 0ull : ((2ull << lim) - 1ull)));
            }
            if (lane < 33) mask64[(size_t)(row0 + q) * 33 + lane] = myout;
        }
    }
}

#define LAS __attribute__((address_space(3)))
#define XB_TMO      128
#define XB_XCNT(j)  (256  + 64 * (j))
#define XB_XSUB(j)  (1280 + 64 * (j))
#define XB_XGEN(j)  (2304 + 64 * (j))
#define XB_TOP      3328
#define XB_TOPGEN   3392
#define XCD_BAR_WORDS 3456
#define XB_SPIN_CAP (1u << 18)

__device__ __forceinline__ unsigned xb_ld(unsigned* p)              { return __hip_atomic_load(p, __ATOMIC_RELAXED, __HIP_MEMORY_SCOPE_AGENT); }
__device__ __forceinline__ unsigned xb_add(unsigned* p, unsigned v) { return __hip_atomic_fetch_add(p, v, __ATOMIC_RELAXED, __HIP_MEMORY_SCOPE_AGENT); }
__device__ __forceinline__ unsigned xb_xcc_id() { return (unsigned)__builtin_amdgcn_s_getreg((3 << 11) | 20) & 0xFu; }
#define XB_SPIN(cond, bar) do { unsigned _sp = 0; while (cond) { __builtin_amdgcn_s_sleep(1); \
    if ((++_sp & 255u) == 0u) { if (xb_ld(&(bar)[XB_TMO])) break; if (_sp > XB_SPIN_CAP) { atomicAdd(&(bar)[XB_TMO], 1u); break; } } } } while (0)

struct XcdBarrier {
    unsigned* bar; unsigned x;
    volatile LAS unsigned* st;
};

__device__ __forceinline__ XcdBarrier xcd_barrier_post(unsigned* bar, volatile LAS unsigned* st) {
    XcdBarrier b; b.bar = bar; b.x = xb_xcc_id(); b.st = st;
    if (threadIdx.x == 0) (void)xb_add(&bar[XB_XCNT(b.x)], 1u);
    return b;
}
__device__ __forceinline__ void xcd_barrier_complete(unsigned* bar, unsigned x, unsigned& nloc, unsigned& nx) {
    const unsigned G = gridDim.x * gridDim.y * gridDim.z;
    unsigned sum, cnt, mine, sp = 0u;
    for (;;) {
        sum = 0u; cnt = 0u; mine = 0u;
#pragma unroll
        for (unsigned j = 0; j < 16; ++j) { const unsigned c = xb_ld(&bar[XB_XCNT(j)]); sum += c; cnt += (c > 0u) ? 1u : 0u; mine = (j == x) ? c : mine; }
        if (sum == G) break;
        __builtin_amdgcn_s_sleep(1);
        if ((++sp & 255u) == 0u) { if (xb_ld(&bar[XB_TMO])) break; if (sp > XB_SPIN_CAP) { atomicAdd(&bar[XB_TMO], 1u); break; } }
    }
    nloc = mine > 0u ? mine : 1u; nx = cnt > 0u ? cnt : 1u;
}

__device__ __forceinline__ void xcd_barrier(const XcdBarrier& b) {
    asm volatile("s_waitcnt vmcnt(0)" ::: "memory");
    __syncthreads();
    if (threadIdx.x == 0) {
        unsigned* bar = b.bar;
        __builtin_amdgcn_s_waitcnt(0);
        unsigned nloc = b.st[0], nx = b.st[1];
        if (nloc == 0u) { xcd_barrier_complete(bar, b.x, nloc, nx); b.st[0] = nloc; b.st[1] = nx; }
        const unsigned old = xb_add(&bar[XB_XSUB(b.x)], 1u);
        const unsigned gen = old / nloc;
        if (old + 1u == (gen + 1u) * nloc) {
            __builtin_amdgcn_fence(__ATOMIC_RELEASE, "agent");
            asm volatile("s_waitcnt vmcnt(0)" ::: "memory");
            const unsigned og = xb_add(&bar[XB_TOP], 1u);
            const unsigned tg = og / nx;
            if (og + 1u == (tg + 1u) * nx) xb_add(&bar[XB_TOPGEN], 1u);
            else XB_SPIN(xb_ld(&bar[XB_TOPGEN]) == tg, bar);
            __builtin_amdgcn_fence(__ATOMIC_ACQUIRE, "agent");
            xb_add(&bar[XB_XGEN(b.x)], 1u);
            asm volatile("s_waitcnt vmcnt(0)" ::: "memory");
        } else {
            XB_SPIN(xb_ld(&bar[XB_XGEN(b.x)]) == gen, bar);
            __builtin_amdgcn_fence(__ATOMIC_ACQUIRE, "agent");
            asm volatile("s_waitcnt vmcnt(0)" ::: "memory");
        }
    }
    __syncthreads();
}
#define GEMM_PHASE(EPI, e, Aptr, Bptr, Mrows, Ncols, Kdim) do { pg8::Gemm g_{(const bf16_t*)(Aptr), (const bf16_t*)(Bptr), (Mrows), (Ncols), (Kdim)}; pg8::StaticOrder S_; S_.init((Mrows), (Ncols), (int)gridDim.x, (int)blockIdx.x); \
    pg8::gemm_phase<EPI, pg8::StaticOrder, true, true>((PG8_LAS unsigned char*)smem, g_, S_, e); } while (0)

__global__ void __launch_bounds__(512, 2) mk_fwd(Args A) {
    extern __shared__ __attribute__((aligned(16))) unsigned char smem[];
    unsigned char* ws = A.ws;
    const int lo = A.ph_lo, hi = A.ph_hi;
    volatile LAS unsigned* xst = (volatile LAS unsigned*)((LAS unsigned char*)smem + LDS_CTL + 64);
    if (threadIdx.x < 2) xst[threadIdx.x] = 0u;
    __syncthreads();
    const XcdBarrier xbar = xcd_barrier_post((unsigned*)(ws + OFF_BAR), xst);
#ifndef PHMASK
#define PHMASK 0xFFFFF
#endif
#define IN(k) (((PHMASK >> (k)) & 1) && lo <= (k) && (k) < hi)
#if MK_COOP
#define SEAM(k) do { if (IN(k) && IN((k) + 1)) { if ((k) == 0) cg::this_grid().sync(); else xcd_barrier(xbar); } } while (0)
#else
#define SEAM(k) do { } while (0)
#endif
#ifdef PROBE_PHASE
    unsigned long long pt0 = 0, pt1 = 0;
#define PSTAMP(k) do { if ((k) == PROBE_PHASE) pt0 = __builtin_amdgcn_s_memrealtime(); if ((k) == PROBE_PHASE + 1) pt1 = __builtin_amdgcn_s_memrealtime(); } while (0)
#else
#define PSTAMP(k) do { } while (0)
#endif
    float* ssq0 = (float*)(ws + OFF_SSQ0); float* ssq1 = (float*)(ws + OFF_SSQ1); float* ssq2 = (float*)(ws + OFF_SSQ2); float* ssq3 = (float*)(ws + OFF_SSQ3); float* ssqY = (float*)(ws + OFF_SSQY);
    bf16_t* h1b = (bf16_t*)(ws + OFF_H1B); bf16_t* delta = (bf16_t*)(ws + OFF_DELTA);
    PSTAMP(0);
    if (IN(0)) { p0_prologue(A, smem); }
    SEAM(0);
    PSTAMP(1);
    if (IN(1)) { EpiSwiGLU e{(bf16_t*)(ws + OFF_ACT), ssq0}; GEMM_PHASE(EpiSwiGLU, e, A.out, ws + OFF_W1, MP, 5632, DM); }
    SEAM(1);
    PSTAMP(2);
    if (IN(2)) { EpiResid e{A.in[0], nullptr, A.in[1], nullptr, h1b, delta, ssq1, 0.5f}; GEMM_PHASE(EpiResid, e, ws + OFF_ACT, ws + OFF_WD1, MP, DM, DFF); }
    SEAM(2);
    PSTAMP(3);
    if (IN(3)) { EpiRet e{ssq1, (const float2*)(ws + OFF_TAB256), (bf16_t*)(ws + OFF_RQ), (bf16_t*)(ws + OFF_RKS), (bf16_t*)(ws + OFF_RVT)}; GEMM_PHASE(EpiRet, e, h1b, ws + OFF_WINA, MP, 4096, DM); }
    SEAM(3);
    PSTAMP(4);
    if (IN(4)) { retention_phase(A, smem); }
    SEAM(4);
    PSTAMP(5);
    if (IN(5)) { EpiAtt e{ssq1, (const float2*)(ws + OFF_TAB128), (const float2*)(ws + OFF_TAB64), ssqY, (bf16_t*)(ws + OFF_AQ), (bf16_t*)(ws + OFF_AKS), (bf16_t*)(ws + OFF_AVT),
                          (bf16_t*)(ws + OFF_IQ), (bf16_t*)(ws + OFF_IK), (float*)(ws + OFF_IW), (bf16_t*)A.out};
                 GEMM_PHASE(EpiAtt, e, h1b, ws + OFF_WINB, MP, 5888, DM); }
    SEAM(5);
    PSTAMP(6);
    if (IN(6)) { indexer_phase(A, smem); }
    SEAM(6);
    PSTAMP(7);
    if (IN(7)) { attention_phase(A, smem); }
    SEAM(7);
    PSTAMP(8);
    if (IN(8)) { { EpiPlain e{(bf16_t*)(ws + OFF_YR)}; GEMM_PHASE(EpiPlain, e, A.out, ws + OFF_WRO, MR, DM, 2048); }
                 { EpiPlain e{(bf16_t*)(ws + OFF_YA)}; GEMM_PHASE(EpiPlain, e, ws + OFF_AQ, ws + OFF_WAO, MR, DM, DM); } }
    SEAM(8);
    PSTAMP(9);
    if (IN(9)) { EpiGate e{ssq1, (bf16_t*)(ws + OFF_YR), (const bf16_t*)(ws + OFF_YA)}; GEMM_PHASE(EpiGate, e, h1b, ws + OFF_WINC, MR, 2048, DM); }
    SEAM(9);
    PSTAMP(10);
    if (IN(10)) { EpiResid e{A.in[0], delta, nullptr, A.out, h1b, nullptr, ssq2, 1.0f}; GEMM_PHASE(EpiResid, e, ws + OFF_YR, ws + OFF_WMX, MR, DM, DM); }
    SEAM(10);
    PSTAMP(11);
    if (IN(11)) { EpiSwiGLU e{(bf16_t*)(ws + OFF_ACT2), ssq2}; GEMM_PHASE(EpiSwiGLU, e, h1b, ws + OFF_W2, MR, 5632, DM); }
    SEAM(11);
    PSTAMP(12);
    if (IN(12)) { EpiResid e{A.out, nullptr, nullptr, A.out, nullptr, nullptr, ssq3, 0.5f}; GEMM_PHASE(EpiResid, e, ws + OFF_ACT2, ws + OFF_WD2, MR, DM, DFF); }
    SEAM(12);
    PSTAMP(13);
    if (IN(13)) {
        const float* gf = A.in[15];
        const int lane = threadIdx.x & 63, wave = threadIdx.x >> 6;
        for (int row = blockIdx.x * 8 + wave; row < MR; row += gridDim.x * 8) {
            const float r = rstd1024(ssq3, row);
            float4* p = (float4*)(A.out + (size_t)row * DM);
#ifdef PROBE_PHASE
            const float pd = 0.08f * sqrtf((float)(pt1 - pt0) * 1e-5f);
#endif
#pragma unroll
            for (int j = 0; j < 4; ++j) { float4 v = p[lane + 64 * j]; const float4 g = ((const float4*)gf)[lane + 64 * j];
                v.x *= r * g.x; v.y *= r * g.y; v.z *= r * g.z; v.w *= r * g.w;
#ifdef PROBE_PHASE
                if (j == 0 && lane == 0) v.x += pd;
#endif
                p[lane + 64 * j] = v; }
        }
    }
}
constexpr int NPHASE = 14;

extern "C" void kernel_launch(void* const* d_in, const int* in_sizes, int n_in, void* d_out, int out_size, void* d_ws, size_t ws_size, hipStream_t stream) {
    static int grid = 0;
    if (grid == 0) {
        if (n_in != 16 || out_size != MR * DM || ws_size < 256 * MiB) { fprintf(stderr, "kernel_launch: unexpected problem (n_in %d out %d ws %zu)\n", n_in, out_size, ws_size); grid = -1; return; }
        int dev = 0, cus = 0, per_cu = 0;
        hipGetDevice(&dev); hipDeviceGetAttribute(&cus, hipDeviceAttributeMultiprocessorCount, dev);
        if (hipFuncSetAttribute((const void*)mk_fwd, hipFuncAttributeMaxDynamicSharedMemorySize, LDS_BYTES) != hipSuccess) { fprintf(stderr, "kernel_launch: hipFuncSetAttribute failed\n"); grid = -1; return; }
        hipOccupancyMaxActiveBlocksPerMultiprocessor(&per_cu, (const void*)mk_fwd, 512, LDS_BYTES);
        (void)hipGetLastError();
        if (per_cu < 1) per_cu = 1;
        grid = cus * 1;
        fprintf(stderr, "kernel_launch: cus %d per_cu %d grid %d\n", cus, per_cu, grid);
    }
    if (grid < 0) return;
    Args a{};
    for (int i = 0; i < 16; ++i) a.in[i] = (const float*)d_in[i];
    a.out = (float*)d_out; a.ws = (unsigned char*)d_ws;
    for (int h = 0; h < 4; ++h) a.l2g[h] = (float)(std::log1p(-std::ldexp(1.0, -5 - h)) / std::log(2.0));
#if MK_COOP
    if (hipMemsetAsync((char*)d_ws + OFF_BAR, 0, 16384, stream) != hipSuccess) { fprintf(stderr, "kernel_launch: memset failed\n"); return; }
    a.ph_lo = 0; a.ph_hi = NPHASE;
    void* args[] = {&a};
    hipError_t e = hipLaunchCooperativeKernel((const void*)mk_fwd, dim3(grid), dim3(512), args, LDS_BYTES, stream);
    if (e != hipSuccess) fprintf(stderr, "cooperative launch failed: %s (grid %d)\n", hipGetErrorString(e), grid);
#else
    for (int p = 0; p < NPHASE; ++p) { a.ph_lo = p; a.ph_hi = p + 1; hipLaunchKernelGGL(mk_fwd, dim3(grid), dim3(512), LDS_BYTES, stream, a); }
#endif
}
```

```cpp
#include <hip/hip_runtime.h>
#include <hip/hip_cooperative_groups.h>
#include <cstdio>
#include <cstdint>
#include <cmath>
namespace cg = cooperative_groups;
namespace pg8 {
#define PG8_LAS __attribute__((address_space(3)))
typedef unsigned short bf16_t;
typedef short bf16x8 __attribute__((ext_vector_type(8)));
typedef float f32x4 __attribute__((ext_vector_type(4)));
typedef unsigned u32x4 __attribute__((ext_vector_type(4)));
constexpr int BM = 256, BK = 64, HALF = 128, HTB = HALF * BK * 2  , STAGE_BYTES = 8 * HTB, NXCD = 8, WGM = 8;

__host__ __device__ __forceinline__ int lds_byte(int r, int c) { const int st = (r >> 4) * 2 + (c >> 5), rr = r & 15, cc = c & 31, ob = rr * 64 + cc * 2; return st * 1024 + (ob ^ (((ob >> 9) & 1) << 5)); }
__host__ __device__ __forceinline__ void stage_rc(int b, int& R, int& C) { const int st = b / 1024, sb = b % 1024, swz = sb ^ (((sb >> 9) & 1) << 5); R = (st >> 1) * 16 + swz / 64; C = (st & 1) * 32 + (swz % 64) / 2; }
__host__ __device__ __forceinline__ int perm32(int rho) { const int n = rho >> 4, i = rho & 15; return 8 * (i >> 2) + 4 * n + (i & 3); }

struct Unit { int pm, pn; };
struct Gemm { const bf16_t* A; const bf16_t* Bt; int M, N, K; };

struct StaticOrder {
    int nM, nN, nwg, G, c;
    __host__ __device__ void init(int M, int N, int G_, int c_) { nM = M / BM; nN = N / BM; nwg = nM * nN; G = G_; c = c_; }
    __host__ __device__ bool next(int i, Unit& u) const {
        const long L = (long)i * G + c; if (L >= nwg) return false;
        int wgid = (int)L; { const int q = nwg / NXCD, r = nwg % NXCD, xcd = wgid % NXCD, off = wgid / NXCD; wgid = (xcd < r ? xcd * (q + 1) : r * (q + 1) + (xcd - r) * q) + off; }
        const int nig = WGM * nN, gid = wgid / nig, fm = gid * WGM, gsz = (nM - fm) < WGM ? (nM - fm) : WGM;
        u.pm = fm + ((wgid % nig) % gsz); u.pn = (wgid % nig) / gsz; return true;
    }
    __device__ __forceinline__ void a_ready(const Unit&) const {}
    __device__ __forceinline__ void done(const Unit&) const {}
};

__device__ __forceinline__ unsigned cvt_pk_bf16(float lo, float hi) { unsigned r; asm volatile("v_cvt_pk_bf16_f32 %0, %1, %2" : "=v"(r) : "v"(lo), "v"(hi)); return r; }

template <class Epi, class Sched, bool ALIGN_EPI = false, bool SP2 = false>
__device__ __forceinline__ void gemm_phase(PG8_LAS unsigned char* lds, const Gemm g, const Sched& S, const Epi& E) {
    const int tid = threadIdx.x, wid = __builtin_amdgcn_readfirstlane(tid >> 6), lane = tid & 63, wr = wid >> 2, wc = wid & 3, fr = lane & 15, fq = lane >> 4;
    const int K = g.K, nt = K / BK;
    unsigned voffA[2], voffB[2];
#pragma unroll
    for (int i = 0; i < 2; ++i) { int R, C; stage_rc(tid * 16 + i * 8192, R, C); const int Rb = Epi::PERM ? ((R & ~31) + perm32(R & 31)) : R;
        voffA[i] = (unsigned)(R * K + C) * 2u; voffB[i] = (unsigned)(Rb * K + C) * 2u; }
    const size_t kstep = (size_t)(BK * 2);
    const size_t hstep = (size_t)HALF * K * 2;
    const size_t tstep = 2 * hstep;
    const unsigned ldsw = (unsigned)wid * 1024u;
    const int aoff = lds_byte(wr * 64 + fr, fq * 8), boff = lds_byte(wc * 32 + fr, fq * 8);
#define PG8_SA(b, h) (((b) * 2 + (h)) * HTB)
#define PG8_SB(b, h) ((4 + (b) * 2 + (h)) * HTB)
#define PG8_STAGE(bufoff, gbase, voff) do { _Pragma("unroll") for (int _i = 0; _i < 2; ++_i) \
        __builtin_amdgcn_global_load_lds((const unsigned*)((const char*)(gbase) + (voff)[_i]), (PG8_LAS unsigned*)(lds + (bufoff) + ldsw + _i * 8192), 16, 0, 0); } while (0)
#define PG8_LDA(dst, b, h) do { _Pragma("unroll") for (int m = 0; m < 4; ++m) _Pragma("unroll") for (int k = 0; k < 2; ++k) dst[m][k] = *(const PG8_LAS bf16x8*)(lds + PG8_SA(b, h) + aoff + m * 2048 + k * 1024); } while (0)
#define PG8_LDB(dst, b, h) do { _Pragma("unroll") for (int n = 0; n < 2; ++n) _Pragma("unroll") for (int k = 0; k < 2; ++k) dst[n][k] = *(const PG8_LAS bf16x8*)(lds + PG8_SB(b, h) + boff + n * 2048 + k * 1024); } while (0)
#define PG8_MMA(ai, bj, At, Bt) do { __builtin_amdgcn_s_setprio(1); _Pragma("unroll") for (int m = 0; m < 4; ++m) _Pragma("unroll") for (int n = 0; n < 2; ++n) _Pragma("unroll") for (int k = 0; k < 2; ++k) \
        acc[ai][bj][m][n] = __builtin_amdgcn_mfma_f32_16x16x32_bf16(Bt[n][k], At[m][k], acc[ai][bj][m][n], 0, 0, 0); __builtin_amdgcn_s_setprio(0); } while (0)
#define PG8_WAIT_V(n) asm volatile("s_waitcnt vmcnt(" #n ")" ::: "memory")
#define PG8_WAIT_L(n) asm volatile("s_waitcnt lgkmcnt(" #n ")" ::: "memory")
#define PG8_BAR __builtin_amdgcn_s_barrier()
#define PG8_SCHED __builtin_amdgcn_sched_barrier(0)
    Unit cur, nxt; int ui = 0;
    if (!S.next(0, cur)) return;
    f32x4 acc[2][2][4][2];
#pragma unroll
    for (int a = 0; a < 2; ++a)
#pragma unroll
        for (int b = 0; b < 2; ++b)
#pragma unroll
            for (int m = 0; m < 4; ++m)
#pragma unroll
                for (int n = 0; n < 2; ++n) acc[a][b][m][n] = (f32x4){0.f, 0.f, 0.f, 0.f};
    bf16x8 At[4][2], B0[2][2], B1[2][2];
    const char* cA = (const char*)g.A + (size_t)cur.pm * tstep; const char* cB = (const char*)g.Bt + (size_t)cur.pn * tstep;
    S.a_ready(cur);
    if constexpr (SP2) {
        PG8_STAGE(PG8_SB(0, 0), cB, voffB); PG8_STAGE(PG8_SB(0, 1), cB + hstep, voffB); PG8_STAGE(PG8_SA(0, 0), cA, voffA); PG8_STAGE(PG8_SA(0, 1), cA + hstep, voffA);
        if (wr == 1) PG8_BAR;
        PG8_WAIT_V(2); PG8_BAR;
        PG8_STAGE(PG8_SB(1, 0), cB + kstep, voffB); PG8_STAGE(PG8_SA(1, 0), cA + kstep, voffA); PG8_STAGE(PG8_SB(1, 1), cB + hstep + kstep, voffB);
        PG8_WAIT_V(6); PG8_BAR;
    } else {
        PG8_STAGE(PG8_SB(0, 0), cB, voffB); PG8_STAGE(PG8_SA(0, 0), cA, voffA); PG8_STAGE(PG8_SB(0, 1), cB + hstep, voffB); PG8_STAGE(PG8_SA(0, 1), cA + hstep, voffA);
        if (wr == 1) PG8_BAR;
        PG8_WAIT_V(4); PG8_BAR;
        PG8_STAGE(PG8_SB(1, 0), cB + kstep, voffB); PG8_STAGE(PG8_SA(1, 0), cA + kstep, voffA); PG8_STAGE(PG8_SB(1, 1), cB + hstep + kstep, voffB);
        PG8_WAIT_V(6); PG8_BAR;
    }
    for (;;) {
        const bool has_next = S.next(ui + 1, nxt);
        const char* nA = has_next ? (const char*)g.A + (size_t)nxt.pm * tstep : cA; const char* nB = has_next ? (const char*)g.Bt + (size_t)nxt.pn * tstep : cB;
        for (int t = 0; t < nt; t += 2) {
            const bool last = (t == nt - 2);
            const char* a1 = cA + (size_t)(t + 1) * kstep;
            const char* a2 = last ? nA : cA + (size_t)(t + 2) * kstep; const char* b2 = last ? nB : cB + (size_t)(t + 2) * kstep;
            const char* a3 = a2 + kstep; const char* b3 = b2 + kstep;
            if (last && has_next) S.a_ready(nxt);
            if constexpr (SP2) {
            PG8_LDB(B0, 0, 0); PG8_LDB(B1, 0, 1); PG8_SCHED; PG8_LDA(At, 0, 0); PG8_STAGE(PG8_SA(1, 1), a1 + hstep, voffA);
            PG8_WAIT_V(8); PG8_WAIT_L(0); PG8_BAR; PG8_MMA(0, 0, At, B0); PG8_MMA(0, 1, At, B1); PG8_BAR; PG8_SCHED;
            PG8_LDA(At, 0, 1); PG8_STAGE(PG8_SB(0, 0), b2, voffB); PG8_STAGE(PG8_SB(0, 1), b2 + hstep, voffB); PG8_STAGE(PG8_SA(0, 0), a2, voffA);
            PG8_WAIT_V(8); PG8_WAIT_L(0); PG8_BAR; PG8_MMA(1, 0, At, B0); PG8_MMA(1, 1, At, B1); PG8_BAR; PG8_SCHED;
            PG8_LDB(B0, 1, 0); PG8_LDB(B1, 1, 1); PG8_SCHED; PG8_LDA(At, 1, 0); PG8_STAGE(PG8_SA(0, 1), a2 + hstep, voffA);
            PG8_WAIT_V(8); PG8_WAIT_L(0); PG8_BAR; PG8_MMA(0, 0, At, B0); PG8_MMA(0, 1, At, B1); PG8_BAR; PG8_SCHED;
            PG8_LDA(At, 1, 1); PG8_STAGE(PG8_SB(1, 0), b3, voffB); PG8_STAGE(PG8_SB(1, 1), b3 + hstep, voffB); PG8_STAGE(PG8_SA(1, 0), a3, voffA);
            PG8_WAIT_V(8); PG8_WAIT_L(0); PG8_BAR; PG8_MMA(1, 0, At, B0); PG8_MMA(1, 1, At, B1); PG8_BAR; PG8_SCHED;
            } else {
            PG8_LDB(B0, 0, 0); PG8_SCHED; PG8_LDA(At, 0, 0); PG8_STAGE(PG8_SA(1, 1), a1 + hstep, voffA);
            PG8_WAIT_L(8); PG8_BAR; PG8_WAIT_L(0); PG8_MMA(0, 0, At, B0); PG8_BAR; PG8_SCHED;
            PG8_LDB(B1, 0, 1); PG8_STAGE(PG8_SB(0, 0), b2, voffB);
            PG8_BAR; PG8_WAIT_L(0); PG8_MMA(0, 1, At, B1); PG8_BAR;
            PG8_LDA(At, 0, 1); PG8_STAGE(PG8_SA(0, 0), a2, voffA);
            PG8_BAR; PG8_WAIT_L(0); PG8_MMA(1, 0, At, B0); PG8_BAR; PG8_SCHED;
            PG8_STAGE(PG8_SB(0, 1), b2 + hstep, voffB);
            PG8_WAIT_V(6); PG8_BAR; PG8_MMA(1, 1, At, B1); PG8_BAR;
            PG8_LDB(B0, 1, 0); PG8_SCHED; PG8_LDA(At, 1, 0); PG8_STAGE(PG8_SA(0, 1), a2 + hstep, voffA);
            PG8_WAIT_L(8); PG8_BAR; PG8_WAIT_L(0); PG8_MMA(0, 0, At, B0); PG8_BAR; PG8_SCHED;
            PG8_LDB(B1, 1, 1); PG8_STAGE(PG8_SB(1, 0), b3, voffB);
            PG8_BAR; PG8_WAIT_L(0); PG8_MMA(0, 1, At, B1); PG8_BAR;
            PG8_LDA(At, 1, 1); PG8_STAGE(PG8_SA(1, 0), a3, voffA);
            PG8_BAR; PG8_WAIT_L(0); PG8_MMA(1, 0, At, B0); PG8_BAR; PG8_SCHED;
            PG8_STAGE(PG8_SB(1, 1), b3 + hstep, voffB);
            PG8_WAIT_V(6); PG8_BAR; PG8_MMA(1, 1, At, B1); PG8_BAR;
            }
        }
        if constexpr (ALIGN_EPI) { if (wr == 0) PG8_BAR; }
        if constexpr (!Epi::AFTER_DRAIN) { E(acc, cur, wr, wc, fr, fq); S.done(cur); }
        if (!has_next) break;
#pragma unroll
        for (int a = 0; a < 2; ++a)
#pragma unroll
            for (int b = 0; b < 2; ++b)
#pragma unroll
                for (int m = 0; m < 4; ++m)
#pragma unroll
                    for (int n = 0; n < 2; ++n) acc[a][b][m][n] = (f32x4){0.f, 0.f, 0.f, 0.f};
        cur = nxt; cA = nA; cB = nB; ++ui;
        if constexpr (ALIGN_EPI) { if (wr == 1) PG8_BAR; }
    }
    PG8_WAIT_V(0);
    if constexpr (!ALIGN_EPI) { if (wr == 0) PG8_BAR; }
    PG8_BAR;
    if constexpr (Epi::AFTER_DRAIN) { E.fused(acc, cur, wr, wc, fr, fq, lds, wid, lane); S.done(cur); }
#undef PG8_SA
#undef PG8_SB
#undef PG8_STAGE
#undef PG8_LDA
#undef PG8_LDB
#undef PG8_MMA
#undef PG8_WAIT_V
#undef PG8_WAIT_L
#undef PG8_BAR
#undef PG8_SCHED
}
}
#ifndef MK_COOP
#define MK_COOP 1
#endif
using pg8::bf16_t; using pg8::bf16x8; using pg8::f32x4; using pg8::cvt_pk_bf16;
typedef short bf16x4 __attribute__((ext_vector_type(4)));
typedef unsigned long long u64;
typedef unsigned u32x2 __attribute__((ext_vector_type(2)));

constexpr int NB = 8, SEQ = 2048, NMETA = 16, TT = 2112, TP = 2112, DM = 1024, DFF = 2816;
constexpr int SPOS0 = 48;
constexpr int MR = NB * SEQ;
constexpr int MP = MR + 256;
constexpr int DIN = 11848;
constexpr int O_RQ = 0, O_RK = 1024, O_RV = 2048, O_RG = 4096, O_AQ = 6144, O_AK = 7168, O_AV = 8192, O_IQ = 9216, O_IK = 9728, O_IW = 9792, O_GR = 9800, O_GA = 10824;
constexpr float EPSN = 1e-6f;
constexpr size_t MiB = 1u << 20;
constexpr size_t WS_ZERO = 0;
constexpr size_t OFF_CTR = 0;
constexpr size_t OFF_SSQ1 = 4096;
constexpr size_t OFF_SSQ2 = OFF_SSQ1 + MP * 4;
constexpr size_t OFF_SSQ3 = OFF_SSQ2 + MR * 4;
constexpr size_t OFF_SSQY = OFF_SSQ3 + MR * 4;
constexpr size_t ZERO_BYTES = OFF_SSQY + (size_t)MR * 16;
constexpr size_t OFF_SSQ0 = 512 * 1024;
constexpr size_t OFF_BAR = 768 * 1024;
constexpr size_t OFF_IW = 1 * MiB;
constexpr size_t OFF_MPART = 1 * MiB + 512 * 1024;
constexpr size_t OFF_TAB256 = 2 * MiB;
constexpr size_t OFF_TAB128 = OFF_TAB256 + (size_t)2064 * 128 * 8;
constexpr size_t OFF_TAB64 = OFF_TAB128 + (size_t)2064 * 64 * 8;
constexpr size_t OFF_MASK = 6 * MiB;
constexpr size_t OFF_WINA = 11 * MiB;
constexpr size_t OFF_WINB = 19 * MiB;
constexpr size_t OFF_WINC = OFF_WINB + (size_t)5888 * 1024 * 2;
constexpr size_t OFF_WRO = OFF_WINC + 4 * MiB;
constexpr size_t OFF_WAO = OFF_WRO + 4 * MiB;
constexpr size_t OFF_WMX = OFF_WAO + 2 * MiB;
constexpr size_t OFF_W2 = OFF_WMX + 2 * MiB;
constexpr size_t OFF_WD2 = OFF_W2 + 11 * MiB;
constexpr size_t OFF_H1B = 59 * MiB;
constexpr size_t OFF_DELTA = OFF_H1B + (size_t)MP * 1024 * 2;
constexpr size_t OFF_R = OFF_DELTA + 32 * MiB;
constexpr size_t OFF_W1 = OFF_R;
constexpr size_t OFF_WD1 = OFF_R + 11 * MiB;
constexpr size_t OFF_ACT = OFF_R + 16 * MiB + MiB / 2;
constexpr size_t OFF_RQ = OFF_R;
constexpr size_t OFF_RKS = OFF_R + 32 * MiB;
constexpr size_t OFF_RVT = OFF_R + 65 * MiB;
constexpr size_t OFF_AQ = OFF_R;
constexpr size_t OFF_AKS = OFF_R + 32 * MiB;
constexpr size_t OFF_AVT = OFF_R + 65 * MiB;
constexpr size_t OFF_IQ = OFF_R + 98 * MiB;
constexpr size_t OFF_IK = OFF_R + 114 * MiB;
constexpr size_t OFF_YR = OFF_R + 32 * MiB;
constexpr size_t OFF_YA = OFF_R + 65 * MiB;
constexpr size_t OFF_ACT2 = OFF_R;
static_assert(OFF_ACT + (size_t)MP * DFF * 2 <= 256 * MiB && OFF_RVT + (size_t)8 * 4 * 512 * TP * 2 <= 256 * MiB && OFF_IK + 2 * MiB <= 256 * MiB, "ws map");
static_assert(OFF_WD2 + (size_t)1024 * 2816 * 2 <= OFF_H1B && OFF_MASK + (size_t)MR * 66 * 4 <= OFF_WINA && OFF_TAB64 + (size_t)2064 * 32 * 8 <= OFF_MASK && ZERO_BYTES <= OFF_SSQ0, "ws map 2");
constexpr int LDS_BYTES = 135168 + 1024;
constexpr int LDS_CTL = 135168;

struct Args {
    const float* in[16]; float* out; unsigned char* ws; float l2g[4]; int ph_lo, ph_hi;
};
static_assert(sizeof(Args) == 16 * 8 + 16 + 16 + 8, "Args has no padding");

__device__ __forceinline__ float wave_sum(float v) {
#pragma unroll
    for (int o = 1; o < 64; o <<= 1) v += __shfl_xor(v, o);
    return v;
}
__device__ __forceinline__ bf16_t f2bf(float v) { return (bf16_t)(cvt_pk_bf16(v, 0.f) & 0xffffu); }
__device__ __forceinline__ float bf2f(unsigned short b) { return __uint_as_float((unsigned)b << 16); }
__device__ __forceinline__ uint2 pack4(float a, float b, float c, float d) { uint2 r; r.x = cvt_pk_bf16(a, b); r.y = cvt_pk_bf16(c, d); return r; }
__device__ __forceinline__ f32x4 unpack4(uint2 v) { f32x4 r; r[0] = __uint_as_float(v.x << 16); r[1] = __uint_as_float(v.x & 0xffff0000u); r[2] = __uint_as_float(v.y << 16); r[3] = __uint_as_float(v.y & 0xffff0000u); return r; }
__device__ __forceinline__ int vpos(int pos) { return (pos & ~31) | (((pos >> 2) & 3) << 3) | (((pos >> 4) & 1) << 2) | (pos & 3); }
__device__ __forceinline__ float silu_f(float x) { return x * __builtin_amdgcn_rcpf(1.f + __expf(-x)); }
__device__ __forceinline__ float sigm_f(float x) { return __builtin_amdgcn_rcpf(1.f + __expf(-x)); }
__device__ __forceinline__ float rstd1024(const float* ssq, int row) { return rsqrtf(ssq[row] * (1.f / 1024.f) + EPSN); }
#define EPI_ROW(ai, m) (u.pm * 256 + (ai) * 128 + wr * 64 + (m) * 16 + fr)
#define EPI_RSTD(ssqp) float rs_[2][4]; { _Pragma("unroll") for (int ai = 0; ai < 2; ++ai) _Pragma("unroll") for (int m = 0; m < 4; ++m) rs_[ai][m] = (ssqp)[EPI_ROW(ai, m)]; \
    _Pragma("unroll") for (int ai = 0; ai < 2; ++ai) _Pragma("unroll") for (int m = 0; m < 4; ++m) rs_[ai][m] = rsqrtf(rs_[ai][m] * (1.f / 1024.f) + EPSN); }

struct EpiSwiGLU {
    static constexpr bool PERM = false, AFTER_DRAIN = false;
    bf16_t* act; const float* ssq;
    __device__ __forceinline__ void operator()(const f32x4 (&acc)[2][2][4][2], const pg8::Unit& u, int wr, int wc, int fr, int fq) const {
        EPI_RSTD(ssq)
#pragma unroll
        for (int ai = 0; ai < 2; ++ai)
#pragma unroll
            for (int m = 0; m < 4; ++m) {
                const int row = EPI_ROW(ai, m); const float r = rs_[ai][m];
#pragma unroll
                for (int bj = 0; bj < 2; ++bj) {
                    const int f0 = u.pn * 128 + bj * 64 + wc * 16 + fq * 4;
                    const f32x4 g = acc[ai][bj][m][0] * r, uu = acc[ai][bj][m][1] * r;
                    *(uint2*)(act + (size_t)row * DFF + f0) = pack4(silu_f(g[0]) * uu[0], silu_f(g[1]) * uu[1], silu_f(g[2]) * uu[2], silu_f(g[3]) * uu[3]);
                }
            }
    }
};

struct EpiResid {
    static constexpr bool PERM = false, AFTER_DRAIN = false;
    const float* resf; const bf16_t* resd; const float* meta; float* outf; bf16_t* outb; bf16_t* outd; float* ssq; float alpha;
    __device__ __forceinline__ void operator()(const f32x4 (&acc)[2][2][4][2], const pg8::Unit& u, int wr, int wc, int fr, int fq) const {
#pragma unroll
        for (int ai = 0; ai < 2; ++ai)
#pragma unroll
            for (int mh = 0; mh < 2; ++mh) {
                f32x4 res[2][2][2]; uint2 rd[2][2][2];
#pragma unroll
                for (int m2 = 0; m2 < 2; ++m2) {
                    const int row = EPI_ROW(ai, 2 * mh + m2);
#pragma unroll
                    for (int bj = 0; bj < 2; ++bj)
#pragma unroll
                        for (int n = 0; n < 2; ++n) {
                            const int c0 = u.pn * 256 + bj * 128 + wc * 32 + n * 16 + fq * 4;
                            res[m2][bj][n] = (f32x4){0.f, 0.f, 0.f, 0.f}; rd[m2][bj][n] = make_uint2(0u, 0u);
                            if (row < MR) { res[m2][bj][n] = *(const f32x4*)(resf + (size_t)row * DM + c0); if (resd) rd[m2][bj][n] = *(const uint2*)(resd + (size_t)row * DM + c0); }
                            else if (meta && row < MR + NMETA) res[m2][bj][n] = *(const f32x4*)(meta + (size_t)(row - MR) * DM + c0);
                        }
                }
#pragma unroll
                for (int m2 = 0; m2 < 2; ++m2) {
                    const int m = 2 * mh + m2; const int row = EPI_ROW(ai, m);
                    float part = 0.f;
#pragma unroll
                    for (int bj = 0; bj < 2; ++bj)
#pragma unroll
                        for (int n = 0; n < 2; ++n) {
                            const int c0 = u.pn * 256 + bj * 128 + wc * 32 + n * 16 + fq * 4;
                            const f32x4 a = acc[ai][bj][m][n] * alpha;
                            const f32x4 h = res[m2][bj][n] + unpack4(rd[m2][bj][n]) + a;
                            part += (h[0] * h[0] + h[1] * h[1]) + (h[2] * h[2] + h[3] * h[3]);
                            if (outf && row < MR) *(f32x4*)(outf + (size_t)row * DM + c0) = h;
                            if (outb) *(uint2*)(outb + (size_t)row * DM + c0) = pack4(h[0], h[1], h[2], h[3]);
                            if (outd && row < MR) *(uint2*)(outd + (size_t)row * DM + c0) = pack4(a[0], a[1], a[2], a[3]);
                        }
                    part += __shfl_xor(part, 16); part += __shfl_xor(part, 32);
                    if (fq == 0) atomicAdd(ssq + row, part);
                }
            }
    }
};

__device__ __forceinline__ void rope4(const f32x4 x1, const f32x4 x2, const float4 t0, const float4 t1, uint2& o1, uint2& o2) {
    o1 = pack4(x1[0] * t0.x - x2[0] * t0.y, x1[1] * t0.z - x2[1] * t0.w, x1[2] * t1.x - x2[2] * t1.y, x1[3] * t1.z - x2[3] * t1.w);
    o2 = pack4(x2[0] * t0.x + x1[0] * t0.y, x2[1] * t0.z + x1[1] * t0.w, x2[2] * t1.x + x1[2] * t1.y, x2[3] * t1.z + x1[3] * t1.w);
}

struct EpiRet {
    static constexpr bool PERM = false, AFTER_DRAIN = false;
    const float* ssq1; const float2* tab256; bf16_t* RQ; bf16_t* RKs; bf16_t* RVt;
    __device__ __forceinline__ void operator()(const f32x4 (&acc)[2][2][4][2], const pg8::Unit& u, int wr, int wc, int fr, int fq) const {
        EPI_RSTD(ssq1)
        if (u.pn < 8) {
            const int head = u.pn & 3; const float sc = u.pn < 4 ? 1.f : 0.0625f;
#pragma unroll
            for (int ai = 0; ai < 2; ++ai)
#pragma unroll
                for (int mh = 0; mh < 2; ++mh) {
                    float4 tb[2][2][2];
#pragma unroll
                    for (int m2 = 0; m2 < 2; ++m2) {
                        const int row = EPI_ROW(ai, 2 * mh + m2); const int pos = row < MR ? NMETA + (row & 2047) : (row < MR + NMETA ? row - MR : 0);
#pragma unroll
                        for (int bj = 0; bj < 2; ++bj) { const float4* tp = (const float4*)(tab256 + (size_t)pos * 128 + 16 * (4 * bj + wc) + 4 * fq); tb[m2][bj][0] = tp[0]; tb[m2][bj][1] = tp[1]; }
                    }
#pragma unroll
                    for (int m2 = 0; m2 < 2; ++m2) {
                        const int m = 2 * mh + m2; const int row = EPI_ROW(ai, m);
                        const bool real = row < MR; const int b = row >> 11; const int pos = real ? NMETA + (row & 2047) : row - MR;
                        if (row < MR + NMETA && (u.pn >= 4 || real)) {
                            const float r = rs_[ai][m] * sc;
#pragma unroll
                            for (int bj = 0; bj < 2; ++bj) {
                                const int jj0 = 16 * (4 * bj + wc) + 4 * fq; uint2 o1, o2;
                                rope4(acc[ai][bj][m][0] * r, acc[ai][bj][m][1] * r, tb[m2][bj][0], tb[m2][bj][1], o1, o2);
                                if (u.pn < 4) { bf16_t* d = RQ + (size_t)row * 1024 + head * 256 + jj0; *(uint2*)d = o1; *(uint2*)(d + 128) = o2; }
                                else if (real) { bf16_t* d = RKs + ((size_t)b * TP + SPOS0 + pos) * 1024 + head * 256 + jj0; *(uint2*)d = o1; *(uint2*)(d + 128) = o2; }
                                else { for (int bb = 0; bb < NB; ++bb) { bf16_t* d = RKs + ((size_t)bb * TP + SPOS0 + pos) * 1024 + head * 256 + jj0; *(uint2*)d = o1; *(uint2*)(d + 128) = o2; } }
                            }
                        }
                    }
                }
        } else {
#pragma unroll
            for (int ai = 0; ai < 2; ++ai)
#pragma unroll
                for (int m = 0; m < 4; ++m) {
                    const int row = EPI_ROW(ai, m);
                    if (row < MR + NMETA) {
                        const bool real = row < MR; const int b = row >> 11; const int pos = real ? NMETA + (row & 2047) : row - MR; const float r = rs_[ai][m];
#pragma unroll
                        for (int bj = 0; bj < 2; ++bj)
#pragma unroll
                            for (int n = 0; n < 2; ++n) {
                                const int cin = (u.pn - 8) * 256 + bj * 128 + wc * 32 + n * 16 + fq * 4; const int head = cin >> 9, dv = cin & 511;
                                const f32x4 v = acc[ai][bj][m][n] * r;
                                const bf16_t v0 = f2bf(v[0]), v1 = f2bf(v[1]), v2 = f2bf(v[2]), v3 = f2bf(v[3]);
                                if (real) { bf16_t* d = RVt + ((size_t)(b * 4 + head) * 512 + dv) * TP + vpos(SPOS0 + pos); d[0] = v0; d[TP] = v1; d[2 * TP] = v2; d[3 * TP] = v3; }
                                else { for (int bb = 0; bb < NB; ++bb) { bf16_t* d = RVt + ((size_t)(bb * 4 + head) * 512 + dv) * TP + vpos(SPOS0 + pos); d[0] = v0; d[TP] = v1; d[2 * TP] = v2; d[3 * TP] = v3; } }
                            }
                    }
                }
        }
    }
};

struct EpiAtt {
    static constexpr bool PERM = false, AFTER_DRAIN = false;
    const float* ssq1; const float2* tab128; const float2* tab64; const float* ssqY;
    bf16_t* AQ; bf16_t* AKs; bf16_t* AVt; bf16_t* IQ; bf16_t* IK; float* IW; bf16_t* Y;
    __device__ __forceinline__ void operator()(const f32x4 (&acc)[2][2][4][2], const pg8::Unit& u, int wr, int wc, int fr, int fq) const {
        EPI_RSTD(ssq1)
        if (u.pn < 8 || u.pn == 12 || u.pn == 13) {
            const bool d128 = u.pn < 8;
#pragma unroll
            for (int ai = 0; ai < 2; ++ai)
#pragma unroll
                for (int mh = 0; mh < 2; ++mh) {
                    float4 tb[2][2];
#pragma unroll
                    for (int m2 = 0; m2 < 2; ++m2) {
                        const int row = EPI_ROW(ai, 2 * mh + m2); const int pos = row < MR ? NMETA + (row & 2047) : (row < MR + NMETA ? row - MR : 0);
                        const float4* tp = d128 ? (const float4*)(tab128 + (size_t)pos * 64 + 16 * wc + 4 * fq) : (const float4*)(tab64 + (size_t)pos * 32 + 16 * (wc & 1) + 4 * fq);
                        tb[m2][0] = tp[0]; tb[m2][1] = tp[1];
                    }
#pragma unroll
                    for (int m2 = 0; m2 < 2; ++m2) {
                        const int m = 2 * mh + m2; const int row = EPI_ROW(ai, m);
                        const bool real = row < MR; const int b = row >> 11; const int pos = real ? NMETA + (row & 2047) : row - MR;
                        if (real || (row < MR + NMETA && u.pn >= 4 && u.pn < 8)) {
                            const float r = rs_[ai][m];
#pragma unroll
                            for (int bj = 0; bj < 2; ++bj) {
                                uint2 o1, o2; rope4(acc[ai][bj][m][0] * r, acc[ai][bj][m][1] * r, tb[m2][0], tb[m2][1], o1, o2);
                                if (d128) {
                                    const int head = 2 * (u.pn & 3) + bj; const int jj0 = 16 * wc + 4 * fq;
                                    if (u.pn < 4) { bf16_t* d = AQ + (size_t)row * 1024 + head * 128 + jj0; *(uint2*)d = o1; *(uint2*)(d + 64) = o2; }
                                    else if (real) { bf16_t* d = AKs + ((size_t)b * TP + SPOS0 + pos) * 1024 + head * 128 + jj0; *(uint2*)d = o1; *(uint2*)(d + 64) = o2; }
                                    else { for (int bb = 0; bb < NB; ++bb) { bf16_t* d = AKs + ((size_t)bb * TP + SPOS0 + pos) * 1024 + head * 128 + jj0; *(uint2*)d = o1; *(uint2*)(d + 64) = o2; } }
                                } else {
                                    const int head = (u.pn - 12) * 4 + 2 * bj + (wc >> 1); const int jj0 = 16 * (wc & 1) + 4 * fq;
                                    bf16_t* d = IQ + (size_t)row * 512 + head * 64 + jj0; *(uint2*)d = o1; *(uint2*)(d + 32) = o2;
                                }
                            }
                        }
                    }
                }
        } else if (u.pn < 12) {
#pragma unroll
            for (int ai = 0; ai < 2; ++ai)
#pragma unroll
                for (int m = 0; m < 4; ++m) {
                    const int row = EPI_ROW(ai, m);
                    if (row < MR + NMETA) {
                        const bool real = row < MR; const int b = row >> 11; const int pos = real ? NMETA + (row & 2047) : row - MR; const float r = rs_[ai][m];
#pragma unroll
                        for (int bj = 0; bj < 2; ++bj)
#pragma unroll
                            for (int n = 0; n < 2; ++n) {
                                const int cin = (u.pn - 8) * 256 + bj * 128 + wc * 32 + n * 16 + fq * 4; const int head = cin >> 7, dd = cin & 127;
                                const f32x4 v = acc[ai][bj][m][n] * r;
                                const bf16_t v0 = f2bf(v[0]), v1 = f2bf(v[1]), v2 = f2bf(v[2]), v3 = f2bf(v[3]);
                                if (real) { bf16_t* d = AVt + ((size_t)(b * 8 + head) * 128 + dd) * TP + vpos(SPOS0 + pos); d[0] = v0; d[TP] = v1; d[2 * TP] = v2; d[3 * TP] = v3; }
                                else { for (int bb = 0; bb < NB; ++bb) { bf16_t* d = AVt + ((size_t)(bb * 8 + head) * 128 + dd) * TP + vpos(SPOS0 + pos); d[0] = v0; d[TP] = v1; d[2 * TP] = v2; d[3 * TP] = v3; } }
                            }
                    }
                }
        } else if (u.pn == 14) {
#pragma unroll
            for (int ai = 0; ai < 2; ++ai) {
                float4 tb[4][2];
                if (wc < 2) {
#pragma unroll
                    for (int m = 0; m < 4; ++m) { const int row = EPI_ROW(ai, m); const int pos = row < MR ? NMETA + (row & 2047) : 0;
                        const float4* tp = (const float4*)(tab64 + (size_t)pos * 32 + 16 * wc + 4 * fq); tb[m][0] = tp[0]; tb[m][1] = tp[1]; }
                }
#pragma unroll
                for (int m = 0; m < 4; ++m) {
                    const int row = EPI_ROW(ai, m);
                    if (row < MR) {
                        const float r = rs_[ai][m];
                        if (wc < 2) {
                            uint2 o1, o2; rope4(acc[ai][0][m][0] * r, acc[ai][0][m][1] * r, tb[m][0], tb[m][1], o1, o2);
                            bf16_t* d = IK + (size_t)row * 64 + 16 * wc + 4 * fq; *(uint2*)d = o1; *(uint2*)(d + 32) = o2;
                        } else if (wc == 2 && fq < 2) {
                            *(f32x4*)(IW + (size_t)row * 8 + 4 * fq) = acc[ai][0][m][0] * r;
                        }
                    }
                }
            }
        } else {
            const int head = (u.pn - 15) >> 1;
#pragma unroll
            for (int ai = 0; ai < 2; ++ai)
#pragma unroll
                for (int mh = 0; mh < 2; ++mh) {
                    uint2 yv[2][2][2]; float ysq[2];
#pragma unroll
                    for (int m2 = 0; m2 < 2; ++m2) {
                        const int row = EPI_ROW(ai, 2 * mh + m2); const int rr = row < MR ? row : 0;
                        ysq[m2] = ssqY[(size_t)rr * 4 + head];
#pragma unroll
                        for (int bj = 0; bj < 2; ++bj)
#pragma unroll
                            for (int n = 0; n < 2; ++n) yv[m2][bj][n] = *(const uint2*)(Y + (size_t)rr * 2048 + (u.pn - 15) * 256 + bj * 128 + wc * 32 + n * 16 + fq * 4);
                    }
#pragma unroll
                    for (int m2 = 0; m2 < 2; ++m2) {
                        const int m = 2 * mh + m2; const int row = EPI_ROW(ai, m);
                        if (row < MR) {
                            const float r = rs_[ai][m]; const float ys = rsqrtf(ysq[m2] * (1.f / 512.f) + EPSN);
#pragma unroll
                            for (int bj = 0; bj < 2; ++bj)
#pragma unroll
                                for (int n = 0; n < 2; ++n) {
                                    const int cin = (u.pn - 15) * 256 + bj * 128 + wc * 32 + n * 16 + fq * 4;
                                    const f32x4 y = unpack4(yv[m2][bj][n]); const f32x4 g = acc[ai][bj][m][n] * r;
                                    *(uint2*)(Y + (size_t)row * 2048 + cin) = pack4(silu_f(g[0]) * y[0] * ys, silu_f(g[1]) * y[1] * ys, silu_f(g[2]) * y[2] * ys, silu_f(g[3]) * y[3] * ys);
                                }
                        }
                    }
                }
        }
    }
};

struct EpiPlain {
    static constexpr bool PERM = false, AFTER_DRAIN = false;
    bf16_t* out;
    __device__ __forceinline__ void operator()(const f32x4 (&acc)[2][2][4][2], const pg8::Unit& u, int wr, int wc, int fr, int fq) const {
#pragma unroll
        for (int ai = 0; ai < 2; ++ai)
#pragma unroll
            for (int m = 0; m < 4; ++m) {
                const int row = EPI_ROW(ai, m);
#pragma unroll
                for (int bj = 0; bj < 2; ++bj)
#pragma unroll
                    for (int n = 0; n < 2; ++n) {
                        const int c0 = u.pn * 256 + bj * 128 + wc * 32 + n * 16 + fq * 4; const f32x4 a = acc[ai][bj][m][n];
                        *(uint2*)(out + (size_t)row * DM + c0) = pack4(a[0], a[1], a[2], a[3]);
                    }
            }
    }
};

struct EpiGate {
    static constexpr bool PERM = false, AFTER_DRAIN = false;
    const float* ssq1; bf16_t* yr; const bf16_t* ya;
    __device__ __forceinline__ void operator()(const f32x4 (&acc)[2][2][4][2], const pg8::Unit& u, int wr, int wc, int fr, int fq) const {
        EPI_RSTD(ssq1)
#pragma unroll
        for (int ai = 0; ai < 2; ++ai) {
            uint2 av[4][2], cv[4][2];
#pragma unroll
            for (int m = 0; m < 4; ++m)
#pragma unroll
                for (int bj = 0; bj < 2; ++bj) { const size_t o = (size_t)EPI_ROW(ai, m) * DM + u.pn * 128 + bj * 64 + wc * 16 + fq * 4; av[m][bj] = *(const uint2*)(yr + o); cv[m][bj] = *(const uint2*)(ya + o); }
#pragma unroll
            for (int m = 0; m < 4; ++m) {
                const float r = rs_[ai][m];
#pragma unroll
                for (int bj = 0; bj < 2; ++bj) {
                    const size_t o = (size_t)EPI_ROW(ai, m) * DM + u.pn * 128 + bj * 64 + wc * 16 + fq * 4;
                    const f32x4 gr = acc[ai][bj][m][0] * r, ga = acc[ai][bj][m][1] * r; const f32x4 a = unpack4(av[m][bj]), c = unpack4(cv[m][bj]);
                    *(uint2*)(yr + o) = pack4(sigm_f(gr[0]) * a[0] + sigm_f(ga[0]) * c[0], sigm_f(gr[1]) * a[1] + sigm_f(ga[1]) * c[1],
                                              sigm_f(gr[2]) * a[2] + sigm_f(ga[2]) * c[2], sigm_f(gr[3]) * a[3] + sigm_f(ga[3]) * c[3]);
                }
            }
        }
    }
};
template <class Map>
__device__ __forceinline__ void convert_w(int K, int N, bf16_t* Wt, int Nd, const float* gain, Map map, unsigned char* smem) {
    bf16_t* tile = (bf16_t*)smem;
    const int tid = threadIdx.x; const int ntk = K / 256, nt = (Nd / 64) * ntk;
    for (int t = blockIdx.x; t < nt; t += gridDim.x) {
        const int n0 = (t / ntk) * 64, k0 = (t % ntk) * 256;
        const int kr = tid >> 4, nq = tid & 15;
        const float* W = nullptr; const int src = map(n0 + 4 * nq, W);
        float4 v[8];
#pragma unroll
        for (int p = 0; p < 8; ++p) { v[p] = make_float4(0.f, 0.f, 0.f, 0.f); if (src >= 0) v[p] = *(const float4*)(W + (size_t)(k0 + kr + 32 * p) * N + src); }
#pragma unroll
        for (int p = 0; p < 8; ++p) {
            const int kl = kr + 32 * p; const float g = gain ? gain[k0 + kl] : 1.f;
            bf16_t* tl = tile + (kl >> 6) * (64 * 72) + (kl & 63);
            tl[(4 * nq + 0) * 72] = f2bf(v[p].x * g); tl[(4 * nq + 1) * 72] = f2bf(v[p].y * g); tl[(4 * nq + 2) * 72] = f2bf(v[p].z * g); tl[(4 * nq + 3) * 72] = f2bf(v[p].w * g);
        }
        __syncthreads();
        const int nl = tid >> 3, kc = tid & 7;
#pragma unroll
        for (int q = 0; q < 4; ++q) *(uint4*)(Wt + (size_t)(n0 + nl) * K + k0 + 64 * q + 8 * kc) = *(const uint4*)(tile + q * (64 * 72) + nl * 72 + 8 * kc);
        __syncthreads();
    }
}
__device__ __forceinline__ int rope_nat(int c, int dbits) {
    const int g = c >> 5, hi = (c >> 4) & 1, i = c & 15; return (hi << (dbits - 1)) + 16 * g + i;
}

__device__ __forceinline__ void p0_prologue(const Args& A, unsigned char* smem) {
    unsigned char* ws = A.ws;
    const int tid = threadIdx.x, lane = tid & 63, wave = tid >> 6;
    const size_t gtid = (size_t)blockIdx.x * 512 + tid, gsz = (size_t)gridDim.x * 512;
    for (size_t i = gtid; i < ZERO_BYTES / 16; i += gsz) ((uint4*)(ws + WS_ZERO))[i] = make_uint4(0, 0, 0, 0);
    {
        bf16_t* xb = (bf16_t*)A.out; float* ssq0 = (float*)(ws + OFF_SSQ0);
        const int gw = blockIdx.x * 8 + wave, ngw = gridDim.x * 8;
        for (int row = gw; row < MP; row += ngw) {
            const float* src = row < MR ? A.in[0] + (size_t)row * DM : (row < MR + NMETA ? A.in[1] + (size_t)(row - MR) * DM : nullptr);
            float s = 0.f;
#pragma unroll
            for (int j = 0; j < 4; ++j) {
                float4 v = make_float4(0.f, 0.f, 0.f, 0.f);
                if (src) v = ((const float4*)src)[lane + 64 * j];
                s += (v.x * v.x + v.y * v.y) + (v.z * v.z + v.w * v.w);
                *(uint2*)(xb + (size_t)row * DM + 4 * (lane + 64 * j)) = pack4(v.x, v.y, v.z, v.w);
            }
            s = wave_sum(s);
            if (lane == 0) ssq0[row] = s;
        }
    }
    { uint4* hp = (uint4*)(ws + OFF_H1B + (size_t)(MR + NMETA) * DM * 2); for (size_t i = gtid; i < (size_t)(MP - MR - NMETA) * DM * 2 / 16; i += gsz) hp[i] = make_uint4(0, 0, 0, 0); }
    {
        float2* t256 = (float2*)(ws + OFF_TAB256); float2* t128 = (float2*)(ws + OFF_TAB128); float2* t64 = (float2*)(ws + OFF_TAB64);
        for (size_t i = gtid; i < (size_t)2064 * 128; i += gsz) {
            const int pos = (int)(i >> 7), j = (int)(i & 127);
            const float inv = exp2f(-(float)j * (13.287712379549449f / 128.f));
            const float ang = (float)pos * inv;
            const double a = (double)ang; const double k = __builtin_rint(a * 0.15915494309189535);
            const double rr = a - k * 6.283185307179586; const double x = rr * 0.25, x2 = x * x;
            double s = x * (1.0 - x2 * (1.0 / 6.0) * (1.0 - x2 * (1.0 / 20.0) * (1.0 - x2 * (1.0 / 42.0) * (1.0 - x2 * (1.0 / 72.0) * (1.0 - x2 * (1.0 / 110.0) * (1.0 - x2 * (1.0 / 156.0)))))));
            double c = 1.0 - x2 * 0.5 * (1.0 - x2 * (1.0 / 12.0) * (1.0 - x2 * (1.0 / 30.0) * (1.0 - x2 * (1.0 / 56.0) * (1.0 - x2 * (1.0 / 90.0) * (1.0 - x2 * (1.0 / 132.0) * (1.0 - x2 * (1.0 / 182.0)))))));
            const double s2 = 2.0 * s * c, c2 = c * c - s * s; const double s4 = 2.0 * s2 * c2, c4 = c2 * c2 - s2 * s2;
            const float2 o = make_float2((float)c4, (float)s4);
            t256[i] = o;
            if ((j & 1) == 0) t128[(size_t)pos * 64 + (j >> 1)] = o;
            if ((j & 3) == 0) t64[(size_t)pos * 32 + (j >> 2)] = o;
        }
    }
    const float* w_in = A.in[7];
    convert_w(DM, DFF, (bf16_t*)(ws + OFF_W1), 5632, A.in[2], [&](int n, const float*& W) { W = ((n >> 4) & 1) ? A.in[4] : A.in[3]; return 16 * (n >> 5) + (n & 15); }, smem);
    convert_w(DFF, DM, (bf16_t*)(ws + OFF_WD1), 1024, nullptr, [&](int n, const float*& W) { W = A.in[5]; return n; }, smem);
    convert_w(DM, DIN, (bf16_t*)(ws + OFF_WINA), 4096, A.in[6], [&](int n, const float*& W) { W = w_in;
        if (n < 2048) return (n < 1024 ? O_RQ : O_RK) + ((n & 1023) >> 8) * 256 + rope_nat(n & 255, 8);
        return O_RV + (n - 2048); }, smem);
    convert_w(DM, DIN, (bf16_t*)(ws + OFF_WINB), 5888, A.in[6], [&](int n, const float*& W) { W = w_in;
        if (n < 2048) return (n < 1024 ? O_AQ : O_AK) + ((n & 1023) >> 7) * 128 + rope_nat(n & 127, 7);
        if (n < 3072) return O_AV + (n - 2048);
        if (n < 3584) return O_IQ + ((n - 3072) >> 6) * 64 + rope_nat((n - 3072) & 63, 6);
        if (n < 3648) return O_IK + rope_nat(n - 3584, 6);
        if (n < 3656) return O_IW + (n - 3648);
        if (n < 3840) return -1;
        return O_RG + (n - 3840); }, smem);
    convert_w(DM, DIN, (bf16_t*)(ws + OFF_WINC), 2048, A.in[6], [&](int n, const float*& W) { W = w_in; return (((n >> 4) & 1) ? O_GA : O_GR) + 16 * (n >> 5) + (n & 15); }, smem);
    convert_w(2048, DM, (bf16_t*)(ws + OFF_WRO), 1024, nullptr, [&](int n, const float*& W) { W = A.in[8]; return n; }, smem);
    convert_w(DM, DM, (bf16_t*)(ws + OFF_WAO), 1024, nullptr, [&](int n, const float*& W) { W = A.in[9]; return n; }, smem);
    convert_w(DM, DM, (bf16_t*)(ws + OFF_WMX), 1024, nullptr, [&](int n, const float*& W) { W = A.in[10]; return n; }, smem);
    convert_w(DM, DFF, (bf16_t*)(ws + OFF_W2), 5632, A.in[11], [&](int n, const float*& W) { W = ((n >> 4) & 1) ? A.in[13] : A.in[12]; return 16 * (n >> 5) + (n & 15); }, smem);
    convert_w(DFF, DM, (bf16_t*)(ws + OFF_WD2), 1024, nullptr, [&](int n, const float*& W) { W = A.in[14]; return n; }, smem);
}

template <int DQK, int DV, int RB, bool SOFTMAX, int NSTG>
__device__ __forceinline__ void flash_unit(const bf16_t* __restrict__ Q, int ldq, const bf16_t* __restrict__ Kb, int ldk, const bf16_t* __restrict__ Vt,
                                           bf16_t* Out, int ldo, int qpos0, int kt_lo, int kt_hi, const u64* __restrict__ mask64, float p0, float* ssqY, unsigned char* smem) {
    constexpr int KCH = DQK / 8, NKD = KCH / 8, NVD = DV / 64, NKS = DQK / 32, NNB = DV / 16;
    constexpr int KBYTES = 64 * DQK * 2, STAGE = KBYTES + DV * 64 * 2;
    const int tid = threadIdx.x, lane = tid & 63, w = __builtin_amdgcn_readfirstlane(tid >> 6), fr = lane & 15, quad = lane >> 4;
    bf16x8 qf[RB][NKS];
#pragma unroll
    for (int rb = 0; rb < RB; ++rb)
#pragma unroll
        for (int ks = 0; ks < NKS; ++ks) qf[rb][ks] = *(const bf16x8*)(Q + (size_t)(w * 16 * RB + rb * 16 + fr) * ldq + ks * 32 + quad * 8);
    f32x4 o[NNB][RB];
#pragma unroll
    for (int nb = 0; nb < NNB; ++nb)
#pragma unroll
        for (int rb = 0; rb < RB; ++rb) o[nb][rb] = (f32x4){0.f, 0.f, 0.f, 0.f};
    float mrun[RB], lrun[RB];
#pragma unroll
    for (int rb = 0; rb < RB; ++rb) { mrun[rb] = -INFINITY; lrun[rb] = 0.f; }
    PG8_LAS unsigned char* lds = (PG8_LAS unsigned char*)smem;
    int koff[4], voff[4];
    float bk[4][4];
#pragma unroll
    for (int kb = 0; kb < 4; ++kb)
#pragma unroll
        for (int j = 0; j < 4; ++j) bk[kb][j] = SOFTMAX ? 1.f : __builtin_amdgcn_exp2f(-(float)(kb * 16 + quad * 4 + j) * p0);
#pragma unroll
    for (int a = 0; a < 4; ++a) { koff[a] = (fr * KCH + ((a * 4) ^ quad ^ fr)) * 16; voff[a] = (fr * 8 + (((a & 1) * 4) ^ quad ^ ((fr >> 1) & 7))) * 16; }
#define FL_DMA(KT, BUF) do { \
    _Pragma("unroll") for (int i = 0; i < NKD; ++i) { const int gi = (i * 8 + w) * 64 + lane, r = gi / KCH, cc = (gi % KCH) ^ (r & 15); int t = 64 * (KT) + r; t = t < TT ? t : TT - 1; \
        __builtin_amdgcn_global_load_lds((const unsigned*)(Kb + (size_t)t * ldk + cc * 8), (PG8_LAS unsigned*)(lds + (BUF) * STAGE + (i * 8 + w) * 1024), 16, 0, 0); } \
    _Pragma("unroll") for (int i = 0; i < NVD; ++i) { const int gi = (i * 8 + w) * 64 + lane, r = gi >> 3, cc = (gi & 7) ^ ((r >> 1) & 7); int t = 64 * (KT) + 8 * cc; t = t < TP ? t : TP - 8; \
        __builtin_amdgcn_global_load_lds((const unsigned*)(Vt + (size_t)r * TP + t), (PG8_LAS unsigned*)(lds + (BUF) * STAGE + KBYTES + (i * 8 + w) * 1024), 16, 0, 0); } } while (0)
    constexpr int NDMA = NKD + NVD;
    PG8_LAS u64* mlds = (PG8_LAS u64*)(lds + NSTG * STAGE);
    if (SOFTMAX) {
        constexpr int NR = 16 * RB * 8;
        for (int i = tid; i < NR * 33; i += 512) { const int r = i / 33, c = i % 33; mlds[c * NR + r] = mask64[(size_t)r * 33 + c]; }
    }
    FL_DMA(kt_lo, 0);
#pragma unroll
    for (int p = 1; p < NSTG - 1; ++p) if (kt_lo + p <= kt_hi) FL_DMA(kt_lo + p, p);
    int cur = 0;
    for (int kt = kt_lo; kt <= kt_hi; ++kt) {
        if (NSTG == 2 || kt + NSTG - 2 > kt_hi) asm volatile("s_waitcnt vmcnt(0)" ::: "memory");
        else if (NSTG == 3) asm volatile("s_waitcnt vmcnt(%0)" :: "n"(NDMA) : "memory");
        else asm volatile("s_waitcnt vmcnt(%0)" :: "n"(2 * NDMA) : "memory");
        __syncthreads();
        { const int nb_ = cur == 0 ? NSTG - 1 : cur - 1; if (kt + NSTG - 1 <= kt_hi) FL_DMA(kt + NSTG - 1, nb_); }
        const PG8_LAS unsigned char* Ks = lds + cur * STAGE; const PG8_LAS unsigned char* Vs = Ks + KBYTES;
        cur = (cur + 1 == NSTG) ? 0 : cur + 1;
        const PG8_LAS unsigned char* kp[4]; const PG8_LAS unsigned char* vp4[4];
#pragma unroll
        for (int a = 0; a < 4; ++a) { kp[a] = Ks + koff[a]; vp4[a] = Vs + voff[a]; }
        u64 mw[RB];
        if (SOFTMAX) {
#pragma unroll
            for (int rb = 0; rb < RB; ++rb) mw[rb] = mlds[kt * (16 * RB * 8) + w * 16 * RB + rb * 16 + fr];
        }
        f32x4 s[4][RB];
#pragma unroll
        for (int kb = 0; kb < 4; ++kb)
#pragma unroll
            for (int rb = 0; rb < RB; ++rb) s[kb][rb] = (f32x4){0.f, 0.f, 0.f, 0.f};
        {
            constexpr int GPK = NKS / 4, NGS = 4 * GPK;
            bf16x8 fg[3][4];
#define FL_LDK(G) do { _Pragma("unroll") for (int q4 = 0; q4 < 4; ++q4) { const int ks_ = ((G) % GPK) * 4 + q4; \
                fg[(G) % 3][q4] = *(const PG8_LAS bf16x8*)(kp[ks_ & 3] + ((G) / GPK) * 16 * KCH * 16 + (ks_ >> 2) * 256); } } while (0)
            FL_LDK(0); if (NGS > 1) FL_LDK(1);
#pragma unroll
            for (int g = 0; g < NGS; ++g) {
                if (g + 2 < NGS) FL_LDK(g + 2);
                __builtin_amdgcn_sched_barrier(0);
#pragma unroll
                for (int q4 = 0; q4 < 4; ++q4)
#pragma unroll
                    for (int rb = 0; rb < RB; ++rb) s[g / GPK][rb] = __builtin_amdgcn_mfma_f32_16x16x32_bf16(fg[g % 3][q4], qf[rb][(g % GPK) * 4 + q4], s[g / GPK][rb], 0, 0, 0);
                __builtin_amdgcn_sched_barrier(0);
            }
        }
        bf16x8 pa[RB][2];
#pragma unroll
        for (int rb = 0; rb < RB; ++rb) {
            const int qpos = qpos0 + w * 16 * RB + rb * 16 + fr;
            float p[4][4];
            if (SOFTMAX) {
                const u64 mq = mw[rb] >> (quad * 4);
                const unsigned mlo = (unsigned)mq, mhi = (unsigned)(mq >> 32);
                float tmax = -INFINITY;
#pragma unroll
                for (int kb = 0; kb < 4; ++kb)
#pragma unroll
                    for (int j = 0; j < 4; ++j) {
                        const unsigned wsel = (kb < 2) ? mlo : mhi; const unsigned bitm = 1u << ((kb & 1) * 16 + j);
                        const float v = (wsel & bitm) ? s[kb][rb][j] : -INFINITY;
                        p[kb][j] = v; tmax = fmaxf(tmax, v);
                    }
                tmax = fmaxf(tmax, __shfl_xor(tmax, 16)); tmax = fmaxf(tmax, __shfl_xor(tmax, 32));
                const float tm = tmax * p0;
                if (__ballot(tm > mrun[rb] + 8.f) != 0ull) {
                    const float mnew = fmaxf(mrun[rb], tm); const float msafe = (mnew == -INFINITY) ? 0.f : mnew;
                    const float alpha = __builtin_amdgcn_exp2f(mrun[rb] - msafe);
                    lrun[rb] *= alpha; mrun[rb] = mnew;
#pragma unroll
                    for (int nb = 0; nb < NNB; ++nb) o[nb][rb] *= alpha;
                }
                const float mref = (mrun[rb] == -INFINITY) ? 0.f : mrun[rb];
                float ps = 0.f;
#pragma unroll
                for (int kb = 0; kb < 4; ++kb)
#pragma unroll
                    for (int j = 0; j < 4; ++j) { const float e = __builtin_amdgcn_exp2f(fmaf(p[kb][j], p0, -mref)); p[kb][j] = e; ps += e; }
                lrun[rb] += ps;
            } else {
                const float aq = __builtin_amdgcn_exp2f((float)(qpos - 64 * kt) * p0);
                if (64 * kt + 63 > qpos0 + w * 16 * RB) {
#pragma unroll
                    for (int kb = 0; kb < 4; ++kb)
#pragma unroll
                        for (int j = 0; j < 4; ++j) { const int kpos = 64 * kt + kb * 16 + quad * 4 + j; p[kb][j] = (kpos <= qpos) ? s[kb][rb][j] * (aq * bk[kb][j]) : 0.f; }
                } else {
#pragma unroll
                    for (int kb = 0; kb < 4; ++kb)
#pragma unroll
                        for (int j = 0; j < 4; ++j) p[kb][j] = s[kb][rb][j] * (aq * bk[kb][j]);
                }
                if (kt == 0) {
#pragma unroll
                    for (int kb = 0; kb < 3; ++kb)
#pragma unroll
                        for (int j = 0; j < 4; ++j) p[kb][j] = 0.f;
                }
            }
#pragma unroll
            for (int i = 0; i < 2; ++i) {
                union { bf16x8 v; unsigned u[4]; } t;
                t.u[0] = cvt_pk_bf16(p[2 * i][0], p[2 * i][1]); t.u[1] = cvt_pk_bf16(p[2 * i][2], p[2 * i][3]);
                t.u[2] = cvt_pk_bf16(p[2 * i + 1][0], p[2 * i + 1][1]); t.u[3] = cvt_pk_bf16(p[2 * i + 1][2], p[2 * i + 1][3]);
                pa[rb][i] = t.v;
            }
        }
        {
            constexpr int GPI = NNB / 4, NGV = 2 * GPI;
            bf16x8 vg[3][4];
#define FL_LDV(G) do { _Pragma("unroll") for (int q4 = 0; q4 < 4; ++q4) { const int nb_ = ((G) % GPI) * 4 + q4, i_ = (G) / GPI; \
                vg[(G) % 3][q4] = *(const PG8_LAS bf16x8*)(vp4[i_] + nb_ * 2048); } } while (0)
            FL_LDV(0); FL_LDV(1);
#pragma unroll
            for (int g = 0; g < NGV; ++g) {
                if (g + 2 < NGV) FL_LDV(g + 2);
                __builtin_amdgcn_sched_barrier(0);
#pragma unroll
                for (int q4 = 0; q4 < 4; ++q4)
#pragma unroll
                    for (int rb = 0; rb < RB; ++rb) o[(g % GPI) * 4 + q4][rb] = __builtin_amdgcn_mfma_f32_16x16x32_bf16(vg[g % 3][q4], pa[rb][g / GPI], o[(g % GPI) * 4 + q4][rb], 0, 0, 0);
                __builtin_amdgcn_sched_barrier(0);
            }
        }
    }
#pragma unroll
    for (int rb = 0; rb < RB; ++rb) {
        const int qrow = w * 16 * RB + rb * 16 + fr;
        float scale = 1.f;
        if (SOFTMAX) { float l = lrun[rb]; l += __shfl_xor(l, 16); l += __shfl_xor(l, 32); scale = 1.f / l; }
        float part = 0.f;
#pragma unroll
        for (int nb = 0; nb < NNB; ++nb) {
            const f32x4 v = o[nb][rb] * scale;
            part += (v[0] * v[0] + v[1] * v[1]) + (v[2] * v[2] + v[3] * v[3]);
            *(uint2*)(Out + (size_t)qrow * ldo + nb * 16 + quad * 4) = pack4(v[0], v[1], v[2], v[3]);
        }
        if (!SOFTMAX) { part += __shfl_xor(part, 16); part += __shfl_xor(part, 32); if (quad == 0) atomicAdd(ssqY + (size_t)qrow * 4, part); }
    }
}

__device__ __forceinline__ unsigned next_unit(unsigned* ctr, unsigned char* smem) {
    volatile unsigned* sh = (volatile unsigned*)(smem + LDS_CTL);
    __syncthreads();
    if (threadIdx.x == 0) *sh = atomicAdd(ctr, 1u);
    __syncthreads();
    return (unsigned)__builtin_amdgcn_readfirstlane((int)*sh);
}

__device__ __forceinline__ void retention_unit(const Args& A, unsigned char* smem, int b, int h, int qb, int dvh) {
    unsigned char* ws = A.ws;
    const bf16_t* RQ = (const bf16_t*)(ws + OFF_RQ); const bf16_t* RKs = (const bf16_t*)(ws + OFF_RKS); const bf16_t* RVt = (const bf16_t*)(ws + OFF_RVT);
    bf16_t* Y = (bf16_t*)A.out; float* ssqY = (float*)(ws + OFF_SSQY);
    const int s0 = 128 * qb, row0 = b * SEQ + s0, qpos0 = SPOS0 + NMETA + s0;
    const float l2g = A.l2g[h]; const int cut = (int)(40.f / -l2g);
    int kt_lo = (qpos0 - cut) / 64; if (qpos0 < cut) kt_lo = 0;
    flash_unit<256, 256, 1, false, 2>(RQ + (size_t)row0 * 1024 + h * 256, 1024, RKs + (size_t)b * TP * 1024 + h * 256, 1024, RVt + ((size_t)(b * 4 + h) * 512 + dvh * 256) * TP,
                                      Y + (size_t)row0 * 2048 + h * 512 + dvh * 256, 2048, qpos0, kt_lo, (qpos0 + 127) / 64, nullptr, l2g, ssqY + (size_t)row0 * 4 + h, smem);
}
__device__ __forceinline__ void retention_phase(const Args& A, unsigned char* smem) {
    if (gridDim.x == 256) {
        const int b = blockIdx.x & 7, c = blockIdx.x >> 3, dvh = c & 1, j = c >> 1;
        for (int r = 0; r < 4; ++r) { __syncthreads(); retention_unit(A, smem, b, 3 - r, (r & 1) ? 15 - j : j, dvh); }
    } else {
        unsigned* ctr = (unsigned*)(A.ws + OFF_CTR) + 0;
        for (;;) { const unsigned u = next_unit(ctr, smem); if (u >= 1024u) break;
            const int rest = (int)(u & 63); retention_unit(A, smem, rest >> 3, (rest >> 1) & 3, 15 - (int)(u >> 6), rest & 1); }
    }
}
__device__ __forceinline__ void attention_unit(const Args& A, unsigned char* smem, int b, int h, int qb) {
    unsigned char* ws = A.ws;
    bf16_t* AQ = (bf16_t*)(ws + OFF_AQ); const bf16_t* AKs = (const bf16_t*)(ws + OFF_AKS); const bf16_t* AVt = (const bf16_t*)(ws + OFF_AVT);
    const u64* mask64 = (const u64*)(ws + OFF_MASK);
    const int s0 = 128 * qb, row0 = b * SEQ + s0, qpos0 = SPOS0 + NMETA + s0;
    flash_unit<128, 128, 1, true, 3>(AQ + (size_t)row0 * 1024 + h * 128, 1024, AKs + (size_t)b * TP * 1024 + h * 128, 1024, AVt + (size_t)(b * 8 + h) * 128 * TP,
                                     AQ + (size_t)row0 * 1024 + h * 128, 1024, qpos0, 0, (qpos0 + 127) / 64, mask64 + (size_t)row0 * 33, 0.08838834764831845f * 1.4426950408889634f, nullptr, smem);
}
__device__ __forceinline__ void attention_phase(const Args& A, unsigned char* smem) {
    if (gridDim.x == 256) {
        const int b = blockIdx.x & 7, c = blockIdx.x >> 3;
        for (int r = 0; r < 4; ++r) { __syncthreads(); attention_unit(A, smem, b, 2 * r + (c >> 4), (r & 1) ? 15 - (c & 15) : (c & 15)); }
    } else {
        unsigned* ctr = (unsigned*)(A.ws + OFF_CTR) + 2;
        for (;;) { const unsigned u = next_unit(ctr, smem); if (u >= 1024u) break;
            const int bh = (int)(u & 63); attention_unit(A, smem, bh >> 3, bh & 7, 15 - (int)(u >> 6)); }
    }
}

__device__ __forceinline__ void cnt_ge_u32(int& c, unsigned a, unsigned b) { asm volatile("v_cmp_ge_u32 vcc, %1, %2\n\tv_addc_co_u32 %0, vcc, 0, %0, vcc" : "+v"(c) : "v"(a), "v"(b) : "vcc"); }
__device__ __forceinline__ void cnt_gt_u32(int& c, unsigned a, unsigned b) { asm volatile("v_cmp_gt_u32 vcc, %1, %2\n\tv_addc_co_u32 %0, vcc, 0, %0, vcc" : "+v"(c) : "v"(a), "v"(b) : "vcc"); }
__device__ __forceinline__ void cnt_eq_u32(int& c, unsigned a, unsigned b) { asm volatile("v_cmp_eq_u32 vcc, %1, %2\n\tv_addc_co_u32 %0, vcc, 0, %0, vcc" : "+v"(c) : "v"(a), "v"(b) : "vcc"); }
__device__ __forceinline__ void cnt_lt_i32(int& c, int a, int b) { asm volatile("v_cmp_lt_i32 vcc, %1, %2\n\tv_addc_co_u32 %0, vcc, 0, %0, vcc" : "+v"(c) : "v"(a), "v"(b) : "vcc"); }
__device__ __forceinline__ int sel_eq_idx(unsigned a, unsigned b, int idx) { int e; const int huge = 0x7fffffff; asm volatile("v_cmp_eq_u32 vcc, %1, %2\n\tv_cndmask_b32 %0, %3, %4, vcc" : "=v"(e) : "v"(a), "v"(b), "v"(huge), "v"(idx) : "vcc"); return e; }
__device__ __forceinline__ int sel_gt_m1(unsigned a, unsigned b, int e) { int v; const int m1 = -1; asm volatile("v_cmp_gt_u32 vcc, %1, %2\n\tv_cndmask_b32 %0, %3, %4, vcc" : "=v"(v) : "v"(a), "v"(b), "v"(e), "v"(m1) : "vcc"); return v; }
__device__ __forceinline__ void shl_in_le_i32(unsigned& nib, int a, int b) { asm volatile("v_cmp_le_i32 vcc, %1, %2\n\tv_addc_co_u32 %0, vcc, %0, %0, vcc" : "+v"(nib) : "v"(a), "v"(b) : "vcc"); }

template <int NP>
__device__ __forceinline__ int pk_count_ge(const unsigned (&x)[NP], unsigned cand) {
    const unsigned cm1 = (cand - 1u) * 0x00010001u, one = 0x00010001u;
    unsigned c = 0u;
#pragma unroll
    for (int m = 0; m < NP; ++m) {
        unsigned t;
        asm("v_pk_sub_u16 %0, %1, %2 clamp" : "=v"(t) : "v"(x[m]), "v"(cm1));
        asm("v_pk_min_u16 %0, %1, %2" : "=v"(t) : "v"(t), "v"(one));
        asm("v_pk_add_u16 %0, %1, %2" : "=v"(c) : "v"(c), "v"(t));
    }
    int v = (int)((c & 0xFFFFu) + (c >> 16));
    v += __builtin_amdgcn_update_dpp(0, v, 0x111, 0xf, 0xf, true);
    v += __builtin_amdgcn_update_dpp(0, v, 0x112, 0xf, 0xf, true);
    v += __builtin_amdgcn_update_dpp(0, v, 0x114, 0xf, 0xf, true);
    v += __builtin_amdgcn_update_dpp(0, v, 0x118, 0xf, 0xf, true);
    v += __builtin_amdgcn_update_dpp(0, v, 0x142, 0xa, 0xf, false);
    v += __builtin_amdgcn_update_dpp(0, v, 0x143, 0xc, 0xf, false);
    return __builtin_amdgcn_readlane(v, 63);
}

template <int NI>
__device__ __forceinline__ u64 select_query(const unsigned* skq, int lane) {
    unsigned uk[NI];
#pragma unroll
    for (int i = 0; i < NI; ++i) uk[i] = skq[64 * i + lane];
    unsigned hp[NI / 2];
#pragma unroll
    for (int m = 0; m < NI / 2; ++m) hp[m] = (uk[2 * m] >> 16) | (uk[2 * m + 1] & 0xFFFF0000u);
    unsigned T16 = 0u;
    for (int bit = 15; bit >= 0; --bit) {
        const unsigned cand = T16 | (1u << bit);
        if (pk_count_ge<NI / 2>(hp, cand) >= 256) T16 = cand;
    }
    const int cgt_hi = (T16 < 0xFFFFu) ? pk_count_ge<NI / 2>(hp, T16 + 1u) : 0;
    const int need_lo = 256 - cgt_hi;
#pragma unroll
    for (int m = 0; m < NI / 2; ++m) {
        const unsigned a = uk[2 * m], b2 = uk[2 * m + 1];
        const unsigned la = ((a >> 16) == T16) ? (a & 0xFFFFu) : 0u, lb = ((b2 >> 16) == T16) ? (b2 << 16) : 0u;
        hp[m] = la | lb;
    }
    unsigned L16 = 0u;
    for (int bit = 15; bit >= 0; --bit) {
        const unsigned cand = L16 | (1u << bit);
        if (pk_count_ge<NI / 2>(hp, cand) >= need_lo) L16 = cand;
    }
    const unsigned Tq = (T16 << 16) | L16;
    int cgt = 0;
#pragma unroll
    for (int i = 0; i < NI; ++i) cgt += __builtin_popcountll(__ballot(uk[i] > Tq));
    int rem = 256 - cgt;
    u64 myout = (lane == 0) ? (0xFFFFull << 48) : 0ull;
#pragma unroll
    for (int i = 0; i < NI; ++i) {
        const u64 gt = __ballot(uk[i] > Tq); u64 eq = __ballot(uk[i] == Tq);
        const int ce = __builtin_popcountll(eq);
        if (ce > rem) eq = __ballot(((eq >> lane) & 1ull) && (int)__builtin_amdgcn_mbcnt_hi((unsigned)(eq >> 32), __builtin_amdgcn_mbcnt_lo((unsigned)eq, 0u)) < rem);
        rem -= (ce > rem) ? rem : ce;
        const u64 sel = gt | eq;
        if (lane == i + 1) myout = sel;
    }
    return myout;
}

__device__ __forceinline__ void indexer_phase(const Args& A, unsigned char* smem) {
    unsigned char* ws = A.ws; unsigned* ctr = (unsigned*)(ws + OFF_CTR) + 1;
    const bf16_t* IQ = (const bf16_t*)(ws + OFF_IQ); const bf16_t* IK = (const bf16_t*)(ws + OFF_IK); const float* IW = (const float*)(ws + OFF_IW);
    u64* mask64 = (u64*)(ws + OFF_MASK);
    constexpr int SKS = 2052;
    unsigned* sk = (unsigned*)smem;
    const int tid = threadIdx.x, lane = tid & 63, w = __builtin_amdgcn_readfirstlane(tid >> 6), fr = lane & 15, quad = lane >> 4;
    for (;;) {
        const unsigned u = next_unit(ctr, smem); if (u >= 1024u) break;
        const int g = 127 - (int)(u >> 3), b = (int)(u & 7), s0 = 16 * g, row0 = b * SEQ + s0;
        const int nkeys = s0 + 16, ni = (nkeys + 63) >> 6;
        if (g >= 16) {
            { const int nz = 512 * ((ni + 7) >> 3) - nkeys; for (int i = tid; i < 16 * nz; i += 512) { const int r = i / nz, c = nkeys + (i % nz); sk[r * SKS + c] = 0u; } }
            bf16x8 qf[8][2];
#pragma unroll
            for (int h = 0; h < 8; ++h)
#pragma unroll
                for (int ks = 0; ks < 2; ++ks) qf[h][ks] = *(const bf16x8*)(IQ + (size_t)(row0 + fr) * 512 + h * 64 + ks * 32 + quad * 8);
            const float4 w0 = *(const float4*)(IW + (size_t)(row0 + fr) * 8), w1 = *(const float4*)(IW + (size_t)(row0 + fr) * 8 + 4);
            const float wq[8] = {w0.x, w0.y, w0.z, w0.w, w1.x, w1.y, w1.z, w1.w};
            const bf16_t* kbase = IK + (size_t)(b * SEQ + fr) * 64 + quad * 8;
            bf16x8 nk0 = *(const bf16x8*)(kbase + (size_t)(16 * w) * 64), nk1 = *(const bf16x8*)(kbase + (size_t)(16 * w) * 64 + 32);
            for (int kt = w; kt <= g; kt += 8) {
                const bf16x8 kf0 = nk0, kf1 = nk1;
                if (kt + 8 <= g) { nk0 = *(const bf16x8*)(kbase + (size_t)(16 * (kt + 8)) * 64); nk1 = *(const bf16x8*)(kbase + (size_t)(16 * (kt + 8)) * 64 + 32); }
                float sc[4] = {0.f, 0.f, 0.f, 0.f};
#pragma unroll
                for (int h = 0; h < 8; ++h) {
                    f32x4 c = __builtin_amdgcn_mfma_f32_16x16x32_bf16(kf0, qf[h][0], (f32x4){0.f, 0.f, 0.f, 0.f}, 0, 0, 0);
                    c = __builtin_amdgcn_mfma_f32_16x16x32_bf16(kf1, qf[h][1], c, 0, 0, 0);
#pragma unroll
                    for (int j = 0; j < 4; ++j) sc[j] += wq[h] * fmaxf(c[j], 0.f);
                }
                unsigned kk[4];
#pragma unroll
                for (int j = 0; j < 4; ++j) {
                    const int s = 16 * kt + quad * 4 + j;
                    const unsigned bits = __float_as_uint(sc[j] + 0.0f);
                    const unsigned ok = bits ^ ((unsigned)((int)bits >> 31) | 0x80000000u);
                    kk[j] = (s > s0 + fr) ? 0u : ok;
                }
                *(uint4*)(sk + fr * SKS + 16 * kt + quad * 4) = make_uint4(kk[0], kk[1], kk[2], kk[3]);
            }
        }
        __syncthreads();
#ifdef DUPB
#define NQQ 4
#else
#define NQQ 2
#endif
#pragma unroll 1
        for (int qq_ = 0; qq_ < NQQ; ++qq_) {
            const int qq = qq_ & 1; const int q = 2 * w + qq; const int sq = s0 + q;
            u64 myout = 0ull;
            if (g >= 16) {
                const unsigned* skq = sk + q * SKS;
                const int n8 = (ni + 7) >> 3;
                if (n8 == 1) myout = select_query<8>(skq, lane); else if (n8 == 2) myout = select_query<16>(skq, lane);
                else if (n8 == 3) myout = select_query<24>(skq, lane); else myout = select_query<32>(skq, lane);
            } else {
                const int lim = sq - 64 * (lane - 1);
                myout = lane == 0 ? (0xFFFFull << 48) : (lim >= 63 ? ~0ull : (lim < 0 ? 0ull : ((2ull << lim) - 1ull)));
            }
            if (lane < 33) mask64[(size_t)(row0 + q) * 33 + lane] = myout;
        }
    }
}


__device__ __forceinline__ void meta_down_phase(const Args& A, unsigned char* smem) {
    unsigned char* ws = A.ws;
    const bf16_t* act = (const bf16_t*)(ws + OFF_ACT); const bf16_t* Wd = (const bf16_t*)(ws + OFF_WD1);
    float* part = (float*)(ws + OFF_MPART); unsigned* ctr = (unsigned*)(ws + OFF_CTR) + 4;
    const int tid = threadIdx.x, lane = tid & 63, w = __builtin_amdgcn_readfirstlane(tid >> 6), fr = lane & 15, quad = lane >> 4;
    float* lred = (float*)smem;
    volatile unsigned* sh = (volatile unsigned*)(smem + LDS_CTL + 16);
    bool last = false;
    for (int task = blockIdx.x; task < 128; task += gridDim.x) {
        const int ct2 = task & 31, ksp = task >> 5;
        f32x4 acc0 = (f32x4){0.f, 0.f, 0.f, 0.f}, acc1 = acc0;
        for (int ks = w; ks < 22; ks += 8) {
            const int kb = ksp * 704 + ks * 32 + quad * 8;
            const bf16x8 af = *(const bf16x8*)(act + (size_t)(MR + fr) * DFF + kb);
            const bf16x8 b0 = *(const bf16x8*)(Wd + (size_t)(32 * ct2 + fr) * DFF + kb), b1 = *(const bf16x8*)(Wd + (size_t)(32 * ct2 + 16 + fr) * DFF + kb);
            acc0 = __builtin_amdgcn_mfma_f32_16x16x32_bf16(af, b0, acc0, 0, 0, 0);
            acc1 = __builtin_amdgcn_mfma_f32_16x16x32_bf16(af, b1, acc1, 0, 0, 0);
        }
        __syncthreads();
#pragma unroll
        for (int j = 0; j < 4; ++j) { lred[(w * 16 + quad * 4 + j) * 32 + fr] = acc0[j]; lred[(w * 16 + quad * 4 + j) * 32 + 16 + fr] = acc1[j]; }
        __syncthreads();
        { float v = 0.f;
#pragma unroll
          for (int ww = 0; ww < 8; ++ww) v += lred[ww * 512 + tid];
          part[((size_t)ksp * 16 + (tid >> 5)) * DM + 32 * ct2 + (tid & 31)] = v; }
        __threadfence();
        __syncthreads();
        if (tid == 0) { const unsigned old = atomicAdd(ctr, 1u); *sh = (old == 127u) ? 1u : 0u; }
        __syncthreads();
        if (*sh) last = true;
    }
    if (last) {
        __threadfence();
        bf16_t* h1b = (bf16_t*)(ws + OFF_H1B); float* ssq1 = (float*)(ws + OFF_SSQ1);
#pragma unroll
        for (int rr = 0; rr < 2; ++rr) {
            const int m = 2 * w + rr; float s = 0.f;
#pragma unroll
            for (int j = 0; j < 4; ++j) {
                const int c = 4 * (lane + 64 * j);
                const float4 mv = *(const float4*)(A.in[1] + (size_t)m * DM + c);
                float hv[4] = {0.f, 0.f, 0.f, 0.f};
#pragma unroll
                for (int q = 0; q < 4; ++q)
#pragma unroll
                    for (int e = 0; e < 4; ++e) hv[e] += __hip_atomic_load(part + ((size_t)q * 16 + m) * DM + c + e, __ATOMIC_RELAXED, __HIP_MEMORY_SCOPE_AGENT);
                const float h0 = mv.x + 0.5f * hv[0], h1 = mv.y + 0.5f * hv[1], h2 = mv.z + 0.5f * hv[2], h3 = mv.w + 0.5f * hv[3];
                s += (h0 * h0 + h1 * h1) + (h2 * h2 + h3 * h3);
                *(uint2*)(h1b + (size_t)(MR + m) * DM + c) = pack4(h0, h1, h2, h3);
            }
            s = wave_sum(s);
            if (lane == 0) atomicAdd(ssq1 + MR + m, s);
        }
    }
    __syncthreads();
}
#define LAS __attribute__((address_space(3)))
#define XB_TMO      128
#define XB_XCNT(j)  (256  + 64 * (j))
#define XB_XSUB(j)  (1280 + 64 * (j))
#define XB_XGEN(j)  (2304 + 64 * (j))
#define XB_TOP      3328
#define XB_TOPGEN   3392
#define XCD_BAR_WORDS 3456
#define XB_SPIN_CAP (1u << 18)

__device__ __forceinline__ unsigned xb_ld(unsigned* p)              { return __hip_atomic_load(p, __ATOMIC_RELAXED, __HIP_MEMORY_SCOPE_AGENT); }
__device__ __forceinline__ unsigned xb_add(unsigned* p, unsigned v) { return __hip_atomic_fetch_add(p, v, __ATOMIC_RELAXED, __HIP_MEMORY_SCOPE_AGENT); }
__device__ __forceinline__ unsigned xb_xcc_id() { return (unsigned)__builtin_amdgcn_s_getreg((3 << 11) | 20) & 0xFu; }
#define XB_SPIN(cond, bar) do { unsigned _sp = 0; while (cond) { __builtin_amdgcn_s_sleep(1); \
    if ((++_sp & 255u) == 0u) { if (xb_ld(&(bar)[XB_TMO])) break; if (_sp > XB_SPIN_CAP) { atomicAdd(&(bar)[XB_TMO], 1u); break; } } } } while (0)

struct XcdBarrier {
    unsigned* bar; unsigned x;
    volatile LAS unsigned* st;
};

__device__ __forceinline__ XcdBarrier xcd_barrier_post(unsigned* bar, volatile LAS unsigned* st) {
    XcdBarrier b; b.bar = bar; b.x = xb_xcc_id(); b.st = st;
    if (threadIdx.x == 0) (void)xb_add(&bar[XB_XCNT(b.x)], 1u);
    return b;
}
__device__ __forceinline__ void xcd_barrier_complete(unsigned* bar, unsigned x, unsigned& nloc, unsigned& nx) {
    const unsigned G = gridDim.x * gridDim.y * gridDim.z;
    unsigned sum, cnt, mine, sp = 0u;
    for (;;) {
        sum = 0u; cnt = 0u; mine = 0u;
#pragma unroll
        for (unsigned j = 0; j < 16; ++j) { const unsigned c = xb_ld(&bar[XB_XCNT(j)]); sum += c; cnt += (c > 0u) ? 1u : 0u; mine = (j == x) ? c : mine; }
        if (sum == G) break;
        __builtin_amdgcn_s_sleep(1);
        if ((++sp & 255u) == 0u) { if (xb_ld(&bar[XB_TMO])) break; if (sp > XB_SPIN_CAP) { atomicAdd(&bar[XB_TMO], 1u); break; } }
    }
    nloc = mine > 0u ? mine : 1u; nx = cnt > 0u ? cnt : 1u;
}

__device__ __forceinline__ void xcd_barrier(const XcdBarrier& b) {
    asm volatile("s_waitcnt vmcnt(0)" ::: "memory");
    __syncthreads();
    if (threadIdx.x == 0) {
        unsigned* bar = b.bar;
        __builtin_amdgcn_s_waitcnt(0);
        unsigned nloc = b.st[0], nx = b.st[1];
        if (nloc == 0u) { xcd_barrier_complete(bar, b.x, nloc, nx); b.st[0] = nloc; b.st[1] = nx; }
        const unsigned old = xb_add(&bar[XB_XSUB(b.x)], 1u);
        const unsigned gen = old / nloc;
        if (old + 1u == (gen + 1u) * nloc) {
            __builtin_amdgcn_fence(__ATOMIC_RELEASE, "agent");
            asm volatile("s_waitcnt vmcnt(0)" ::: "memory");
            const unsigned og = xb_add(&bar[XB_TOP], 1u);
            const unsigned tg = og / nx;
            if (og + 1u == (tg + 1u) * nx) xb_add(&bar[XB_TOPGEN], 1u);
            else XB_SPIN(xb_ld(&bar[XB_TOPGEN]) == tg, bar);
            __builtin_amdgcn_fence(__ATOMIC_ACQUIRE, "agent");
            xb_add(&bar[XB_XGEN(b.x)], 1u);
            asm volatile("s_waitcnt vmcnt(0)" ::: "memory");
        } else {
            XB_SPIN(xb_ld(&bar[XB_XGEN(b.x)]) == gen, bar);
            __builtin_amdgcn_fence(__ATOMIC_ACQUIRE, "agent");
            asm volatile("s_waitcnt vmcnt(0)" ::: "memory");
        }
    }
    __syncthreads();
}
#define GEMM_PHASE(EPI, e, Aptr, Bptr, Mrows, Ncols, Kdim) do { pg8::Gemm g_{(const bf16_t*)(Aptr), (const bf16_t*)(Bptr), (Mrows), (Ncols), (Kdim)}; pg8::StaticOrder S_; S_.init((Mrows), (Ncols), (int)gridDim.x, (int)blockIdx.x); \
    pg8::gemm_phase<EPI, pg8::StaticOrder, true, true>((PG8_LAS unsigned char*)smem, g_, S_, e); } while (0)

__global__ void __launch_bounds__(512, 2) mk_fwd(Args A) {
    extern __shared__ __attribute__((aligned(16))) unsigned char smem[];
    unsigned char* ws = A.ws;
    const int lo = A.ph_lo, hi = A.ph_hi;
    volatile LAS unsigned* xst = (volatile LAS unsigned*)((LAS unsigned char*)smem + LDS_CTL + 64);
    if (threadIdx.x < 2) xst[threadIdx.x] = 0u;
    __syncthreads();
    const XcdBarrier xbar = xcd_barrier_post((unsigned*)(ws + OFF_BAR), xst);
#ifndef PHMASK
#define PHMASK 0xFFFFF
#endif
#define IN(k) (((PHMASK >> (k)) & 1) && lo <= (k) && (k) < hi)
#if MK_COOP
#define SEAM(k) do { if (IN(k) && IN((k) + 1)) { if ((k) == 0) cg::this_grid().sync(); else xcd_barrier(xbar); } } while (0)
#else
#define SEAM(k) do { } while (0)
#endif
#ifdef PROBE_PHASE
    unsigned long long pt0 = 0, pt1 = 0;
#define PSTAMP(k) do { if ((k) == PROBE_PHASE) pt0 = __builtin_amdgcn_s_memrealtime(); if ((k) == PROBE_PHASE + 1) pt1 = __builtin_amdgcn_s_memrealtime(); } while (0)
#else
#define PSTAMP(k) do { } while (0)
#endif
    float* ssq0 = (float*)(ws + OFF_SSQ0); float* ssq1 = (float*)(ws + OFF_SSQ1); float* ssq2 = (float*)(ws + OFF_SSQ2); float* ssq3 = (float*)(ws + OFF_SSQ3); float* ssqY = (float*)(ws + OFF_SSQY);
    bf16_t* h1b = (bf16_t*)(ws + OFF_H1B); bf16_t* delta = (bf16_t*)(ws + OFF_DELTA);
    PSTAMP(0);
    if (IN(0)) { p0_prologue(A, smem); }
    SEAM(0);
    PSTAMP(1);
    if (IN(1)) { EpiSwiGLU e{(bf16_t*)(ws + OFF_ACT), ssq0}; GEMM_PHASE(EpiSwiGLU, e, A.out, ws + OFF_W1, MP, 5632, DM); }
    SEAM(1);
    PSTAMP(2);
    if (IN(2)) { meta_down_phase(A, smem); EpiResid e{A.in[0], nullptr, nullptr, nullptr, h1b, delta, ssq1, 0.5f}; GEMM_PHASE(EpiResid, e, ws + OFF_ACT, ws + OFF_WD1, MR, DM, DFF); }
    SEAM(2);
    PSTAMP(3);
    if (IN(3)) { EpiRet e{ssq1, (const float2*)(ws + OFF_TAB256), (bf16_t*)(ws + OFF_RQ), (bf16_t*)(ws + OFF_RKS), (bf16_t*)(ws + OFF_RVT)}; GEMM_PHASE(EpiRet, e, h1b, ws + OFF_WINA, MP, 4096, DM); }
    SEAM(3);
    PSTAMP(4);
    if (IN(4)) { retention_phase(A, smem); }
    SEAM(4);
    PSTAMP(5);
    if (IN(5)) { EpiAtt e{ssq1, (const float2*)(ws + OFF_TAB128), (const float2*)(ws + OFF_TAB64), ssqY, (bf16_t*)(ws + OFF_AQ), (bf16_t*)(ws + OFF_AKS), (bf16_t*)(ws + OFF_AVT),
                          (bf16_t*)(ws + OFF_IQ), (bf16_t*)(ws + OFF_IK), (float*)(ws + OFF_IW), (bf16_t*)A.out};
                 GEMM_PHASE(EpiAtt, e, h1b, ws + OFF_WINB, MP, 5888, DM); }
    SEAM(5);
    PSTAMP(6);
    if (IN(6)) { indexer_phase(A, smem); }
    SEAM(6);
    PSTAMP(7);
    if (IN(7)) { attention_phase(A, smem); }
    SEAM(7);
    PSTAMP(8);
    if (IN(8)) { { EpiPlain e{(bf16_t*)(ws + OFF_YR)}; GEMM_PHASE(EpiPlain, e, A.out, ws + OFF_WRO, MR, DM, 2048); }
                 { EpiPlain e{(bf16_t*)(ws + OFF_YA)}; GEMM_PHASE(EpiPlain, e, ws + OFF_AQ, ws + OFF_WAO, MR, DM, DM); } }
    SEAM(8);
    PSTAMP(9);
    if (IN(9)) { EpiGate e{ssq1, (bf16_t*)(ws + OFF_YR), (const bf16_t*)(ws + OFF_YA)}; GEMM_PHASE(EpiGate, e, h1b, ws + OFF_WINC, MR, 2048, DM); }
    SEAM(9);
    PSTAMP(10);
    if (IN(10)) { EpiResid e{A.in[0], delta, nullptr, A.out, h1b, nullptr, ssq2, 1.0f}; GEMM_PHASE(EpiResid, e, ws + OFF_YR, ws + OFF_WMX, MR, DM, DM); }
    SEAM(10);
    PSTAMP(11);
    if (IN(11)) { EpiSwiGLU e{(bf16_t*)(ws + OFF_ACT2), ssq2}; GEMM_PHASE(EpiSwiGLU, e, h1b, ws + OFF_W2, MR, 5632, DM); }
    SEAM(11);
    PSTAMP(12);
    if (IN(12)) { EpiResid e{A.out, nullptr, nullptr, A.out, nullptr, nullptr, ssq3, 0.5f}; GEMM_PHASE(EpiResid, e, ws + OFF_ACT2, ws + OFF_WD2, MR, DM, DFF); }
    SEAM(12);
    PSTAMP(13);
    if (IN(13)) {
        const float* gf = A.in[15];
        const int lane = threadIdx.x & 63, wave = threadIdx.x >> 6;
        for (int row = blockIdx.x * 8 + wave; row < MR; row += gridDim.x * 8) {
            const float r = rstd1024(ssq3, row);
            float4* p = (float4*)(A.out + (size_t)row * DM);
#ifdef PROBE_PHASE
            const float pd = 0.08f * sqrtf((float)(pt1 - pt0) * 1e-5f);
#endif
#pragma unroll
            for (int j = 0; j < 4; ++j) { float4 v = p[lane + 64 * j]; const float4 g = ((const float4*)gf)[lane + 64 * j];
                v.x *= r * g.x; v.y *= r * g.y; v.z *= r * g.z; v.w *= r * g.w;
#ifdef PROBE_PHASE
                if (j == 0 && lane == 0) v.x += pd;
#endif
                p[lane + 64 * j] = v; }
        }
    }
}
constexpr int NPHASE = 14;

extern "C" void kernel_launch(void* const* d_in, const int* in_sizes, int n_in, void* d_out, int out_size, void* d_ws, size_t ws_size, hipStream_t stream) {
    static int grid = 0;
    if (grid == 0) {
        if (n_in != 16 || out_size != MR * DM || ws_size < 256 * MiB) { fprintf(stderr, "kernel_launch: unexpected problem (n_in %d out %d ws %zu)\n", n_in, out_size, ws_size); grid = -1; return; }
        int dev = 0, cus = 0, per_cu = 0;
        hipGetDevice(&dev); hipDeviceGetAttribute(&cus, hipDeviceAttributeMultiprocessorCount, dev);
        if (hipFuncSetAttribute((const void*)mk_fwd, hipFuncAttributeMaxDynamicSharedMemorySize, LDS_BYTES) != hipSuccess) { fprintf(stderr, "kernel_launch: hipFuncSetAttribute failed\n"); grid = -1; return; }
        hipOccupancyMaxActiveBlocksPerMultiprocessor(&per_cu, (const void*)mk_fwd, 512, LDS_BYTES);
        (void)hipGetLastError();
        if (per_cu < 1) per_cu = 1;
        grid = cus * 1;
        fprintf(stderr, "kernel_launch: cus %d per_cu %d grid %d\n", cus, per_cu, grid);
    }
    if (grid < 0) return;
    Args a{};
    for (int i = 0; i < 16; ++i) a.in[i] = (const float*)d_in[i];
    a.out = (float*)d_out; a.ws = (unsigned char*)d_ws;
    for (int h = 0; h < 4; ++h) a.l2g[h] = (float)(std::log1p(-std::ldexp(1.0, -5 - h)) / std::log(2.0));
#if MK_COOP
    if (hipMemsetAsync((char*)d_ws + OFF_BAR, 0, 16384, stream) != hipSuccess) { fprintf(stderr, "kernel_launch: memset failed\n"); return; }
    a.ph_lo = 0; a.ph_hi = NPHASE;
    void* args[] = {&a};
    hipError_t e = hipLaunchCooperativeKernel((const void*)mk_fwd, dim3(grid), dim3(512), args, LDS_BYTES, stream);
    if (e != hipSuccess) fprintf(stderr, "cooperative launch failed: %s (grid %d)\n", hipGetErrorString(e), grid);
#else
    for (int p = 0; p < NPHASE; ++p) { a.ph_lo = p; a.ph_hi = p + 1; hipLaunchKernelGGL(mk_fwd, dim3(grid), dim3(512), LDS_BYTES, stream, a); }
#endif
}
```

```cpp
#include <hip/hip_runtime.h>
#include <hip/hip_cooperative_groups.h>
#include <cstdio>
#include <cstdint>
#include <cmath>
namespace cg = cooperative_groups;
namespace pg8 {
#define PG8_LAS __attribute__((address_space(3)))
typedef unsigned short bf16_t;
typedef short bf16x8 __attribute__((ext_vector_type(8)));
typedef float f32x4 __attribute__((ext_vector_type(4)));
typedef unsigned u32x4 __attribute__((ext_vector_type(4)));
constexpr int BM = 256, BK = 64, HALF = 128, HTB = HALF * BK * 2  , STAGE_BYTES = 8 * HTB, NXCD = 8, WGM = 8;

__host__ __device__ __forceinline__ int lds_byte(int r, int c) { const int st = (r >> 4) * 2 + (c >> 5), rr = r & 15, cc = c & 31, ob = rr * 64 + cc * 2; return st * 1024 + (ob ^ (((ob >> 9) & 1) << 5)); }
__host__ __device__ __forceinline__ void stage_rc(int b, int& R, int& C) { const int st = b / 1024, sb = b % 1024, swz = sb ^ (((sb >> 9) & 1) << 5); R = (st >> 1) * 16 + swz / 64; C = (st & 1) * 32 + (swz % 64) / 2; }
__host__ __device__ __forceinline__ int perm32(int rho) { const int n = rho >> 4, i = rho & 15; return 8 * (i >> 2) + 4 * n + (i & 3); }

struct Unit { int pm, pn; };
struct Gemm { const bf16_t* A; const bf16_t* Bt; int M, N, K; };

struct StaticOrder {
    int nM, nN, nwg, G, c;
    __host__ __device__ void init(int M, int N, int G_, int c_) { nM = M / BM; nN = N / BM; nwg = nM * nN; G = G_; c = c_; }
    __host__ __device__ bool next(int i, Unit& u) const {
        const long L = (long)i * G + c; if (L >= nwg) return false;
        int wgid = (int)L; { const int q = nwg / NXCD, r = nwg % NXCD, xcd = wgid % NXCD, off = wgid / NXCD; wgid = (xcd < r ? xcd * (q + 1) : r * (q + 1) + (xcd - r) * q) + off; }
        const int nig = WGM * nN, gid = wgid / nig, fm = gid * WGM, gsz = (nM - fm) < WGM ? (nM - fm) : WGM;
        u.pm = fm + ((wgid % nig) % gsz); u.pn = (wgid % nig) / gsz; return true;
    }
    __device__ __forceinline__ void a_ready(const Unit&) const {}
    __device__ __forceinline__ void done(const Unit&) const {}
};

__device__ __forceinline__ unsigned cvt_pk_bf16(float lo, float hi) { unsigned r; asm volatile("v_cvt_pk_bf16_f32 %0, %1, %2" : "=v"(r) : "v"(lo), "v"(hi)); return r; }

template <class Epi, class Sched, bool ALIGN_EPI = false, bool SP2 = false>
__device__ __forceinline__ void gemm_phase(PG8_LAS unsigned char* lds, const Gemm g, const Sched& S, const Epi& E) {
    const int tid = threadIdx.x, wid = __builtin_amdgcn_readfirstlane(tid >> 6), lane = tid & 63, wr = wid >> 2, wc = wid & 3, fr = lane & 15, fq = lane >> 4;
    const int K = g.K, nt = K / BK;
    unsigned voffA[2], voffB[2];
#pragma unroll
    for (int i = 0; i < 2; ++i) { int R, C; stage_rc(tid * 16 + i * 8192, R, C); const int Rb = Epi::PERM ? ((R & ~31) + perm32(R & 31)) : R;
        voffA[i] = (unsigned)(R * K + C) * 2u; voffB[i] = (unsigned)(Rb * K + C) * 2u; }
    const size_t kstep = (size_t)(BK * 2);
    const size_t hstep = (size_t)HALF * K * 2;
    const size_t tstep = 2 * hstep;
    const unsigned ldsw = (unsigned)wid * 1024u;
    const int aoff = lds_byte(wr * 64 + fr, fq * 8), boff = lds_byte(wc * 32 + fr, fq * 8);
#define PG8_SA(b, h) (((b) * 2 + (h)) * HTB)
#define PG8_SB(b, h) ((4 + (b) * 2 + (h)) * HTB)
#define PG8_STAGE(bufoff, gbase, voff) do { _Pragma("unroll") for (int _i = 0; _i < 2; ++_i) \
        __builtin_amdgcn_global_load_lds((const unsigned*)((const char*)(gbase) + (voff)[_i]), (PG8_LAS unsigned*)(lds + (bufoff) + ldsw + _i * 8192), 16, 0, 0); } while (0)
#define PG8_LDA(dst, b, h) do { _Pragma("unroll") for (int m = 0; m < 4; ++m) _Pragma("unroll") for (int k = 0; k < 2; ++k) dst[m][k] = *(const PG8_LAS bf16x8*)(lds + PG8_SA(b, h) + aoff + m * 2048 + k * 1024); } while (0)
#define PG8_LDB(dst, b, h) do { _Pragma("unroll") for (int n = 0; n < 2; ++n) _Pragma("unroll") for (int k = 0; k < 2; ++k) dst[n][k] = *(const PG8_LAS bf16x8*)(lds + PG8_SB(b, h) + boff + n * 2048 + k * 1024); } while (0)
#define PG8_MMA(ai, bj, At, Bt) do { __builtin_amdgcn_s_setprio(1); _Pragma("unroll") for (int m = 0; m < 4; ++m) _Pragma("unroll") for (int n = 0; n < 2; ++n) _Pragma("unroll") for (int k = 0; k < 2; ++k) \
        acc[ai][bj][m][n] = __builtin_amdgcn_mfma_f32_16x16x32_bf16(Bt[n][k], At[m][k], acc[ai][bj][m][n], 0, 0, 0); __builtin_amdgcn_s_setprio(0); } while (0)
#define PG8_WAIT_V(n) asm volatile("s_waitcnt vmcnt(" #n ")" ::: "memory")
#define PG8_WAIT_L(n) asm volatile("s_waitcnt lgkmcnt(" #n ")" ::: "memory")
#define PG8_BAR __builtin_amdgcn_s_barrier()
#define PG8_SCHED __builtin_amdgcn_sched_barrier(0)
    Unit cur, nxt; int ui = 0;
    if (!S.next(0, cur)) return;
    f32x4 acc[2][2][4][2];
#pragma unroll
    for (int a = 0; a < 2; ++a)
#pragma unroll
        for (int b = 0; b < 2; ++b)
#pragma unroll
            for (int m = 0; m < 4; ++m)
#pragma unroll
                for (int n = 0; n < 2; ++n) acc[a][b][m][n] = (f32x4){0.f, 0.f, 0.f, 0.f};
    bf16x8 At[4][2], B0[2][2], B1[2][2];
    const char* cA = (const char*)g.A + (size_t)cur.pm * tstep; const char* cB = (const char*)g.Bt + (size_t)cur.pn * tstep;
    S.a_ready(cur);
    if constexpr (SP2) {
        PG8_STAGE(PG8_SB(0, 0), cB, voffB); PG8_STAGE(PG8_SB(0, 1), cB + hstep, voffB); PG8_STAGE(PG8_SA(0, 0), cA, voffA); PG8_STAGE(PG8_SA(0, 1), cA + hstep, voffA);
        if (wr == 1) PG8_BAR;
        PG8_WAIT_V(2); PG8_BAR;
        PG8_STAGE(PG8_SB(1, 0), cB + kstep, voffB); PG8_STAGE(PG8_SA(1, 0), cA + kstep, voffA); PG8_STAGE(PG8_SB(1, 1), cB + hstep + kstep, voffB);
        PG8_WAIT_V(6); PG8_BAR;
    } else {
        PG8_STAGE(PG8_SB(0, 0), cB, voffB); PG8_STAGE(PG8_SA(0, 0), cA, voffA); PG8_STAGE(PG8_SB(0, 1), cB + hstep, voffB); PG8_STAGE(PG8_SA(0, 1), cA + hstep, voffA);
        if (wr == 1) PG8_BAR;
        PG8_WAIT_V(4); PG8_BAR;
        PG8_STAGE(PG8_SB(1, 0), cB + kstep, voffB); PG8_STAGE(PG8_SA(1, 0), cA + kstep, voffA); PG8_STAGE(PG8_SB(1, 1), cB + hstep + kstep, voffB);
        PG8_WAIT_V(6); PG8_BAR;
    }
    for (;;) {
        const bool has_next = S.next(ui + 1, nxt);
        const char* nA = has_next ? (const char*)g.A + (size_t)nxt.pm * tstep : cA; const char* nB = has_next ? (const char*)g.Bt + (size_t)nxt.pn * tstep : cB;
        for (int t = 0; t < nt; t += 2) {
            const bool last = (t == nt - 2);
            const char* a1 = cA + (size_t)(t + 1) * kstep;
            const char* a2 = last ? nA : cA + (size_t)(t + 2) * kstep; const char* b2 = last ? nB : cB + (size_t)(t + 2) * kstep;
            const char* a3 = a2 + kstep; const char* b3 = b2 + kstep;
            if (last && has_next) S.a_ready(nxt);
            if constexpr (SP2) {
            PG8_LDB(B0, 0, 0); PG8_LDB(B1, 0, 1); PG8_SCHED; PG8_LDA(At, 0, 0); PG8_STAGE(PG8_SA(1, 1), a1 + hstep, voffA);
            PG8_WAIT_V(8); PG8_WAIT_L(0); PG8_BAR; PG8_MMA(0, 0, At, B0); PG8_MMA(0, 1, At, B1); PG8_BAR; PG8_SCHED;
            PG8_LDA(At, 0, 1); PG8_STAGE(PG8_SB(0, 0), b2, voffB); PG8_STAGE(PG8_SB(0, 1), b2 + hstep, voffB); PG8_STAGE(PG8_SA(0, 0), a2, voffA);
            PG8_WAIT_V(8); PG8_WAIT_L(0); PG8_BAR; PG8_MMA(1, 0, At, B0); PG8_MMA(1, 1, At, B1); PG8_BAR; PG8_SCHED;
            PG8_LDB(B0, 1, 0); PG8_LDB(B1, 1, 1); PG8_SCHED; PG8_LDA(At, 1, 0); PG8_STAGE(PG8_SA(0, 1), a2 + hstep, voffA);
            PG8_WAIT_V(8); PG8_WAIT_L(0); PG8_BAR; PG8_MMA(0, 0, At, B0); PG8_MMA(0, 1, At, B1); PG8_BAR; PG8_SCHED;
            PG8_LDA(At, 1, 1); PG8_STAGE(PG8_SB(1, 0), b3, voffB); PG8_STAGE(PG8_SB(1, 1), b3 + hstep, voffB); PG8_STAGE(PG8_SA(1, 0), a3, voffA);
            PG8_WAIT_V(8); PG8_WAIT_L(0); PG8_BAR; PG8_MMA(1, 0, At, B0); PG8_MMA(1, 1, At, B1); PG8_BAR; PG8_SCHED;
            } else {
            PG8_LDB(B0, 0, 0); PG8_SCHED; PG8_LDA(At, 0, 0); PG8_STAGE(PG8_SA(1, 1), a1 + hstep, voffA);
            PG8_WAIT_L(8); PG8_BAR; PG8_WAIT_L(0); PG8_MMA(0, 0, At, B0); PG8_BAR; PG8_SCHED;
            PG8_LDB(B1, 0, 1); PG8_STAGE(PG8_SB(0, 0), b2, voffB);
            PG8_BAR; PG8_WAIT_L(0); PG8_MMA(0, 1, At, B1); PG8_BAR;
            PG8_LDA(At, 0, 1); PG8_STAGE(PG8_SA(0, 0), a2, voffA);
            PG8_BAR; PG8_WAIT_L(0); PG8_MMA(1, 0, At, B0); PG8_BAR; PG8_SCHED;
            PG8_STAGE(PG8_SB(0, 1), b2 + hstep, voffB);
            PG8_WAIT_V(6); PG8_BAR; PG8_MMA(1, 1, At, B1); PG8_BAR;
            PG8_LDB(B0, 1, 0); PG8_SCHED; PG8_LDA(At, 1, 0); PG8_STAGE(PG8_SA(0, 1), a2 + hstep, voffA);
            PG8_WAIT_L(8); PG8_BAR; PG8_WAIT_L(0); PG8_MMA(0, 0, At, B0); PG8_BAR; PG8_SCHED;
            PG8_LDB(B1, 1, 1); PG8_STAGE(PG8_SB(1, 0), b3, voffB);
            PG8_BAR; PG8_WAIT_L(0); PG8_MMA(0, 1, At, B1); PG8_BAR;
            PG8_LDA(At, 1, 1); PG8_STAGE(PG8_SA(1, 0), a3, voffA);
            PG8_BAR; PG8_WAIT_L(0); PG8_MMA(1, 0, At, B0); PG8_BAR; PG8_SCHED;
            PG8_STAGE(PG8_SB(1, 1), b3 + hstep, voffB);
            PG8_WAIT_V(6); PG8_BAR; PG8_MMA(1, 1, At, B1); PG8_BAR;
            }
        }
        if constexpr (ALIGN_EPI) { if (wr == 0) PG8_BAR; }
        if constexpr (!Epi::AFTER_DRAIN) { E(acc, cur, wr, wc, fr, fq); S.done(cur); }
        if (!has_next) break;
#pragma unroll
        for (int a = 0; a < 2; ++a)
#pragma unroll
            for (int b = 0; b < 2; ++b)
#pragma unroll
                for (int m = 0; m < 4; ++m)
#pragma unroll
                    for (int n = 0; n < 2; ++n) acc[a][b][m][n] = (f32x4){0.f, 0.f, 0.f, 0.f};
        cur = nxt; cA = nA; cB = nB; ++ui;
        if constexpr (ALIGN_EPI) { if (wr == 1) PG8_BAR; }
    }
    PG8_WAIT_V(0);
    if constexpr (!ALIGN_EPI) { if (wr == 0) PG8_BAR; }
    PG8_BAR;
    if constexpr (Epi::AFTER_DRAIN) { E.fused(acc, cur, wr, wc, fr, fq, lds, wid, lane); S.done(cur); }
#undef PG8_SA
#undef PG8_SB
#undef PG8_STAGE
#undef PG8_LDA
#undef PG8_LDB
#undef PG8_MMA
#undef PG8_WAIT_V
#undef PG8_WAIT_L
#undef PG8_BAR
#undef PG8_SCHED
}
}
#ifndef MK_COOP
#define MK_COOP 1
#endif
using pg8::bf16_t; using pg8::bf16x8; using pg8::f32x4; using pg8::cvt_pk_bf16;
typedef short bf16x4 __attribute__((ext_vector_type(4)));
typedef unsigned long long u64;
typedef unsigned u32x2 __attribute__((ext_vector_type(2)));

constexpr int NB = 8, SEQ = 2048, NMETA = 16, TT = 2112, TP = 2112, DM = 1024, DFF = 2816;
constexpr int SPOS0 = 48;
constexpr int MR = NB * SEQ;
constexpr int MP = MR + 256;
constexpr int DIN = 11848;
constexpr int O_RQ = 0, O_RK = 1024, O_RV = 2048, O_RG = 4096, O_AQ = 6144, O_AK = 7168, O_AV = 8192, O_IQ = 9216, O_IK = 9728, O_IW = 9792, O_GR = 9800, O_GA = 10824;
constexpr float EPSN = 1e-6f;
constexpr size_t MiB = 1u << 20;
constexpr size_t WS_ZERO = 0;
constexpr size_t OFF_CTR = 0;
constexpr size_t OFF_SSQ1 = 4096;
constexpr size_t OFF_SSQ2 = OFF_SSQ1 + MP * 4;
constexpr size_t OFF_SSQ3 = OFF_SSQ2 + MR * 4;
constexpr size_t OFF_SSQY = OFF_SSQ3 + MR * 4;
constexpr size_t ZERO_BYTES = OFF_SSQY + (size_t)MR * 16;
constexpr size_t OFF_SSQ0 = 512 * 1024;
constexpr size_t OFF_BAR = 768 * 1024;
constexpr size_t OFF_IW = 1 * MiB;
constexpr size_t OFF_MPART = 1 * MiB + 512 * 1024;
constexpr size_t OFF_TAB256 = 2 * MiB;
constexpr size_t OFF_TAB128 = OFF_TAB256 + (size_t)2064 * 128 * 8;
constexpr size_t OFF_TAB64 = OFF_TAB128 + (size_t)2064 * 64 * 8;
constexpr size_t OFF_MASK = 6 * MiB;
constexpr size_t OFF_WINA = 11 * MiB;
constexpr size_t OFF_WINB = 19 * MiB;
constexpr size_t OFF_WINC = OFF_WINB + (size_t)5888 * 1024 * 2;
constexpr size_t OFF_WRO = OFF_WINC + 4 * MiB;
constexpr size_t OFF_WAO = OFF_WRO + 4 * MiB;
constexpr size_t OFF_WMX = OFF_WAO + 2 * MiB;
constexpr size_t OFF_W2 = OFF_WMX + 2 * MiB;
constexpr size_t OFF_WD2 = OFF_W2 + 11 * MiB;
constexpr size_t OFF_H1B = 59 * MiB;
constexpr size_t OFF_DELTA = OFF_H1B + (size_t)MP * 1024 * 2;
constexpr size_t OFF_R = OFF_DELTA + 32 * MiB;
constexpr size_t OFF_W1 = OFF_R;
constexpr size_t OFF_WD1 = OFF_R + 11 * MiB;
constexpr size_t OFF_ACT = OFF_R + 16 * MiB + MiB / 2;
constexpr size_t OFF_RQ = OFF_R;
constexpr size_t OFF_RKS = OFF_R + 32 * MiB;
constexpr size_t OFF_RVT = OFF_R + 65 * MiB;
constexpr size_t OFF_AQ = OFF_R;
constexpr size_t OFF_AKS = OFF_R + 32 * MiB;
constexpr size_t OFF_AVT = OFF_R + 65 * MiB;
constexpr size_t OFF_IQ = OFF_R + 98 * MiB;
constexpr size_t OFF_IK = OFF_R + 114 * MiB;
constexpr size_t OFF_YR = OFF_R + 32 * MiB;
constexpr size_t OFF_YA = OFF_R + 65 * MiB;
constexpr size_t OFF_ACT2 = OFF_R;
static_assert(OFF_ACT + (size_t)MP * DFF * 2 <= 256 * MiB && OFF_RVT + (size_t)8 * 4 * 512 * TP * 2 <= 256 * MiB && OFF_IK + 2 * MiB <= 256 * MiB, "ws map");
static_assert(OFF_WD2 + (size_t)1024 * 2816 * 2 <= OFF_H1B && OFF_MASK + (size_t)MR * 66 * 4 <= OFF_WINA && OFF_TAB64 + (size_t)2064 * 32 * 8 <= OFF_MASK && ZERO_BYTES <= OFF_SSQ0, "ws map 2");
constexpr int LDS_BYTES = 135168 + 1024;
constexpr int LDS_CTL = 135168;

struct Args {
    const float* in[16]; float* out; unsigned char* ws; float l2g[4]; int ph_lo, ph_hi;
};
static_assert(sizeof(Args) == 16 * 8 + 16 + 16 + 8, "Args has no padding");

__device__ __forceinline__ float wave_sum(float v) {
#pragma unroll
    for (int o = 1; o < 64; o <<= 1) v += __shfl_xor(v, o);
    return v;
}
__device__ __forceinline__ bf16_t f2bf(float v) { return (bf16_t)(cvt_pk_bf16(v, 0.f) & 0xffffu); }
__device__ __forceinline__ float bf2f(unsigned short b) { return __uint_as_float((unsigned)b << 16); }
__device__ __forceinline__ uint2 pack4(float a, float b, float c, float d) { uint2 r; r.x = cvt_pk_bf16(a, b); r.y = cvt_pk_bf16(c, d); return r; }
__device__ __forceinline__ f32x4 unpack4(uint2 v) { f32x4 r; r[0] = __uint_as_float(v.x << 16); r[1] = __uint_as_float(v.x & 0xffff0000u); r[2] = __uint_as_float(v.y << 16); r[3] = __uint_as_float(v.y & 0xffff0000u); return r; }
__device__ __forceinline__ int vpos(int pos) { return (pos & ~31) | (((pos >> 2) & 3) << 3) | (((pos >> 4) & 1) << 2) | (pos & 3); }
__device__ __forceinline__ float silu_f(float x) { return x * __builtin_amdgcn_rcpf(1.f + __expf(-x)); }
__device__ __forceinline__ float sigm_f(float x) { return __builtin_amdgcn_rcpf(1.f + __expf(-x)); }
__device__ __forceinline__ float rstd1024(const float* ssq, int row) { return rsqrtf(ssq[row] * (1.f / 1024.f) + EPSN); }
#define EPI_ROW(ai, m) (u.pm * 256 + (ai) * 128 + wr * 64 + (m) * 16 + fr)
#define EPI_RSTD(ssqp) float rs_[2][4]; { _Pragma("unroll") for (int ai = 0; ai < 2; ++ai) _Pragma("unroll") for (int m = 0; m < 4; ++m) rs_[ai][m] = (ssqp)[EPI_ROW(ai, m)]; \
    _Pragma("unroll") for (int ai = 0; ai < 2; ++ai) _Pragma("unroll") for (int m = 0; m < 4; ++m) rs_[ai][m] = rsqrtf(rs_[ai][m] * (1.f / 1024.f) + EPSN); }

struct EpiSwiGLU {
    static constexpr bool PERM = false, AFTER_DRAIN = false;
    bf16_t* act; const float* ssq;
    __device__ __forceinline__ void operator()(const f32x4 (&acc)[2][2][4][2], const pg8::Unit& u, int wr, int wc, int fr, int fq) const {
        EPI_RSTD(ssq)
#pragma unroll
        for (int ai = 0; ai < 2; ++ai)
#pragma unroll
            for (int m = 0; m < 4; ++m) {
                const int row = EPI_ROW(ai, m); const float r = rs_[ai][m];
#pragma unroll
                for (int bj = 0; bj < 2; ++bj) {
                    const int f0 = u.pn * 128 + bj * 64 + wc * 16 + fq * 4;
                    const f32x4 g = acc[ai][bj][m][0] * r, uu = acc[ai][bj][m][1] * r;
                    *(uint2*)(act + (size_t)row * DFF + f0) = pack4(silu_f(g[0]) * uu[0], silu_f(g[1]) * uu[1], silu_f(g[2]) * uu[2], silu_f(g[3]) * uu[3]);
                }
            }
    }
};

struct EpiResid {
    static constexpr bool PERM = false, AFTER_DRAIN = false;
    const float* resf; const bf16_t* resd; const float* meta; float* outf; bf16_t* outb; bf16_t* outd; float* ssq; float alpha;
    __device__ __forceinline__ void operator()(const f32x4 (&acc)[2][2][4][2], const pg8::Unit& u, int wr, int wc, int fr, int fq) const {
#pragma unroll
        for (int ai = 0; ai < 2; ++ai)
#pragma unroll
            for (int mh = 0; mh < 2; ++mh) {
                f32x4 res[2][2][2]; uint2 rd[2][2][2];
#pragma unroll
                for (int m2 = 0; m2 < 2; ++m2) {
                    const int row = EPI_ROW(ai, 2 * mh + m2);
#pragma unroll
                    for (int bj = 0; bj < 2; ++bj)
#pragma unroll
                        for (int n = 0; n < 2; ++n) {
                            const int c0 = u.pn * 256 + bj * 128 + wc * 32 + n * 16 + fq * 4;
                            res[m2][bj][n] = (f32x4){0.f, 0.f, 0.f, 0.f}; rd[m2][bj][n] = make_uint2(0u, 0u);
                            if (row < MR) { res[m2][bj][n] = *(const f32x4*)(resf + (size_t)row * DM + c0); if (resd) rd[m2][bj][n] = *(const uint2*)(resd + (size_t)row * DM + c0); }
                            else if (meta && row < MR + NMETA) res[m2][bj][n] = *(const f32x4*)(meta + (size_t)(row - MR) * DM + c0);
                        }
                }
#pragma unroll
                for (int m2 = 0; m2 < 2; ++m2) {
                    const int m = 2 * mh + m2; const int row = EPI_ROW(ai, m);
                    float part = 0.f;
#pragma unroll
                    for (int bj = 0; bj < 2; ++bj)
#pragma unroll
                        for (int n = 0; n < 2; ++n) {
                            const int c0 = u.pn * 256 + bj * 128 + wc * 32 + n * 16 + fq * 4;
                            const f32x4 a = acc[ai][bj][m][n] * alpha;
                            const f32x4 h = res[m2][bj][n] + unpack4(rd[m2][bj][n]) + a;
                            part += (h[0] * h[0] + h[1] * h[1]) + (h[2] * h[2] + h[3] * h[3]);
                            if (outf && row < MR) *(f32x4*)(outf + (size_t)row * DM + c0) = h;
                            if (outb) *(uint2*)(outb + (size_t)row * DM + c0) = pack4(h[0], h[1], h[2], h[3]);
                            if (outd && row < MR) *(uint2*)(outd + (size_t)row * DM + c0) = pack4(a[0], a[1], a[2], a[3]);
                        }
                    part += __shfl_xor(part, 16); part += __shfl_xor(part, 32);
                    if (fq == 0) atomicAdd(ssq + row, part);
                }
            }
    }
};

__device__ __forceinline__ void rope4(const f32x4 x1, const f32x4 x2, const float4 t0, const float4 t1, uint2& o1, uint2& o2) {
    o1 = pack4(x1[0] * t0.x - x2[0] * t0.y, x1[1] * t0.z - x2[1] * t0.w, x1[2] * t1.x - x2[2] * t1.y, x1[3] * t1.z - x2[3] * t1.w);
    o2 = pack4(x2[0] * t0.x + x1[0] * t0.y, x2[1] * t0.z + x1[1] * t0.w, x2[2] * t1.x + x1[2] * t1.y, x2[3] * t1.z + x1[3] * t1.w);
}

struct EpiRet {
    static constexpr bool PERM = false, AFTER_DRAIN = false;
    const float* ssq1; const float2* tab256; bf16_t* RQ; bf16_t* RKs; bf16_t* RVt;
    __device__ __forceinline__ void operator()(const f32x4 (&acc)[2][2][4][2], const pg8::Unit& u, int wr, int wc, int fr, int fq) const {
        EPI_RSTD(ssq1)
        if (u.pn < 8) {
            const int head = u.pn & 3; const float sc = u.pn < 4 ? 1.f : 0.0625f;
#pragma unroll
            for (int ai = 0; ai < 2; ++ai)
#pragma unroll
                for (int mh = 0; mh < 2; ++mh) {
                    float4 tb[2][2][2];
#pragma unroll
                    for (int m2 = 0; m2 < 2; ++m2) {
                        const int row = EPI_ROW(ai, 2 * mh + m2); const int pos = row < MR ? NMETA + (row & 2047) : (row < MR + NMETA ? row - MR : 0);
#pragma unroll
                        for (int bj = 0; bj < 2; ++bj) { const float4* tp = (const float4*)(tab256 + (size_t)pos * 128 + 16 * (4 * bj + wc) + 4 * fq); tb[m2][bj][0] = tp[0]; tb[m2][bj][1] = tp[1]; }
                    }
#pragma unroll
                    for (int m2 = 0; m2 < 2; ++m2) {
                        const int m = 2 * mh + m2; const int row = EPI_ROW(ai, m);
                        const bool real = row < MR; const int b = row >> 11; const int pos = real ? NMETA + (row & 2047) : row - MR;
                        if (row < MR + NMETA && (u.pn >= 4 || real)) {
                            const float r = rs_[ai][m] * sc;
#pragma unroll
                            for (int bj = 0; bj < 2; ++bj) {
                                const int jj0 = 16 * (4 * bj + wc) + 4 * fq; uint2 o1, o2;
                                rope4(acc[ai][bj][m][0] * r, acc[ai][bj][m][1] * r, tb[m2][bj][0], tb[m2][bj][1], o1, o2);
                                if (u.pn < 4) { bf16_t* d = RQ + (size_t)row * 1024 + head * 256 + jj0; *(uint2*)d = o1; *(uint2*)(d + 128) = o2; }
                                else if (real) { bf16_t* d = RKs + ((size_t)b * TP + SPOS0 + pos) * 1024 + head * 256 + jj0; *(uint2*)d = o1; *(uint2*)(d + 128) = o2; }
                                else { for (int bb = 0; bb < NB; ++bb) { bf16_t* d = RKs + ((size_t)bb * TP + SPOS0 + pos) * 1024 + head * 256 + jj0; *(uint2*)d = o1; *(uint2*)(d + 128) = o2; } }
                            }
                        }
                    }
                }
        } else {
#pragma unroll
            for (int ai = 0; ai < 2; ++ai)
#pragma unroll
                for (int m = 0; m < 4; ++m) {
                    const int row = EPI_ROW(ai, m);
                    if (row < MR + NMETA) {
                        const bool real = row < MR; const int b = row >> 11; const int pos = real ? NMETA + (row & 2047) : row - MR; const float r = rs_[ai][m];
#pragma unroll
                        for (int bj = 0; bj < 2; ++bj)
#pragma unroll
                            for (int n = 0; n < 2; ++n) {
                                const int cin = (u.pn - 8) * 256 + bj * 128 + wc * 32 + n * 16 + fq * 4; const int head = cin >> 9, dv = cin & 511;
                                const f32x4 v = acc[ai][bj][m][n] * r;
                                const bf16_t v0 = f2bf(v[0]), v1 = f2bf(v[1]), v2 = f2bf(v[2]), v3 = f2bf(v[3]);
                                if (real) { bf16_t* d = RVt + ((size_t)(b * 4 + head) * 512 + dv) * TP + vpos(SPOS0 + pos); d[0] = v0; d[TP] = v1; d[2 * TP] = v2; d[3 * TP] = v3; }
                                else { for (int bb = 0; bb < NB; ++bb) { bf16_t* d = RVt + ((size_t)(bb * 4 + head) * 512 + dv) * TP + vpos(SPOS0 + pos); d[0] = v0; d[TP] = v1; d[2 * TP] = v2; d[3 * TP] = v3; } }
                            }
                    }
                }
        }
    }
};

struct EpiAtt {
    static constexpr bool PERM = false, AFTER_DRAIN = false;
    const float* ssq1; const float2* tab128; const float2* tab64; const float* ssqY;
    bf16_t* AQ; bf16_t* AKs; bf16_t* AVt; bf16_t* IQ; bf16_t* IK; float* IW; bf16_t* Y;
    __device__ __forceinline__ void operator()(const f32x4 (&acc)[2][2][4][2], const pg8::Unit& u, int wr, int wc, int fr, int fq) const {
        EPI_RSTD(ssq1)
        if (u.pn < 8 || u.pn == 12 || u.pn == 13) {
            const bool d128 = u.pn < 8;
#pragma unroll
            for (int ai = 0; ai < 2; ++ai)
#pragma unroll
                for (int mh = 0; mh < 2; ++mh) {
                    float4 tb[2][2];
#pragma unroll
                    for (int m2 = 0; m2 < 2; ++m2) {
                        const int row = EPI_ROW(ai, 2 * mh + m2); const int pos = row < MR ? NMETA + (row & 2047) : (row < MR + NMETA ? row - MR : 0);
                        const float4* tp = d128 ? (const float4*)(tab128 + (size_t)pos * 64 + 16 * wc + 4 * fq) : (const float4*)(tab64 + (size_t)pos * 32 + 16 * (wc & 1) + 4 * fq);
                        tb[m2][0] = tp[0]; tb[m2][1] = tp[1];
                    }
#pragma unroll
                    for (int m2 = 0; m2 < 2; ++m2) {
                        const int m = 2 * mh + m2; const int row = EPI_ROW(ai, m);
                        const bool real = row < MR; const int b = row >> 11; const int pos = real ? NMETA + (row & 2047) : row - MR;
                        if (real || (row < MR + NMETA && u.pn >= 4 && u.pn < 8)) {
                            const float r = rs_[ai][m];
#pragma unroll
                            for (int bj = 0; bj < 2; ++bj) {
                                uint2 o1, o2; rope4(acc[ai][bj][m][0] * r, acc[ai][bj][m][1] * r, tb[m2][0], tb[m2][1], o1, o2);
                                if (d128) {
                                    const int head = 2 * (u.pn & 3) + bj; const int jj0 = 16 * wc + 4 * fq;
                                    if (u.pn < 4) { bf16_t* d = AQ + (size_t)row * 1024 + head * 128 + jj0; *(uint2*)d = o1; *(uint2*)(d + 64) = o2; }
                                    else if (real) { bf16_t* d = AKs + ((size_t)b * TP + SPOS0 + pos) * 1024 + head * 128 + jj0; *(uint2*)d = o1; *(uint2*)(d + 64) = o2; }
                                    else { for (int bb = 0; bb < NB; ++bb) { bf16_t* d = AKs + ((size_t)bb * TP + SPOS0 + pos) * 1024 + head * 128 + jj0; *(uint2*)d = o1; *(uint2*)(d + 64) = o2; } }
                                } else {
                                    const int head = (u.pn - 12) * 4 + 2 * bj + (wc >> 1); const int jj0 = 16 * (wc & 1) + 4 * fq;
                                    bf16_t* d = IQ + (size_t)row * 512 + head * 64 + jj0; *(uint2*)d = o1; *(uint2*)(d + 32) = o2;
                                }
                            }
                        }
                    }
                }
        } else if (u.pn < 12) {
#pragma unroll
            for (int ai = 0; ai < 2; ++ai)
#pragma unroll
                for (int m = 0; m < 4; ++m) {
                    const int row = EPI_ROW(ai, m);
                    if (row < MR + NMETA) {
                        const bool real = row < MR; const int b = row >> 11; const int pos = real ? NMETA + (row & 2047) : row - MR; const float r = rs_[ai][m];
#pragma unroll
                        for (int bj = 0; bj < 2; ++bj)
#pragma unroll
                            for (int n = 0; n < 2; ++n) {
                                const int cin = (u.pn - 8) * 256 + bj * 128 + wc * 32 + n * 16 + fq * 4; const int head = cin >> 7, dd = cin & 127;
                                const f32x4 v = acc[ai][bj][m][n] * r;
                                const bf16_t v0 = f2bf(v[0]), v1 = f2bf(v[1]), v2 = f2bf(v[2]), v3 = f2bf(v[3]);
                                if (real) { bf16_t* d = AVt + ((size_t)(b * 8 + head) * 128 + dd) * TP + vpos(SPOS0 + pos); d[0] = v0; d[TP] = v1; d[2 * TP] = v2; d[3 * TP] = v3; }
                                else { for (int bb = 0; bb < NB; ++bb) { bf16_t* d = AVt + ((size_t)(bb * 8 + head) * 128 + dd) * TP + vpos(SPOS0 + pos); d[0] = v0; d[TP] = v1; d[2 * TP] = v2; d[3 * TP] = v3; } }
                            }
                    }
                }
        } else if (u.pn == 14) {
#pragma unroll
            for (int ai = 0; ai < 2; ++ai) {
                float4 tb[4][2];
                if (wc < 2) {
#pragma unroll
                    for (int m = 0; m < 4; ++m) { const int row = EPI_ROW(ai, m); const int pos = row < MR ? NMETA + (row & 2047) : 0;
                        const float4* tp = (const float4*)(tab64 + (size_t)pos * 32 + 16 * wc + 4 * fq); tb[m][0] = tp[0]; tb[m][1] = tp[1]; }
                }
#pragma unroll
                for (int m = 0; m < 4; ++m) {
                    const int row = EPI_ROW(ai, m);
                    if (row < MR) {
                        const float r = rs_[ai][m];
                        if (wc < 2) {
                            uint2 o1, o2; rope4(acc[ai][0][m][0] * r, acc[ai][0][m][1] * r, tb[m][0], tb[m][1], o1, o2);
                            bf16_t* d = IK + (size_t)row * 64 + 16 * wc + 4 * fq; *(uint2*)d = o1; *(uint2*)(d + 32) = o2;
                        } else if (wc == 2 && fq < 2) {
                            *(f32x4*)(IW + (size_t)row * 8 + 4 * fq) = acc[ai][0][m][0] * r;
                        }
                    }
                }
            }
        } else {
            const int head = (u.pn - 15) >> 1;
#pragma unroll
            for (int ai = 0; ai < 2; ++ai)
#pragma unroll
                for (int mh = 0; mh < 2; ++mh) {
                    uint2 yv[2][2][2]; float ysq[2];
#pragma unroll
                    for (int m2 = 0; m2 < 2; ++m2) {
                        const int row = EPI_ROW(ai, 2 * mh + m2); const int rr = row < MR ? row : 0;
                        ysq[m2] = ssqY[(size_t)rr * 4 + head];
#pragma unroll
                        for (int bj = 0; bj < 2; ++bj)
#pragma unroll
                            for (int n = 0; n < 2; ++n) yv[m2][bj][n] = *(const uint2*)(Y + (size_t)rr * 2048 + (u.pn - 15) * 256 + bj * 128 + wc * 32 + n * 16 + fq * 4);
                    }
#pragma unroll
                    for (int m2 = 0; m2 < 2; ++m2) {
                        const int m = 2 * mh + m2; const int row = EPI_ROW(ai, m);
                        if (row < MR) {
                            const float r = rs_[ai][m]; const float ys = rsqrtf(ysq[m2] * (1.f / 512.f) + EPSN);
#pragma unroll
                            for (int bj = 0; bj < 2; ++bj)
#pragma unroll
                                for (int n = 0; n < 2; ++n) {
                                    const int cin = (u.pn - 15) * 256 + bj * 128 + wc * 32 + n * 16 + fq * 4;
                                    const f32x4 y = unpack4(yv[m2][bj][n]); const f32x4 g = acc[ai][bj][m][n] * r;
                                    *(uint2*)(Y + (size_t)row * 2048 + cin) = pack4(silu_f(g[0]) * y[0] * ys, silu_f(g[1]) * y[1] * ys, silu_f(g[2]) * y[2] * ys, silu_f(g[3]) * y[3] * ys);
                                }
                        }
                    }
                }
        }
    }
};

struct EpiPlain {
    static constexpr bool PERM = false, AFTER_DRAIN = false;
    bf16_t* out;
    __device__ __forceinline__ void operator()(const f32x4 (&acc)[2][2][4][2], const pg8::Unit& u, int wr, int wc, int fr, int fq) const {
#pragma unroll
        for (int ai = 0; ai < 2; ++ai)
#pragma unroll
            for (int m = 0; m < 4; ++m) {
                const int row = EPI_ROW(ai, m);
#pragma unroll
                for (int bj = 0; bj < 2; ++bj)
#pragma unroll
                    for (int n = 0; n < 2; ++n) {
                        const int c0 = u.pn * 256 + bj * 128 + wc * 32 + n * 16 + fq * 4; const f32x4 a = acc[ai][bj][m][n];
                        *(uint2*)(out + (size_t)row * DM + c0) = pack4(a[0], a[1], a[2], a[3]);
                    }
            }
    }
};

struct EpiGate {
    static constexpr bool PERM = false, AFTER_DRAIN = false;
    const float* ssq1; bf16_t* yr; const bf16_t* ya;
    __device__ __forceinline__ void operator()(const f32x4 (&acc)[2][2][4][2], const pg8::Unit& u, int wr, int wc, int fr, int fq) const {
        EPI_RSTD(ssq1)
#pragma unroll
        for (int ai = 0; ai < 2; ++ai) {
            uint2 av[4][2], cv[4][2];
#pragma unroll
            for (int m = 0; m < 4; ++m)
#pragma unroll
                for (int bj = 0; bj < 2; ++bj) { const size_t o = (size_t)EPI_ROW(ai, m) * DM + u.pn * 128 + bj * 64 + wc * 16 + fq * 4; av[m][bj] = *(const uint2*)(yr + o); cv[m][bj] = *(const uint2*)(ya + o); }
#pragma unroll
            for (int m = 0; m < 4; ++m) {
                const float r = rs_[ai][m];
#pragma unroll
                for (int bj = 0; bj < 2; ++bj) {
                    const size_t o = (size_t)EPI_ROW(ai, m) * DM + u.pn * 128 + bj * 64 + wc * 16 + fq * 4;
                    const f32x4 gr = acc[ai][bj][m][0] * r, ga = acc[ai][bj][m][1] * r; const f32x4 a = unpack4(av[m][bj]), c = unpack4(cv[m][bj]);
                    *(uint2*)(yr + o) = pack4(sigm_f(gr[0]) * a[0] + sigm_f(ga[0]) * c[0], sigm_f(gr[1]) * a[1] + sigm_f(ga[1]) * c[1],
                                              sigm_f(gr[2]) * a[2] + sigm_f(ga[2]) * c[2], sigm_f(gr[3]) * a[3] + sigm_f(ga[3]) * c[3]);
                }
            }
        }
    }
};
template <class Map>
__device__ __forceinline__ void convert_w(int K, int N, bf16_t* Wt, int Nd, const float* gain, Map map, unsigned char* smem) {
    bf16_t* tile = (bf16_t*)smem;
    const int tid = threadIdx.x; const int ntk = K / 256, nt = (Nd / 64) * ntk;
    for (int t = blockIdx.x; t < nt; t += gridDim.x) {
        const int n0 = (t / ntk) * 64, k0 = (t % ntk) * 256;
        const int kr = tid >> 4, nq = tid & 15;
        const float* W = nullptr; const int src = map(n0 + 4 * nq, W);
        float4 v[8];
#pragma unroll
        for (int p = 0; p < 8; ++p) { v[p] = make_float4(0.f, 0.f, 0.f, 0.f); if (src >= 0) v[p] = *(const float4*)(W + (size_t)(k0 + kr + 32 * p) * N + src); }
#pragma unroll
        for (int p = 0; p < 8; ++p) {
            const int kl = kr + 32 * p; const float g = gain ? gain[k0 + kl] : 1.f;
            bf16_t* tl = tile + (kl >> 6) * (64 * 72) + (kl & 63);
            tl[(4 * nq + 0) * 72] = f2bf(v[p].x * g); tl[(4 * nq + 1) * 72] = f2bf(v[p].y * g); tl[(4 * nq + 2) * 72] = f2bf(v[p].z * g); tl[(4 * nq + 3) * 72] = f2bf(v[p].w * g);
        }
        __syncthreads();
        const int nl = tid >> 3, kc = tid & 7;
#pragma unroll
        for (int q = 0; q < 4; ++q) *(uint4*)(Wt + (size_t)(n0 + nl) * K + k0 + 64 * q + 8 * kc) = *(const uint4*)(tile + q * (64 * 72) + nl * 72 + 8 * kc);
        __syncthreads();
    }
}
__device__ __forceinline__ int rope_nat(int c, int dbits) {
    const int g = c >> 5, hi = (c >> 4) & 1, i = c & 15; return (hi << (dbits - 1)) + 16 * g + i;
}

__device__ __forceinline__ void p0_prologue(const Args& A, unsigned char* smem) {
    unsigned char* ws = A.ws;
    const int tid = threadIdx.x, lane = tid & 63, wave = tid >> 6;
    const size_t gtid = (size_t)blockIdx.x * 512 + tid, gsz = (size_t)gridDim.x * 512;
    for (size_t i = gtid; i < ZERO_BYTES / 16; i += gsz) ((uint4*)(ws + WS_ZERO))[i] = make_uint4(0, 0, 0, 0);
    {
        bf16_t* xb = (bf16_t*)A.out; float* ssq0 = (float*)(ws + OFF_SSQ0);
        const int gw = blockIdx.x * 8 + wave, ngw = gridDim.x * 8;
        for (int row = gw; row < MP; row += ngw) {
            const float* src = row < MR ? A.in[0] + (size_t)row * DM : (row < MR + NMETA ? A.in[1] + (size_t)(row - MR) * DM : nullptr);
            float s = 0.f;
#pragma unroll
            for (int j = 0; j < 4; ++j) {
                float4 v = make_float4(0.f, 0.f, 0.f, 0.f);
                if (src) v = ((const float4*)src)[lane + 64 * j];
                s += (v.x * v.x + v.y * v.y) + (v.z * v.z + v.w * v.w);
                *(uint2*)(xb + (size_t)row * DM + 4 * (lane + 64 * j)) = pack4(v.x, v.y, v.z, v.w);
            }
            s = wave_sum(s);
            if (lane == 0) ssq0[row] = s;
        }
    }
    { uint4* hp = (uint4*)(ws + OFF_H1B + (size_t)(MR + NMETA) * DM * 2); for (size_t i = gtid; i < (size_t)(MP - MR - NMETA) * DM * 2 / 16; i += gsz) hp[i] = make_uint4(0, 0, 0, 0); }
    {
        float2* t256 = (float2*)(ws + OFF_TAB256); float2* t128 = (float2*)(ws + OFF_TAB128); float2* t64 = (float2*)(ws + OFF_TAB64);
        for (size_t i = gtid; i < (size_t)2064 * 128; i += gsz) {
            const int pos = (int)(i >> 7), j = (int)(i & 127);
            const float inv = exp2f(-(float)j * (13.287712379549449f / 128.f));
            const float ang = (float)pos * inv;
            const double a = (double)ang; const double k = __builtin_rint(a * 0.15915494309189535);
            const double rr = a - k * 6.283185307179586; const double x = rr * 0.25, x2 = x * x;
            double s = x * (1.0 - x2 * (1.0 / 6.0) * (1.0 - x2 * (1.0 / 20.0) * (1.0 - x2 * (1.0 / 42.0) * (1.0 - x2 * (1.0 / 72.0) * (1.0 - x2 * (1.0 / 110.0) * (1.0 - x2 * (1.0 / 156.0)))))));
            double c = 1.0 - x2 * 0.5 * (1.0 - x2 * (1.0 / 12.0) * (1.0 - x2 * (1.0 / 30.0) * (1.0 - x2 * (1.0 / 56.0) * (1.0 - x2 * (1.0 / 90.0) * (1.0 - x2 * (1.0 / 132.0) * (1.0 - x2 * (1.0 / 182.0)))))));
            const double s2 = 2.0 * s * c, c2 = c * c - s * s; const double s4 = 2.0 * s2 * c2, c4 = c2 * c2 - s2 * s2;
            const float2 o = make_float2((float)c4, (float)s4);
            t256[i] = o;
            if ((j & 1) == 0) t128[(size_t)pos * 64 + (j >> 1)] = o;
            if ((j & 3) == 0) t64[(size_t)pos * 32 + (j >> 2)] = o;
        }
    }
    const float* w_in = A.in[7];
    convert_w(DM, DFF, (bf16_t*)(ws + OFF_W1), 5632, A.in[2], [&](int n, const float*& W) { W = ((n >> 4) & 1) ? A.in[4] : A.in[3]; return 16 * (n >> 5) + (n & 15); }, smem);
    convert_w(DFF, DM, (bf16_t*)(ws + OFF_WD1), 1024, nullptr, [&](int n, const float*& W) { W = A.in[5]; return n; }, smem);
    convert_w(DM, DIN, (bf16_t*)(ws + OFF_WINA), 4096, A.in[6], [&](int n, const float*& W) { W = w_in;
        if (n < 2048) return (n < 1024 ? O_RQ : O_RK) + ((n & 1023) >> 8) * 256 + rope_nat(n & 255, 8);
        return O_RV + (n - 2048); }, smem);
    convert_w(DM, DIN, (bf16_t*)(ws + OFF_WINB), 5888, A.in[6], [&](int n, const float*& W) { W = w_in;
        if (n < 2048) return (n < 1024 ? O_AQ : O_AK) + ((n & 1023) >> 7) * 128 + rope_nat(n & 127, 7);
        if (n < 3072) return O_AV + (n - 2048);
        if (n < 3584) return O_IQ + ((n - 3072) >> 6) * 64 + rope_nat((n - 3072) & 63, 6);
        if (n < 3648) return O_IK + rope_nat(n - 3584, 6);
        if (n < 3656) return O_IW + (n - 3648);
        if (n < 3840) return -1;
        return O_RG + (n - 3840); }, smem);
    convert_w(DM, DIN, (bf16_t*)(ws + OFF_WINC), 2048, A.in[6], [&](int n, const float*& W) { W = w_in; return (((n >> 4) & 1) ? O_GA : O_GR) + 16 * (n >> 5) + (n & 15); }, smem);
    convert_w(2048, DM, (bf16_t*)(ws + OFF_WRO), 1024, nullptr, [&](int n, const float*& W) { W = A.in[8]; return n; }, smem);
    convert_w(DM, DM, (bf16_t*)(ws + OFF_WAO), 1024, nullptr, [&](int n, const float*& W) { W = A.in[9]; return n; }, smem);
    convert_w(DM, DM, (bf16_t*)(ws + OFF_WMX), 1024, nullptr, [&](int n, const float*& W) { W = A.in[10]; return n; }, smem);
    convert_w(DM, DFF, (bf16_t*)(ws + OFF_W2), 5632, A.in[11], [&](int n, const float*& W) { W = ((n >> 4) & 1) ? A.in[13] : A.in[12]; return 16 * (n >> 5) + (n & 15); }, smem);
    convert_w(DFF, DM, (bf16_t*)(ws + OFF_WD2), 1024, nullptr, [&](int n, const float*& W) { W = A.in[14]; return n; }, smem);
}

template <int DQK, int DV, int RB, bool SOFTMAX, int NSTG>
__device__ __forceinline__ void flash_unit(const bf16_t* __restrict__ Q, int ldq, const bf16_t* __restrict__ Kb, int ldk, const bf16_t* __restrict__ Vt,
                                           bf16_t* Out, int ldo, int qpos0, int kt_lo, int kt_hi, const u64* __restrict__ mask64, float p0, float* ssqY, unsigned char* smem) {
    constexpr int KCH = DQK / 8, NKD = KCH / 8, NVD = DV / 64, NKS = DQK / 32, NNB = DV / 16;
    constexpr int KBYTES = 64 * DQK * 2, STAGE = KBYTES + DV * 64 * 2;
    const int tid = threadIdx.x, lane = tid & 63, w = __builtin_amdgcn_readfirstlane(tid >> 6), fr = lane & 15, quad = lane >> 4;
    bf16x8 qf[RB][NKS];
#pragma unroll
    for (int rb = 0; rb < RB; ++rb)
#pragma unroll
        for (int ks = 0; ks < NKS; ++ks) qf[rb][ks] = *(const bf16x8*)(Q + (size_t)(w * 16 * RB + rb * 16 + fr) * ldq + ks * 32 + quad * 8);
    f32x4 o[NNB][RB];
#pragma unroll
    for (int nb = 0; nb < NNB; ++nb)
#pragma unroll
        for (int rb = 0; rb < RB; ++rb) o[nb][rb] = (f32x4){0.f, 0.f, 0.f, 0.f};
    float mrun[RB], lrun[RB];
#pragma unroll
    for (int rb = 0; rb < RB; ++rb) { mrun[rb] = -INFINITY; lrun[rb] = 0.f; }
    PG8_LAS unsigned char* lds = (PG8_LAS unsigned char*)smem;
    int koff[4], voff[4];
    float bk[4][4];
#pragma unroll
    for (int kb = 0; kb < 4; ++kb)
#pragma unroll
        for (int j = 0; j < 4; ++j) bk[kb][j] = SOFTMAX ? 1.f : __builtin_amdgcn_exp2f(-(float)(kb * 16 + quad * 4 + j) * p0);
#pragma unroll
    for (int a = 0; a < 4; ++a) { koff[a] = (fr * KCH + ((a * 4) ^ quad ^ fr)) * 16; voff[a] = (fr * 8 + (((a & 1) * 4) ^ quad ^ ((fr >> 1) & 7))) * 16; }
#define FL_DMA(KT, BUF) do { \
    _Pragma("unroll") for (int i = 0; i < NKD; ++i) { const int gi = (i * 8 + w) * 64 + lane, r = gi / KCH, cc = (gi % KCH) ^ (r & 15); int t = 64 * (KT) + r; t = t < TT ? t : TT - 1; \
        __builtin_amdgcn_global_load_lds((const unsigned*)(Kb + (size_t)t * ldk + cc * 8), (PG8_LAS unsigned*)(lds + (BUF) * STAGE + (i * 8 + w) * 1024), 16, 0, 0); } \
    _Pragma("unroll") for (int i = 0; i < NVD; ++i) { const int gi = (i * 8 + w) * 64 + lane, r = gi >> 3, cc = (gi & 7) ^ ((r >> 1) & 7); int t = 64 * (KT) + 8 * cc; t = t < TP ? t : TP - 8; \
        __builtin_amdgcn_global_load_lds((const unsigned*)(Vt + (size_t)r * TP + t), (PG8_LAS unsigned*)(lds + (BUF) * STAGE + KBYTES + (i * 8 + w) * 1024), 16, 0, 0); } } while (0)
    constexpr int NDMA = NKD + NVD;
    PG8_LAS u64* mlds = (PG8_LAS u64*)(lds + NSTG * STAGE);
    if (SOFTMAX) {
        constexpr int NR = 16 * RB * 8;
        for (int i = tid; i < NR * 33; i += 512) { const int r = i / 33, c = i % 33; mlds[c * NR + r] = mask64[(size_t)r * 33 + c]; }
    }
    FL_DMA(kt_lo, 0);
#pragma unroll
    for (int p = 1; p < NSTG - 1; ++p) if (kt_lo + p <= kt_hi) FL_DMA(kt_lo + p, p);
    int cur = 0;
    for (int kt = kt_lo; kt <= kt_hi; ++kt) {
        if (NSTG == 2 || kt + NSTG - 2 > kt_hi) asm volatile("s_waitcnt vmcnt(0)" ::: "memory");
        else if (NSTG == 3) asm volatile("s_waitcnt vmcnt(%0)" :: "n"(NDMA) : "memory");
        else asm volatile("s_waitcnt vmcnt(%0)" :: "n"(2 * NDMA) : "memory");
        __syncthreads();
        { const int nb_ = cur == 0 ? NSTG - 1 : cur - 1; if (kt + NSTG - 1 <= kt_hi) FL_DMA(kt + NSTG - 1, nb_); }
        const PG8_LAS unsigned char* Ks = lds + cur * STAGE; const PG8_LAS unsigned char* Vs = Ks + KBYTES;
        cur = (cur + 1 == NSTG) ? 0 : cur + 1;
        const PG8_LAS unsigned char* kp[4]; const PG8_LAS unsigned char* vp4[4];
#pragma unroll
        for (int a = 0; a < 4; ++a) { kp[a] = Ks + koff[a]; vp4[a] = Vs + voff[a]; }
        u64 mw[RB];
        if (SOFTMAX) {
#pragma unroll
            for (int rb = 0; rb < RB; ++rb) mw[rb] = mlds[kt * (16 * RB * 8) + w * 16 * RB + rb * 16 + fr];
        }
        f32x4 s[4][RB];
#pragma unroll
        for (int kb = 0; kb < 4; ++kb)
#pragma unroll
            for (int rb = 0; rb < RB; ++rb) s[kb][rb] = (f32x4){0.f, 0.f, 0.f, 0.f};
        {
            constexpr int GPK = NKS / 4, NGS = 4 * GPK;
            bf16x8 fg[3][4];
#define FL_LDK(G) do { _Pragma("unroll") for (int q4 = 0; q4 < 4; ++q4) { const int ks_ = ((G) % GPK) * 4 + q4; \
                fg[(G) % 3][q4] = *(const PG8_LAS bf16x8*)(kp[ks_ & 3] + ((G) / GPK) * 16 * KCH * 16 + (ks_ >> 2) * 256); } } while (0)
            FL_LDK(0); if (NGS > 1) FL_LDK(1);
#pragma unroll
            for (int g = 0; g < NGS; ++g) {
                if (g + 2 < NGS) FL_LDK(g + 2);
                __builtin_amdgcn_sched_barrier(0);
#pragma unroll
                for (int q4 = 0; q4 < 4; ++q4)
#pragma unroll
                    for (int rb = 0; rb < RB; ++rb) s[g / GPK][rb] = __builtin_amdgcn_mfma_f32_16x16x32_bf16(fg[g % 3][q4], qf[rb][(g % GPK) * 4 + q4], s[g / GPK][rb], 0, 0, 0);
                __builtin_amdgcn_sched_barrier(0);
            }
        }
        bf16x8 pa[RB][2];
#pragma unroll
        for (int rb = 0; rb < RB; ++rb) {
            const int qpos = qpos0 + w * 16 * RB + rb * 16 + fr;
            float p[4][4];
            if (SOFTMAX) {
                const u64 mq = mw[rb] >> (quad * 4);
                const unsigned mlo = (unsigned)mq, mhi = (unsigned)(mq >> 32);
                float tmax = -INFINITY;
#pragma unroll
                for (int kb = 0; kb < 4; ++kb)
#pragma unroll
                    for (int j = 0; j < 4; ++j) {
                        const unsigned wsel = (kb < 2) ? mlo : mhi; const unsigned bitm = 1u << ((kb & 1) * 16 + j);
                        const float v = (wsel & bitm) ? s[kb][rb][j] : -INFINITY;
                        p[kb][j] = v; tmax = fmaxf(tmax, v);
                    }
                tmax = fmaxf(tmax, __shfl_xor(tmax, 16)); tmax = fmaxf(tmax, __shfl_xor(tmax, 32));
                const float tm = tmax * p0;
                if (__ballot(tm > mrun[rb] + 8.f) != 0ull) {
                    const float mnew = fmaxf(mrun[rb], tm); const float msafe = (mnew == -INFINITY) ? 0.f : mnew;
                    const float alpha = __builtin_amdgcn_exp2f(mrun[rb] - msafe);
                    lrun[rb] *= alpha; mrun[rb] = mnew;
#pragma unroll
                    for (int nb = 0; nb < NNB; ++nb) o[nb][rb] *= alpha;
                }
                const float mref = (mrun[rb] == -INFINITY) ? 0.f : mrun[rb];
                float ps = 0.f;
#pragma unroll
                for (int kb = 0; kb < 4; ++kb)
#pragma unroll
                    for (int j = 0; j < 4; ++j) { const float e = __builtin_amdgcn_exp2f(fmaf(p[kb][j], p0, -mref)); p[kb][j] = e; ps += e; }
                lrun[rb] += ps;
            } else {
                const float aq = __builtin_amdgcn_exp2f((float)(qpos - 64 * kt) * p0);
                if (64 * kt + 63 > qpos0 + w * 16 * RB) {
#pragma unroll
                    for (int kb = 0; kb < 4; ++kb)
#pragma unroll
                        for (int j = 0; j < 4; ++j) { const int kpos = 64 * kt + kb * 16 + quad * 4 + j; p[kb][j] = (kpos <= qpos) ? s[kb][rb][j] * (aq * bk[kb][j]) : 0.f; }
                } else {
#pragma unroll
                    for (int kb = 0; kb < 4; ++kb)
#pragma unroll
                        for (int j = 0; j < 4; ++j) p[kb][j] = s[kb][rb][j] * (aq * bk[kb][j]);
                }
                if (kt == 0) {
#pragma unroll
                    for (int kb = 0; kb < 3; ++kb)
#pragma unroll
                        for (int j = 0; j < 4; ++j) p[kb][j] = 0.f;
                }
            }
#pragma unroll
            for (int i = 0; i < 2; ++i) {
                union { bf16x8 v; unsigned u[4]; } t;
                t.u[0] = cvt_pk_bf16(p[2 * i][0], p[2 * i][1]); t.u[1] = cvt_pk_bf16(p[2 * i][2], p[2 * i][3]);
                t.u[2] = cvt_pk_bf16(p[2 * i + 1][0], p[2 * i + 1][1]); t.u[3] = cvt_pk_bf16(p[2 * i + 1][2], p[2 * i + 1][3]);
                pa[rb][i] = t.v;
            }
        }
        {
            constexpr int GPI = NNB / 4, NGV = 2 * GPI;
            bf16x8 vg[3][4];
#define FL_LDV(G) do { _Pragma("unroll") for (int q4 = 0; q4 < 4; ++q4) { const int nb_ = ((G) % GPI) * 4 + q4, i_ = (G) / GPI; \
                vg[(G) % 3][q4] = *(const PG8_LAS bf16x8*)(vp4[i_] + nb_ * 2048); } } while (0)
            FL_LDV(0); FL_LDV(1);
#pragma unroll
            for (int g = 0; g < NGV; ++g) {
                if (g + 2 < NGV) FL_LDV(g + 2);
                __builtin_amdgcn_sched_barrier(0);
#pragma unroll
                for (int q4 = 0; q4 < 4; ++q4)
#pragma unroll
                    for (int rb = 0; rb < RB; ++rb) o[(g % GPI) * 4 + q4][rb] = __builtin_amdgcn_mfma_f32_16x16x32_bf16(vg[g % 3][q4], pa[rb][g / GPI], o[(g % GPI) * 4 + q4][rb], 0, 0, 0);
                __builtin_amdgcn_sched_barrier(0);
            }
        }
    }
#pragma unroll
    for (int rb = 0; rb < RB; ++rb) {
        const int qrow = w * 16 * RB + rb * 16 + fr;
        float scale = 1.f;
        if (SOFTMAX) { float l = lrun[rb]; l += __shfl_xor(l, 16); l += __shfl_xor(l, 32); scale = 1.f / l; }
        float part = 0.f;
#pragma unroll
        for (int nb = 0; nb < NNB; ++nb) {
            const f32x4 v = o[nb][rb] * scale;
            part += (v[0] * v[0] + v[1] * v[1]) + (v[2] * v[2] + v[3] * v[3]);
            *(uint2*)(Out + (size_t)qrow * ldo + nb * 16 + quad * 4) = pack4(v[0], v[1], v[2], v[3]);
        }
        if (!SOFTMAX) { part += __shfl_xor(part, 16); part += __shfl_xor(part, 32); if (quad == 0) atomicAdd(ssqY + (size_t)qrow * 4, part); }
    }
}

__device__ __forceinline__ unsigned next_unit(unsigned* ctr, unsigned char* smem) {
    volatile unsigned* sh = (volatile unsigned*)(smem + LDS_CTL);
    __syncthreads();
    if (threadIdx.x == 0) *sh = atomicAdd(ctr, 1u);
    __syncthreads();
    return (unsigned)__builtin_amdgcn_readfirstlane((int)*sh);
}

__device__ __forceinline__ void retention_unit(const Args& A, unsigned char* smem, int b, int h, int qb, int dvh) {
    unsigned char* ws = A.ws;
    const bf16_t* RQ = (const bf16_t*)(ws + OFF_RQ); const bf16_t* RKs = (const bf16_t*)(ws + OFF_RKS); const bf16_t* RVt = (const bf16_t*)(ws + OFF_RVT);
    bf16_t* Y = (bf16_t*)A.out; float* ssqY = (float*)(ws + OFF_SSQY);
    const int s0 = 128 * qb, row0 = b * SEQ + s0, qpos0 = SPOS0 + NMETA + s0;
    const float l2g = A.l2g[h]; const int cut = (int)(40.f / -l2g);
    int kt_lo = (qpos0 - cut) / 64; if (qpos0 < cut) kt_lo = 0;
    flash_unit<256, 256, 1, false, 2>(RQ + (size_t)row0 * 1024 + h * 256, 1024, RKs + (size_t)b * TP * 1024 + h * 256, 1024, RVt + ((size_t)(b * 4 + h) * 512 + dvh * 256) * TP,
                                      Y + (size_t)row0 * 2048 + h * 512 + dvh * 256, 2048, qpos0, kt_lo, (qpos0 + 127) / 64, nullptr, l2g, ssqY + (size_t)row0 * 4 + h, smem);
}
__device__ __forceinline__ void retention_phase(const Args& A, unsigned char* smem) {
    if (gridDim.x == 256) {
        const int b = blockIdx.x & 7, c = blockIdx.x >> 3, dvh = c & 1, j = c >> 1;
        for (int r = 0; r < 4; ++r) { __syncthreads(); retention_unit(A, smem, b, 3 - r, (r & 1) ? 15 - j : j, dvh); }
    } else {
        unsigned* ctr = (unsigned*)(A.ws + OFF_CTR) + 0;
        for (;;) { const unsigned u = next_unit(ctr, smem); if (u >= 1024u) break;
            const int rest = (int)(u & 63); retention_unit(A, smem, rest >> 3, (rest >> 1) & 3, 15 - (int)(u >> 6), rest & 1); }
    }
}
__device__ __forceinline__ void attention_unit(const Args& A, unsigned char* smem, int b, int h, int qb) {
    unsigned char* ws = A.ws;
    bf16_t* AQ = (bf16_t*)(ws + OFF_AQ); const bf16_t* AKs = (const bf16_t*)(ws + OFF_AKS); const bf16_t* AVt = (const bf16_t*)(ws + OFF_AVT);
    const u64* mask64 = (const u64*)(ws + OFF_MASK);
    const int s0 = 128 * qb, row0 = b * SEQ + s0, qpos0 = SPOS0 + NMETA + s0;
    flash_unit<128, 128, 1, true, 3>(AQ + (size_t)row0 * 1024 + h * 128, 1024, AKs + (size_t)b * TP * 1024 + h * 128, 1024, AVt + (size_t)(b * 8 + h) * 128 * TP,
                                     AQ + (size_t)row0 * 1024 + h * 128, 1024, qpos0, 0, (qpos0 + 127) / 64, mask64 + (size_t)row0 * 33, 0.08838834764831845f * 1.4426950408889634f, nullptr, smem);
}
__device__ __forceinline__ void attention_phase(const Args& A, unsigned char* smem) {
    if (gridDim.x == 256) {
        const int b = blockIdx.x & 7, c = blockIdx.x >> 3;
        for (int r = 0; r < 4; ++r) { __syncthreads(); attention_unit(A, smem, b, 2 * r + (c >> 4), (r & 1) ? 15 - (c & 15) : (c & 15)); }
    } else {
        unsigned* ctr = (unsigned*)(A.ws + OFF_CTR) + 2;
        for (;;) { const unsigned u = next_unit(ctr, smem); if (u >= 1024u) break;
            const int bh = (int)(u & 63); attention_unit(A, smem, bh >> 3, bh & 7, 15 - (int)(u >> 6)); }
    }
}

__device__ __forceinline__ void cnt_ge_u32(int& c, unsigned a, unsigned b) { asm volatile("v_cmp_ge_u32 vcc, %1, %2\n\tv_addc_co_u32 %0, vcc, 0, %0, vcc" : "+v"(c) : "v"(a), "v"(b) : "vcc"); }
__device__ __forceinline__ void cnt_gt_u32(int& c, unsigned a, unsigned b) { asm volatile("v_cmp_gt_u32 vcc, %1, %2\n\tv_addc_co_u32 %0, vcc, 0, %0, vcc" : "+v"(c) : "v"(a), "v"(b) : "vcc"); }
__device__ __forceinline__ void cnt_eq_u32(int& c, unsigned a, unsigned b) { asm volatile("v_cmp_eq_u32 vcc, %1, %2\n\tv_addc_co_u32 %0, vcc, 0, %0, vcc" : "+v"(c) : "v"(a), "v"(b) : "vcc"); }
__device__ __forceinline__ void cnt_lt_i32(int& c, int a, int b) { asm volatile("v_cmp_lt_i32 vcc, %1, %2\n\tv_addc_co_u32 %0, vcc, 0, %0, vcc" : "+v"(c) : "v"(a), "v"(b) : "vcc"); }
__device__ __forceinline__ int sel_eq_idx(unsigned a, unsigned b, int idx) { int e; const int huge = 0x7fffffff; asm volatile("v_cmp_eq_u32 vcc, %1, %2\n\tv_cndmask_b32 %0, %3, %4, vcc" : "=v"(e) : "v"(a), "v"(b), "v"(huge), "v"(idx) : "vcc"); return e; }
__device__ __forceinline__ int sel_gt_m1(unsigned a, unsigned b, int e) { int v; const int m1 = -1; asm volatile("v_cmp_gt_u32 vcc, %1, %2\n\tv_cndmask_b32 %0, %3, %4, vcc" : "=v"(v) : "v"(a), "v"(b), "v"(e), "v"(m1) : "vcc"); return v; }
__device__ __forceinline__ void shl_in_le_i32(unsigned& nib, int a, int b) { asm volatile("v_cmp_le_i32 vcc, %1, %2\n\tv_addc_co_u32 %0, vcc, %0, %0, vcc" : "+v"(nib) : "v"(a), "v"(b) : "vcc"); }

template <int NP>
__device__ __forceinline__ int pk_count_ge(const unsigned (&x)[NP], unsigned cand) {
    const unsigned cm1 = (cand - 1u) * 0x00010001u, one = 0x00010001u;
    unsigned c = 0u;
#pragma unroll
    for (int m = 0; m < NP; ++m) {
        unsigned t;
        asm("v_pk_sub_u16 %0, %1, %2 clamp" : "=v"(t) : "v"(x[m]), "v"(cm1));
        asm("v_pk_min_u16 %0, %1, %2" : "=v"(t) : "v"(t), "v"(one));
        asm("v_pk_add_u16 %0, %1, %2" : "=v"(c) : "v"(c), "v"(t));
    }
    int v = (int)((c & 0xFFFFu) + (c >> 16));
    v += __builtin_amdgcn_update_dpp(0, v, 0x111, 0xf, 0xf, true);
    v += __builtin_amdgcn_update_dpp(0, v, 0x112, 0xf, 0xf, true);
    v += __builtin_amdgcn_update_dpp(0, v, 0x114, 0xf, 0xf, true);
    v += __builtin_amdgcn_update_dpp(0, v, 0x118, 0xf, 0xf, true);
    v += __builtin_amdgcn_update_dpp(0, v, 0x142, 0xa, 0xf, false);
    v += __builtin_amdgcn_update_dpp(0, v, 0x143, 0xc, 0xf, false);
    return __builtin_amdgcn_readlane(v, 63);
}

template <int NI>
__device__ __forceinline__ u64 select_query(const unsigned* skq, int lane) {
    unsigned uk[NI];
#pragma unroll
    for (int i = 0; i < NI; ++i) uk[i] = skq[64 * i + lane];
    unsigned hp[NI / 2];
#pragma unroll
    for (int m = 0; m < NI / 2; ++m) hp[m] = (uk[2 * m] >> 16) | (uk[2 * m + 1] & 0xFFFF0000u);
    unsigned T16 = 0u;
    for (int bit = 15; bit >= 0; --bit) {
        const unsigned cand = T16 | (1u << bit);
        if (pk_count_ge<NI / 2>(hp, cand) >= 256) T16 = cand;
    }
    const int cgt_hi = (T16 < 0xFFFFu) ? pk_count_ge<NI / 2>(hp, T16 + 1u) : 0;
    const int need_lo = 256 - cgt_hi;
#pragma unroll
    for (int m = 0; m < NI / 2; ++m) {
        const unsigned a = uk[2 * m], b2 = uk[2 * m + 1];
        const unsigned la = ((a >> 16) == T16) ? (a & 0xFFFFu) : 0u, lb = ((b2 >> 16) == T16) ? (b2 << 16) : 0u;
        hp[m] = la | lb;
    }
    unsigned L16 = 0u;
    for (int bit = 15; bit >= 0; --bit) {
        const unsigned cand = L16 | (1u << bit);
        if (pk_count_ge<NI / 2>(hp, cand) >= need_lo) L16 = cand;
    }
    const unsigned Tq = (T16 << 16) | L16;
    int cgt = 0;
#pragma unroll
    for (int i = 0; i < NI; ++i) cgt += __builtin_popcountll(__ballot(uk[i] > Tq));
    int rem = 256 - cgt;
    u64 myout = (lane == 0) ? (0xFFFFull << 48) : 0ull;
#pragma unroll
    for (int i = 0; i < NI; ++i) {
        const u64 gt = __ballot(uk[i] > Tq); u64 eq = __ballot(uk[i] == Tq);
        const int ce = __builtin_popcountll(eq);
        if (ce > rem) eq = __ballot(((eq >> lane) & 1ull) && (int)__builtin_amdgcn_mbcnt_hi((unsigned)(eq >> 32), __builtin_amdgcn_mbcnt_lo((unsigned)eq, 0u)) < rem);
        rem -= (ce > rem) ? rem : ce;
        const u64 sel = gt | eq;
        if (lane == i + 1) myout = sel;
    }
    return myout;
}

__device__ __forceinline__ void indexer_phase(const Args& A, unsigned char* smem) {
    unsigned char* ws = A.ws; unsigned* ctr = (unsigned*)(ws + OFF_CTR) + 1;
    const bf16_t* IQ = (const bf16_t*)(ws + OFF_IQ); const bf16_t* IK = (const bf16_t*)(ws + OFF_IK); const float* IW = (const float*)(ws + OFF_IW);
    u64* mask64 = (u64*)(ws + OFF_MASK);
    constexpr int SKS = 2052;
    unsigned* sk = (unsigned*)smem;
    const int tid = threadIdx.x, lane = tid & 63, w = __builtin_amdgcn_readfirstlane(tid >> 6), fr = lane & 15, quad = lane >> 4;
    for (;;) {
        const unsigned u = next_unit(ctr, smem); if (u >= 1024u) break;
        const int g = 127 - (int)(u >> 3), b = (int)(u & 7), s0 = 16 * g, row0 = b * SEQ + s0;
        const int nkeys = s0 + 16, ni = (nkeys + 63) >> 6;
        if (g >= 16) {
            { const int nz = 512 * ((ni + 7) >> 3) - nkeys; for (int i = tid; i < 16 * nz; i += 512) { const int r = i / nz, c = nkeys + (i % nz); sk[r * SKS + c] = 0u; } }
            bf16x8 qf[8][2];
#pragma unroll
            for (int h = 0; h < 8; ++h)
#pragma unroll
                for (int ks = 0; ks < 2; ++ks) qf[h][ks] = *(const bf16x8*)(IQ + (size_t)(row0 + fr) * 512 + h * 64 + ks * 32 + quad * 8);
            const float4 w0 = *(const float4*)(IW + (size_t)(row0 + fr) * 8), w1 = *(const float4*)(IW + (size_t)(row0 + fr) * 8 + 4);
            const float wq[8] = {w0.x, w0.y, w0.z, w0.w, w1.x, w1.y, w1.z, w1.w};
            const bf16_t* kbase = IK + (size_t)(b * SEQ + fr) * 64 + quad * 8;
            bf16x8 nk0 = *(const bf16x8*)(kbase + (size_t)(16 * w) * 64), nk1 = *(const bf16x8*)(kbase + (size_t)(16 * w) * 64 + 32);
            for (int kt = w; kt <= g; kt += 8) {
                const bf16x8 kf0 = nk0, kf1 = nk1;
                if (kt + 8 <= g) { nk0 = *(const bf16x8*)(kbase + (size_t)(16 * (kt + 8)) * 64); nk1 = *(const bf16x8*)(kbase + (size_t)(16 * (kt + 8)) * 64 + 32); }
                float sc[4] = {0.f, 0.f, 0.f, 0.f};
#pragma unroll
                for (int h = 0; h < 8; ++h) {
                    f32x4 c = __builtin_amdgcn_mfma_f32_16x16x32_bf16(kf0, qf[h][0], (f32x4){0.f, 0.f, 0.f, 0.f}, 0, 0, 0);
                    c = __builtin_amdgcn_mfma_f32_16x16x32_bf16(kf1, qf[h][1], c, 0, 0, 0);
#pragma unroll
                    for (int j = 0; j < 4; ++j) sc[j] += wq[h] * fmaxf(c[j], 0.f);
                }
                unsigned kk[4];
#pragma unroll
                for (int j = 0; j < 4; ++j) {
                    const int s = 16 * kt + quad * 4 + j;
                    const unsigned bits = __float_as_uint(sc[j] + 0.0f);
                    const unsigned ok = bits ^ ((unsigned)((int)bits >> 31) | 0x80000000u);
                    kk[j] = (s > s0 + fr) ? 0u : ok;
                }
                *(uint4*)(sk + fr * SKS + 16 * kt + quad * 4) = make_uint4(kk[0], kk[1], kk[2], kk[3]);
            }
        }
        __syncthreads();
#ifdef DUPB
#define NQQ 4
#else
#define NQQ 2
#endif
#pragma unroll 1
        for (int qq_ = 0; qq_ < NQQ; ++qq_) {
            const int qq = qq_ & 1; const int q = 2 * w + qq; const int sq = s0 + q;
            u64 myout = 0ull;
            if (g >= 16) {
                const unsigned* skq = sk + q * SKS;
                const int n8 = (ni + 7) >> 3;
                if (n8 == 1) myout = select_query<8>(skq, lane); else if (n8 == 2) myout = select_query<16>(skq, lane);
                else if (n8 == 3) myout = select_query<24>(skq, lane); else myout = select_query<32>(skq, lane);
            } else {
                const int lim = sq - 64 * (lane - 1);
                myout = lane == 0 ? (0xFFFFull << 48) : (lim >= 63 ? ~0ull : (lim < 0 ? 0ull : ((2ull << lim) - 1ull)));
            }
            if (lane < 33) mask64[(size_t)(row0 + q) * 33 + lane] = myout;
        }
    }
}


__device__ __forceinline__ void meta_down_phase(const Args& A, unsigned char* smem) {
    unsigned char* ws = A.ws;
    const bf16_t* act = (const bf16_t*)(ws + OFF_ACT); const bf16_t* Wd = (const bf16_t*)(ws + OFF_WD1);
    float* part = (float*)(ws + OFF_MPART); unsigned* ctr = (unsigned*)(ws + OFF_CTR) + 16;
    bf16_t* h1b = (bf16_t*)(ws + OFF_H1B); float* ssq1 = (float*)(ws + OFF_SSQ1);
    const int tid = threadIdx.x, lane = tid & 63, w = __builtin_amdgcn_readfirstlane(tid >> 6), fr = lane & 15, quad = lane >> 4;
    float* lred = (float*)smem;
    volatile unsigned* sh = (volatile unsigned*)(smem + LDS_CTL + 16);
    for (int task = blockIdx.x; task < 64; task += gridDim.x) {
        const int ct = task & 15, ksp = task >> 4;
        f32x4 acc[4];
#pragma unroll
        for (int h = 0; h < 4; ++h) acc[h] = (f32x4){0.f, 0.f, 0.f, 0.f};
        for (int ks = w; ks < 22; ks += 8) {
            const int kb = ksp * 704 + ks * 32 + quad * 8;
            const bf16x8 af = *(const bf16x8*)(act + (size_t)(MR + fr) * DFF + kb);
            bf16x8 bfv[4];
#pragma unroll
            for (int h = 0; h < 4; ++h) bfv[h] = *(const bf16x8*)(Wd + (size_t)(64 * ct + 16 * h + fr) * DFF + kb);
#pragma unroll
            for (int h = 0; h < 4; ++h) acc[h] = __builtin_amdgcn_mfma_f32_16x16x32_bf16(af, bfv[h], acc[h], 0, 0, 0);
        }
        __syncthreads();
#pragma unroll
        for (int h = 0; h < 4; ++h)
#pragma unroll
            for (int j = 0; j < 4; ++j) lred[(w * 16 + quad * 4 + j) * 64 + 16 * h + fr] = acc[h][j];
        __syncthreads();
#pragma unroll
        for (int q = 0; q < 2; ++q) {
            const int e = tid + 512 * q; float v = 0.f;
#pragma unroll
            for (int ww = 0; ww < 8; ++ww) v += lred[ww * 1024 + e];
            part[((size_t)ksp * 16 + (e >> 6)) * DM + 64 * ct + (e & 63)] = v;
        }
        __threadfence();
        __syncthreads();
        if (tid == 0) { const unsigned old = atomicAdd(ctr + ct, 1u); *sh = (old == 3u) ? 1u : 0u; }
        __syncthreads();
        if (*sh) {
            __threadfence();
#pragma unroll
            for (int q = 0; q < 2; ++q) {
                const int e = tid + 512 * q, m = e >> 6, c = 64 * ct + (e & 63);
                float hv = 0.f;
#pragma unroll
                for (int k4 = 0; k4 < 4; ++k4) hv += __hip_atomic_load(part + ((size_t)k4 * 16 + m) * DM + c, __ATOMIC_RELAXED, __HIP_MEMORY_SCOPE_AGENT);
                const float hval = A.in[1][(size_t)m * DM + c] + 0.5f * hv;
                h1b[(size_t)(MR + m) * DM + c] = f2bf(hval);
                const float s = wave_sum(hval * hval);
                if (lane == 0) atomicAdd(ssq1 + MR + m, s);
            }
        }
    }
    __syncthreads();
}
#define LAS __attribute__((address_space(3)))
#define XB_TMO      128
#define XB_XCNT(j)  (256  + 64 * (j))
#define XB_XSUB(j)  (1280 + 64 * (j))
#define XB_XGEN(j)  (2304 + 64 * (j))
#define XB_TOP      3328
#define XB_TOPGEN   3392
#define XCD_BAR_WORDS 3456
#define XB_SPIN_CAP (1u << 18)

__device__ __forceinline__ unsigned xb_ld(unsigned* p)              { return __hip_atomic_load(p, __ATOMIC_RELAXED, __HIP_MEMORY_SCOPE_AGENT); }
__device__ __forceinline__ unsigned xb_add(unsigned* p, unsigned v) { return __hip_atomic_fetch_add(p, v, __ATOMIC_RELAXED, __HIP_MEMORY_SCOPE_AGENT); }
__device__ __forceinline__ unsigned xb_xcc_id() { return (unsigned)__builtin_amdgcn_s_getreg((3 << 11) | 20) & 0xFu; }
#define XB_SPIN(cond, bar) do { unsigned _sp = 0; while (cond) { __builtin_amdgcn_s_sleep(1); \
    if ((++_sp & 255u) == 0u) { if (xb_ld(&(bar)[XB_TMO])) break; if (_sp > XB_SPIN_CAP) { atomicAdd(&(bar)[XB_TMO], 1u); break; } } } } while (0)

struct XcdBarrier {
    unsigned* bar; unsigned x;
    volatile LAS unsigned* st;
};

__device__ __forceinline__ XcdBarrier xcd_barrier_post(unsigned* bar, volatile LAS unsigned* st) {
    XcdBarrier b; b.bar = bar; b.x = xb_xcc_id(); b.st = st;
    if (threadIdx.x == 0) (void)xb_add(&bar[XB_XCNT(b.x)], 1u);
    return b;
}
__device__ __forceinline__ void xcd_barrier_complete(unsigned* bar, unsigned x, unsigned& nloc, unsigned& nx) {
    const unsigned G = gridDim.x * gridDim.y * gridDim.z;
    unsigned sum, cnt, mine, sp = 0u;
    for (;;) {
        sum = 0u; cnt = 0u; mine = 0u;
#pragma unroll
        for (unsigned j = 0; j < 16; ++j) { const unsigned c = xb_ld(&bar[XB_XCNT(j)]); sum += c; cnt += (c > 0u) ? 1u : 0u; mine = (j == x) ? c : mine; }
        if (sum == G) break;
        __builtin_amdgcn_s_sleep(1);
        if ((++sp & 255u) == 0u) { if (xb_ld(&bar[XB_TMO])) break; if (sp > XB_SPIN_CAP) { atomicAdd(&bar[XB_TMO], 1u); break; } }
    }
    nloc = mine > 0u ? mine : 1u; nx = cnt > 0u ? cnt : 1u;
}

__device__ __forceinline__ void xcd_barrier(const XcdBarrier& b) {
    asm volatile("s_waitcnt vmcnt(0)" ::: "memory");
    __syncthreads();
    if (threadIdx.x == 0) {
        unsigned* bar = b.bar;
        __builtin_amdgcn_s_waitcnt(0);
        unsigned nloc = b.st[0], nx = b.st[1];
        if (nloc == 0u) { xcd_barrier_complete(bar, b.x, nloc, nx); b.st[0] = nloc; b.st[1] = nx; }
        const unsigned old = xb_add(&bar[XB_XSUB(b.x)], 1u);
        const unsigned gen = old / nloc;
        if (old + 1u == (gen + 1u) * nloc) {
            __builtin_amdgcn_fence(__ATOMIC_RELEASE, "agent");
            asm volatile("s_waitcnt vmcnt(0)" ::: "memory");
            const unsigned og = xb_add(&bar[XB_TOP], 1u);
            const unsigned tg = og / nx;
            if (og + 1u == (tg + 1u) * nx) xb_add(&bar[XB_TOPGEN], 1u);
            else XB_SPIN(xb_ld(&bar[XB_TOPGEN]) == tg, bar);
            __builtin_amdgcn_fence(__ATOMIC_ACQUIRE, "agent");
            xb_add(&bar[XB_XGEN(b.x)], 1u);
            asm volatile("s_waitcnt vmcnt(0)" ::: "memory");
        } else {
            XB_SPIN(xb_ld(&bar[XB_XGEN(b.x)]) == gen, bar);
            __builtin_amdgcn_fence(__ATOMIC_ACQUIRE, "agent");
            asm volatile("s_waitcnt vmcnt(0)" ::: "memory");
        }
    }
    __syncthreads();
}
#define GEMM_PHASE(EPI, e, Aptr, Bptr, Mrows, Ncols, Kdim) do { pg8::Gemm g_{(const bf16_t*)(Aptr), (const bf16_t*)(Bptr), (Mrows), (Ncols), (Kdim)}; pg8::StaticOrder S_; S_.init((Mrows), (Ncols), (int)gridDim.x, (int)blockIdx.x); \
    pg8::gemm_phase<EPI, pg8::StaticOrder, true, true>((PG8_LAS unsigned char*)smem, g_, S_, e); } while (0)

__global__ void __launch_bounds__(512, 2) mk_fwd(Args A) {
    extern __shared__ __attribute__((aligned(16))) unsigned char smem[];
    unsigned char* ws = A.ws;
    const int lo = A.ph_lo, hi = A.ph_hi;
    volatile LAS unsigned* xst = (volatile LAS unsigned*)((LAS unsigned char*)smem + LDS_CTL + 64);
    if (threadIdx.x < 2) xst[threadIdx.x] = 0u;
    __syncthreads();
    const XcdBarrier xbar = xcd_barrier_post((unsigned*)(ws + OFF_BAR), xst);
#ifndef PHMASK
#define PHMASK 0xFFFFF
#endif
#define IN(k) (((PHMASK >> (k)) & 1) && lo <= (k) && (k) < hi)
#if MK_COOP
#define SEAM(k) do { if (IN(k) && IN((k) + 1)) { if ((k) == 0) cg::this_grid().sync(); else xcd_barrier(xbar); } } while (0)
#else
#define SEAM(k) do { } while (0)
#endif
#ifdef PROBE_PHASE
    unsigned long long pt0 = 0, pt1 = 0;
#define PSTAMP(k) do { if ((k) == PROBE_PHASE) pt0 = __builtin_amdgcn_s_memrealtime(); if ((k) == PROBE_PHASE + 1) pt1 = __builtin_amdgcn_s_memrealtime(); } while (0)
#else
#define PSTAMP(k) do { } while (0)
#endif
    float* ssq0 = (float*)(ws + OFF_SSQ0); float* ssq1 = (float*)(ws + OFF_SSQ1); float* ssq2 = (float*)(ws + OFF_SSQ2); float* ssq3 = (float*)(ws + OFF_SSQ3); float* ssqY = (float*)(ws + OFF_SSQY);
    bf16_t* h1b = (bf16_t*)(ws + OFF_H1B); bf16_t* delta = (bf16_t*)(ws + OFF_DELTA);
    PSTAMP(0);
    if (IN(0)) { p0_prologue(A, smem); }
    SEAM(0);
    PSTAMP(1);
    if (IN(1)) { EpiSwiGLU e{(bf16_t*)(ws + OFF_ACT), ssq0}; GEMM_PHASE(EpiSwiGLU, e, A.out, ws + OFF_W1, MP, 5632, DM); }
    SEAM(1);
    PSTAMP(2);
    if (IN(2)) { meta_down_phase(A, smem); EpiResid e{A.in[0], nullptr, nullptr, nullptr, h1b, delta, ssq1, 0.5f}; GEMM_PHASE(EpiResid, e, ws + OFF_ACT, ws + OFF_WD1, MR, DM, DFF); }
    SEAM(2);
    PSTAMP(3);
    if (IN(3)) { EpiRet e{ssq1, (const float2*)(ws + OFF_TAB256), (bf16_t*)(ws + OFF_RQ), (bf16_t*)(ws + OFF_RKS), (bf16_t*)(ws + OFF_RVT)}; GEMM_PHASE(EpiRet, e, h1b, ws + OFF_WINA, MP, 4096, DM); }
    SEAM(3);
    PSTAMP(4);
    if (IN(4)) { retention_phase(A, smem); }
    SEAM(4);
    PSTAMP(5);
    if (IN(5)) { EpiAtt e{ssq1, (const float2*)(ws + OFF_TAB128), (const float2*)(ws + OFF_TAB64), ssqY, (bf16_t*)(ws + OFF_AQ), (bf16_t*)(ws + OFF_AKS), (bf16_t*)(ws + OFF_AVT),
                          (bf16_t*)(ws + OFF_IQ), (bf16_t*)(ws + OFF_IK), (float*)(ws + OFF_IW), (bf16_t*)A.out};
                 GEMM_PHASE(EpiAtt, e, h1b, ws + OFF_WINB, MP, 5888, DM); }
    SEAM(5);
    PSTAMP(6);
    if (IN(6)) { indexer_phase(A, smem); }
    SEAM(6);
    PSTAMP(7);
    if (IN(7)) { attention_phase(A, smem); }
    SEAM(7);
    PSTAMP(8);
    if (IN(8)) { { EpiPlain e{(bf16_t*)(ws + OFF_YR)}; GEMM_PHASE(EpiPlain, e, A.out, ws + OFF_WRO, MR, DM, 2048); }
                 { EpiPlain e{(bf16_t*)(ws + OFF_YA)}; GEMM_PHASE(EpiPlain, e, ws + OFF_AQ, ws + OFF_WAO, MR, DM, DM); } }
    SEAM(8);
    PSTAMP(9);
    if (IN(9)) { EpiGate e{ssq1, (bf16_t*)(ws + OFF_YR), (const bf16_t*)(ws + OFF_YA)}; GEMM_PHASE(EpiGate, e, h1b, ws + OFF_WINC, MR, 2048, DM); }
    SEAM(9);
    PSTAMP(10);
    if (IN(10)) { EpiResid e{A.in[0], delta, nullptr, A.out, h1b, nullptr, ssq2, 1.0f}; GEMM_PHASE(EpiResid, e, ws + OFF_YR, ws + OFF_WMX, MR, DM, DM); }
    SEAM(10);
    PSTAMP(11);
    if (IN(11)) { EpiSwiGLU e{(bf16_t*)(ws + OFF_ACT2), ssq2}; GEMM_PHASE(EpiSwiGLU, e, h1b, ws + OFF_W2, MR, 5632, DM); }
    SEAM(11);
    PSTAMP(12);
    if (IN(12)) { EpiResid e{A.out, nullptr, nullptr, A.out, nullptr, nullptr, ssq3, 0.5f}; GEMM_PHASE(EpiResid, e, ws + OFF_ACT2, ws + OFF_WD2, MR, DM, DFF); }
    SEAM(12);
    PSTAMP(13);
    if (IN(13)) {
        const float* gf = A.in[15];
        const int lane = threadIdx.x & 63, wave = threadIdx.x >> 6;
        for (int row = blockIdx.x * 8 + wave; row < MR; row += gridDim.x * 8) {
            const float r = rstd1024(ssq3, row);
            float4* p = (float4*)(A.out + (size_t)row * DM);
#ifdef PROBE_PHASE
            const float pd = 0.08f * sqrtf((float)(pt1 - pt0) * 1e-5f);
#endif
#pragma unroll
            for (int j = 0; j < 4; ++j) { float4 v = p[lane + 64 * j]; const float4 g = ((const float4*)gf)[lane + 64 * j];
                v.x *= r * g.x; v.y *= r * g.y; v.z *= r * g.z; v.w *= r * g.w;
#ifdef PROBE_PHASE
                if (j == 0 && lane == 0) v.x += pd;
#endif
                p[lane + 64 * j] = v; }
        }
    }
}
constexpr int NPHASE = 14;

extern "C" void kernel_launch(void* const* d_in, const int* in_sizes, int n_in, void* d_out, int out_size, void* d_ws, size_t ws_size, hipStream_t stream) {
    static int grid = 0;
    if (grid == 0) {
        if (n_in != 16 || out_size != MR * DM || ws_size < 256 * MiB) { fprintf(stderr, "kernel_launch: unexpected problem (n_in %d out %d ws %zu)\n", n_in, out_size, ws_size); grid = -1; return; }
        int dev = 0, cus = 0, per_cu = 0;
        hipGetDevice(&dev); hipDeviceGetAttribute(&cus, hipDeviceAttributeMultiprocessorCount, dev);
        if (hipFuncSetAttribute((const void*)mk_fwd, hipFuncAttributeMaxDynamicSharedMemorySize, LDS_BYTES) != hipSuccess) { fprintf(stderr, "kernel_launch: hipFuncSetAttribute failed\n"); grid = -1; return; }
        hipOccupancyMaxActiveBlocksPerMultiprocessor(&per_cu, (const void*)mk_fwd, 512, LDS_BYTES);
        (void)hipGetLastError();
        if (per_cu < 1) per_cu = 1;
        grid = cus * 1;
        fprintf(stderr, "kernel_launch: cus %d per_cu %d grid %d\n", cus, per_cu, grid);
    }
    if (grid < 0) return;
    Args a{};
    for (int i = 0; i < 16; ++i) a.in[i] = (const float*)d_in[i];
    a.out = (float*)d_out; a.ws = (unsigned char*)d_ws;
    for (int h = 0; h < 4; ++h) a.l2g[h] = (float)(std::log1p(-std::ldexp(1.0, -5 - h)) / std::log(2.0));
#if MK_COOP
    if (hipMemsetAsync((char*)d_ws + OFF_BAR, 0, 16384, stream) != hipSuccess) { fprintf(stderr, "kernel_launch: memset failed\n"); return; }
    a.ph_lo = 0; a.ph_hi = NPHASE;
    void* args[] = {&a};
    hipError_t e = hipLaunchCooperativeKernel((const void*)mk_fwd, dim3(grid), dim3(512), args, LDS_BYTES, stream);
    if (e != hipSuccess) fprintf(stderr, "cooperative launch failed: %s (grid %d)\n", hipGetErrorString(e), grid);
#else
    for (int p = 0; p < NPHASE; ++p) { a.ph_lo = p; a.ph_hi = p + 1; hipLaunchKernelGGL(mk_fwd, dim3(grid), dim3(512), LDS_BYTES, stream, a); }
#endif
}
```

```cpp
#include <hip/hip_runtime.h>
#include <hip/hip_cooperative_groups.h>
#include <cstdio>
#include <cstdint>
#include <cmath>
namespace cg = cooperative_groups;
namespace pg8 {
#define PG8_LAS __attribute__((address_space(3)))
typedef unsigned short bf16_t;
typedef short bf16x8 __attribute__((ext_vector_type(8)));
typedef float f32x4 __attribute__((ext_vector_type(4)));
typedef unsigned u32x4 __attribute__((ext_vector_type(4)));
constexpr int BM = 256, BK = 64, HALF = 128, HTB = HALF * BK * 2  , STAGE_BYTES = 8 * HTB, NXCD = 8, WGM = 8;

__host__ __device__ __forceinline__ int lds_byte(int r, int c) { const int st = (r >> 4) * 2 + (c >> 5), rr = r & 15, cc = c & 31, ob = rr * 64 + cc * 2; return st * 1024 + (ob ^ (((ob >> 9) & 1) << 5)); }
__host__ __device__ __forceinline__ void stage_rc(int b, int& R, int& C) { const int st = b / 1024, sb = b % 1024, swz = sb ^ (((sb >> 9) & 1) << 5); R = (st >> 1) * 16 + swz / 64; C = (st & 1) * 32 + (swz % 64) / 2; }
__host__ __device__ __forceinline__ int perm32(int rho) { const int n = rho >> 4, i = rho & 15; return 8 * (i >> 2) + 4 * n + (i & 3); }

struct Unit { int pm, pn; };
struct Gemm { const bf16_t* A; const bf16_t* Bt; int M, N, K; };

struct StaticOrder {
    int nM, nN, nwg, G, c;
    __host__ __device__ void init(int M, int N, int G_, int c_) { nM = M / BM; nN = N / BM; nwg = nM * nN; G = G_; c = c_; }
    __host__ __device__ bool next(int i, Unit& u) const {
        const long L = (long)i * G + c; if (L >= nwg) return false;
        int wgid = (int)L; { const int q = nwg / NXCD, r = nwg % NXCD, xcd = wgid % NXCD, off = wgid / NXCD; wgid = (xcd < r ? xcd * (q + 1) : r * (q + 1) + (xcd - r) * q) + off; }
        const int nig = WGM * nN, gid = wgid / nig, fm = gid * WGM, gsz = (nM - fm) < WGM ? (nM - fm) : WGM;
        u.pm = fm + ((wgid % nig) % gsz); u.pn = (wgid % nig) / gsz; return true;
    }
    __device__ __forceinline__ void a_ready(const Unit&) const {}
    __device__ __forceinline__ void done(const Unit&) const {}
};

__device__ __forceinline__ unsigned cvt_pk_bf16(float lo, float hi) { unsigned r; asm volatile("v_cvt_pk_bf16_f32 %0, %1, %2" : "=v"(r) : "v"(lo), "v"(hi)); return r; }

template <class Epi, class Sched, bool ALIGN_EPI = false, bool SP2 = false>
__device__ __forceinline__ void gemm_phase(PG8_LAS unsigned char* lds, const Gemm g, const Sched& S, const Epi& E) {
    const int tid = threadIdx.x, wid = __builtin_amdgcn_readfirstlane(tid >> 6), lane = tid & 63, wr = wid >> 2, wc = wid & 3, fr = lane & 15, fq = lane >> 4;
    const int K = g.K, nt = K / BK;
    unsigned voffA[2], voffB[2];
#pragma unroll
    for (int i = 0; i < 2; ++i) { int R, C; stage_rc(tid * 16 + i * 8192, R, C); const int Rb = Epi::PERM ? ((R & ~31) + perm32(R & 31)) : R;
        voffA[i] = (unsigned)(R * K + C) * 2u; voffB[i] = (unsigned)(Rb * K + C) * 2u; }
    const size_t kstep = (size_t)(BK * 2);
    const size_t hstep = (size_t)HALF * K * 2;
    const size_t tstep = 2 * hstep;
    const unsigned ldsw = (unsigned)wid * 1024u;
    const int aoff = lds_byte(wr * 64 + fr, fq * 8), boff = lds_byte(wc * 32 + fr, fq * 8);
#define PG8_SA(b, h) (((b) * 2 + (h)) * HTB)
#define PG8_SB(b, h) ((4 + (b) * 2 + (h)) * HTB)
#define PG8_STAGE(bufoff, gbase, voff) do { _Pragma("unroll") for (int _i = 0; _i < 2; ++_i) \
        __builtin_amdgcn_global_load_lds((const unsigned*)((const char*)(gbase) + (voff)[_i]), (PG8_LAS unsigned*)(lds + (bufoff) + ldsw + _i * 8192), 16, 0, 0); } while (0)
#define PG8_LDA(dst, b, h) do { _Pragma("unroll") for (int m = 0; m < 4; ++m) _Pragma("unroll") for (int k = 0; k < 2; ++k) dst[m][k] = *(const PG8_LAS bf16x8*)(lds + PG8_SA(b, h) + aoff + m * 2048 + k * 1024); } while (0)
#define PG8_LDB(dst, b, h) do { _Pragma("unroll") for (int n = 0; n < 2; ++n) _Pragma("unroll") for (int k = 0; k < 2; ++k) dst[n][k] = *(const PG8_LAS bf16x8*)(lds + PG8_SB(b, h) + boff + n * 2048 + k * 1024); } while (0)
#define PG8_MMA(ai, bj, At, Bt) do { __builtin_amdgcn_s_setprio(1); _Pragma("unroll") for (int m = 0; m < 4; ++m) _Pragma("unroll") for (int n = 0; n < 2; ++n) _Pragma("unroll") for (int k = 0; k < 2; ++k) \
        acc[ai][bj][m][n] = __builtin_amdgcn_mfma_f32_16x16x32_bf16(Bt[n][k], At[m][k], acc[ai][bj][m][n], 0, 0, 0); __builtin_amdgcn_s_setprio(0); } while (0)
#define PG8_WAIT_V(n) asm volatile("s_waitcnt vmcnt(" #n ")" ::: "memory")
#define PG8_WAIT_L(n) asm volatile("s_waitcnt lgkmcnt(" #n ")" ::: "memory")
#define PG8_BAR __builtin_amdgcn_s_barrier()
#define PG8_SCHED __builtin_amdgcn_sched_barrier(0)
    Unit cur, nxt; int ui = 0;
    if (!S.next(0, cur)) return;
    f32x4 acc[2][2][4][2];
#pragma unroll
    for (int a = 0; a < 2; ++a)
#pragma unroll
        for (int b = 0; b < 2; ++b)
#pragma unroll
            for (int m = 0; m < 4; ++m)
#pragma unroll
                for (int n = 0; n < 2; ++n) acc[a][b][m][n] = (f32x4){0.f, 0.f, 0.f, 0.f};
    bf16x8 At[4][2], B0[2][2], B1[2][2];
    const char* cA = (const char*)g.A + (size_t)cur.pm * tstep; const char* cB = (const char*)g.Bt + (size_t)cur.pn * tstep;
    S.a_ready(cur);
    if constexpr (SP2) {
        PG8_STAGE(PG8_SB(0, 0), cB, voffB); PG8_STAGE(PG8_SB(0, 1), cB + hstep, voffB); PG8_STAGE(PG8_SA(0, 0), cA, voffA); PG8_STAGE(PG8_SA(0, 1), cA + hstep, voffA);
        if (wr == 1) PG8_BAR;
        PG8_WAIT_V(2); PG8_BAR;
        PG8_STAGE(PG8_SB(1, 0), cB + kstep, voffB); PG8_STAGE(PG8_SA(1, 0), cA + kstep, voffA); PG8_STAGE(PG8_SB(1, 1), cB + hstep + kstep, voffB);
        PG8_WAIT_V(6); PG8_BAR;
    } else {
        PG8_STAGE(PG8_SB(0, 0), cB, voffB); PG8_STAGE(PG8_SA(0, 0), cA, voffA); PG8_STAGE(PG8_SB(0, 1), cB + hstep, voffB); PG8_STAGE(PG8_SA(0, 1), cA + hstep, voffA);
        if (wr == 1) PG8_BAR;
        PG8_WAIT_V(4); PG8_BAR;
        PG8_STAGE(PG8_SB(1, 0), cB + kstep, voffB); PG8_STAGE(PG8_SA(1, 0), cA + kstep, voffA); PG8_STAGE(PG8_SB(1, 1), cB + hstep + kstep, voffB);
        PG8_WAIT_V(6); PG8_BAR;
    }
    for (;;) {
        const bool has_next = S.next(ui + 1, nxt);
        const char* nA = has_next ? (const char*)g.A + (size_t)nxt.pm * tstep : cA; const char* nB = has_next ? (const char*)g.Bt + (size_t)nxt.pn * tstep : cB;
        for (int t = 0; t < nt; t += 2) {
            const bool last = (t == nt - 2);
            const char* a1 = cA + (size_t)(t + 1) * kstep;
            const char* a2 = last ? nA : cA + (size_t)(t + 2) * kstep; const char* b2 = last ? nB : cB + (size_t)(t + 2) * kstep;
            const char* a3 = a2 + kstep; const char* b3 = b2 + kstep;
            if (last && has_next) S.a_ready(nxt);
            if constexpr (SP2) {
            PG8_LDB(B0, 0, 0); PG8_LDB(B1, 0, 1); PG8_SCHED; PG8_LDA(At, 0, 0); PG8_STAGE(PG8_SA(1, 1), a1 + hstep, voffA);
            PG8_WAIT_V(8); PG8_WAIT_L(0); PG8_BAR; PG8_MMA(0, 0, At, B0); PG8_MMA(0, 1, At, B1); PG8_BAR; PG8_SCHED;
            PG8_LDA(At, 0, 1); PG8_STAGE(PG8_SB(0, 0), b2, voffB); PG8_STAGE(PG8_SB(0, 1), b2 + hstep, voffB); PG8_STAGE(PG8_SA(0, 0), a2, voffA);
            PG8_WAIT_V(8); PG8_WAIT_L(0); PG8_BAR; PG8_MMA(1, 0, At, B0); PG8_MMA(1, 1, At, B1); PG8_BAR; PG8_SCHED;
            PG8_LDB(B0, 1, 0); PG8_LDB(B1, 1, 1); PG8_SCHED; PG8_LDA(At, 1, 0); PG8_STAGE(PG8_SA(0, 1), a2 + hstep, voffA);
            PG8_WAIT_V(8); PG8_WAIT_L(0); PG8_BAR; PG8_MMA(0, 0, At, B0); PG8_MMA(0, 1, At, B1); PG8_BAR; PG8_SCHED;
            PG8_LDA(At, 1, 1); PG8_STAGE(PG8_SB(1, 0), b3, voffB); PG8_STAGE(PG8_SB(1, 1), b3 + hstep, voffB); PG8_STAGE(PG8_SA(1, 0), a3, voffA);
            PG8_WAIT_V(8); PG8_WAIT_L(0); PG8_BAR; PG8_MMA(1, 0, At, B0); PG8_MMA(1, 1, At, B1); PG8_BAR; PG8_SCHED;
            } else {
            PG8_LDB(B0, 0, 0); PG8_SCHED; PG8_LDA(At, 0, 0); PG8_STAGE(PG8_SA(1, 1), a1 + hstep, voffA);
            PG8_WAIT_L(8); PG8_BAR; PG8_WAIT_L(0); PG8_MMA(0, 0, At, B0); PG8_BAR; PG8_SCHED;
            PG8_LDB(B1, 0, 1); PG8_STAGE(PG8_SB(0, 0), b2, voffB);
            PG8_BAR; PG8_WAIT_L(0); PG8_MMA(0, 1, At, B1); PG8_BAR;
            PG8_LDA(At, 0, 1); PG8_STAGE(PG8_SA(0, 0), a2, voffA);
            PG8_BAR; PG8_WAIT_L(0); PG8_MMA(1, 0, At, B0); PG8_BAR; PG8_SCHED;
            PG8_STAGE(PG8_SB(0, 1), b2 + hstep, voffB);
            PG8_WAIT_V(6); PG8_BAR; PG8_MMA(1, 1, At, B1); PG8_BAR;
            PG8_LDB(B0, 1, 0); PG8_SCHED; PG8_LDA(At, 1, 0); PG8_STAGE(PG8_SA(0, 1), a2 + hstep, voffA);
            PG8_WAIT_L(8); PG8_BAR; PG8_WAIT_L(0); PG8_MMA(0, 0, At, B0); PG8_BAR; PG8_SCHED;
            PG8_LDB(B1, 1, 1); PG8_STAGE(PG8_SB(1, 0), b3, voffB);
            PG8_BAR; PG8_WAIT_L(0); PG8_MMA(0, 1, At, B1); PG8_BAR;
            PG8_LDA(At, 1, 1); PG8_STAGE(PG8_SA(1, 0), a3, voffA);
            PG8_BAR; PG8_WAIT_L(0); PG8_MMA(1, 0, At, B0); PG8_BAR; PG8_SCHED;
            PG8_STAGE(PG8_SB(1, 1), b3 + hstep, voffB);
            PG8_WAIT_V(6); PG8_BAR; PG8_MMA(1, 1, At, B1); PG8_BAR;
            }
        }
        if constexpr (ALIGN_EPI) { if (wr == 0) PG8_BAR; }
        if constexpr (!Epi::AFTER_DRAIN) { E(acc, cur, wr, wc, fr, fq); S.done(cur); }
        if (!has_next) break;
#pragma unroll
        for (int a = 0; a < 2; ++a)
#pragma unroll
            for (int b = 0; b < 2; ++b)
#pragma unroll
                for (int m = 0; m < 4; ++m)
#pragma unroll
                    for (int n = 0; n < 2; ++n) acc[a][b][m][n] = (f32x4){0.f, 0.f, 0.f, 0.f};
        cur = nxt; cA = nA; cB = nB; ++ui;
        if constexpr (ALIGN_EPI) { if (wr == 1) PG8_BAR; }
    }
    PG8_WAIT_V(0);
    if constexpr (!ALIGN_EPI) { if (wr == 0) PG8_BAR; }
    PG8_BAR;
    if constexpr (Epi::AFTER_DRAIN) { E.fused(acc, cur, wr, wc, fr, fq, lds, wid, lane); S.done(cur); }
#undef PG8_SA
#undef PG8_SB
#undef PG8_STAGE
#undef PG8_LDA
#undef PG8_LDB
#undef PG8_MMA
#undef PG8_WAIT_V
#undef PG8_WAIT_L
#undef PG8_BAR
#undef PG8_SCHED
}
}
#ifndef MK_COOP
#define MK_COOP 1
#endif
using pg8::bf16_t; using pg8::bf16x8; using pg8::f32x4; using pg8::cvt_pk_bf16;
typedef short bf16x4 __attribute__((ext_vector_type(4)));
typedef unsigned long long u64;
typedef unsigned u32x2 __attribute__((ext_vector_type(2)));

constexpr int NB = 8, SEQ = 2048, NMETA = 16, TT = 2112, TP = 2112, DM = 1024, DFF = 2816;
constexpr int SPOS0 = 48;
constexpr int MR = NB * SEQ;
constexpr int MP = MR + 256;
constexpr int DIN = 11848;
constexpr int O_RQ = 0, O_RK = 1024, O_RV = 2048, O_RG = 4096, O_AQ = 6144, O_AK = 7168, O_AV = 8192, O_IQ = 9216, O_IK = 9728, O_IW = 9792, O_GR = 9800, O_GA = 10824;
constexpr float EPSN = 1e-6f;
constexpr size_t MiB = 1u << 20;
constexpr size_t WS_ZERO = 0;
constexpr size_t OFF_CTR = 0;
constexpr size_t OFF_SSQ1 = 4096;
constexpr size_t OFF_SSQ2 = OFF_SSQ1 + MP * 4;
constexpr size_t OFF_SSQ3 = OFF_SSQ2 + MR * 4;
constexpr size_t OFF_SSQY = OFF_SSQ3 + MR * 4;
constexpr size_t ZERO_BYTES = OFF_SSQY + (size_t)MR * 16;
constexpr size_t OFF_SSQ0 = 512 * 1024;
constexpr size_t OFF_BAR = 768 * 1024;
constexpr size_t OFF_IW = 1 * MiB;
constexpr size_t OFF_MPART = 1 * MiB + 512 * 1024;
constexpr size_t OFF_TAB256 = 2 * MiB;
constexpr size_t OFF_TAB128 = OFF_TAB256 + (size_t)2064 * 128 * 8;
constexpr size_t OFF_TAB64 = OFF_TAB128 + (size_t)2064 * 64 * 8;
constexpr size_t OFF_MASK = 6 * MiB;
constexpr size_t OFF_WINA = 11 * MiB;
constexpr size_t OFF_WINB = 19 * MiB;
constexpr size_t OFF_WINC = OFF_WINB + (size_t)5888 * 1024 * 2;
constexpr size_t OFF_WRO = OFF_WINC + 4 * MiB;
constexpr size_t OFF_WAO = OFF_WRO + 4 * MiB;
constexpr size_t OFF_WMX = OFF_WAO + 2 * MiB;
constexpr size_t OFF_W2 = OFF_WMX + 2 * MiB;
constexpr size_t OFF_WD2 = OFF_W2 + 11 * MiB;
constexpr size_t OFF_H1B = 59 * MiB;
constexpr size_t OFF_DELTA = OFF_H1B + (size_t)MP * 1024 * 2;
constexpr size_t OFF_R = OFF_DELTA + 32 * MiB;
constexpr size_t OFF_W1 = OFF_R;
constexpr size_t OFF_WD1 = OFF_R + 11 * MiB;
constexpr size_t OFF_ACT = OFF_R + 16 * MiB + MiB / 2;
constexpr size_t OFF_RQ = OFF_R;
constexpr size_t OFF_RKS = OFF_R + 32 * MiB;
constexpr size_t OFF_RVT = OFF_R + 65 * MiB;
constexpr size_t OFF_AQ = OFF_R;
constexpr size_t OFF_AKS = OFF_R + 32 * MiB;
constexpr size_t OFF_AVT = OFF_R + 65 * MiB;
constexpr size_t OFF_IQ = OFF_R + 98 * MiB;
constexpr size_t OFF_IK = OFF_R + 114 * MiB;
constexpr size_t OFF_YR = OFF_R + 32 * MiB;
constexpr size_t OFF_YA = OFF_R + 65 * MiB;
constexpr size_t OFF_ACT2 = OFF_R;
static_assert(OFF_ACT + (size_t)MP * DFF * 2 <= 256 * MiB && OFF_RVT + (size_t)8 * 4 * 512 * TP * 2 <= 256 * MiB && OFF_IK + 2 * MiB <= 256 * MiB, "ws map");
static_assert(OFF_WD2 + (size_t)1024 * 2816 * 2 <= OFF_H1B && OFF_MASK + (size_t)MR * 66 * 4 <= OFF_WINA && OFF_TAB64 + (size_t)2064 * 32 * 8 <= OFF_MASK && ZERO_BYTES <= OFF_SSQ0, "ws map 2");
constexpr int LDS_BYTES = 135168 + 1024;
constexpr int LDS_CTL = 135168;

struct Args {
    const float* in[16]; float* out; unsigned char* ws; float l2g[4]; int ph_lo, ph_hi;
};
static_assert(sizeof(Args) == 16 * 8 + 16 + 16 + 8, "Args has no padding");

__device__ __forceinline__ float wave_sum(float v) {
#pragma unroll
    for (int o = 1; o < 64; o <<= 1) v += __shfl_xor(v, o);
    return v;
}
__device__ __forceinline__ bf16_t f2bf(float v) { return (bf16_t)(cvt_pk_bf16(v, 0.f) & 0xffffu); }
__device__ __forceinline__ float bf2f(unsigned short b) { return __uint_as_float((unsigned)b << 16); }
__device__ __forceinline__ uint2 pack4(float a, float b, float c, float d) { uint2 r; r.x = cvt_pk_bf16(a, b); r.y = cvt_pk_bf16(c, d); return r; }
__device__ __forceinline__ f32x4 unpack4(uint2 v) { f32x4 r; r[0] = __uint_as_float(v.x << 16); r[1] = __uint_as_float(v.x & 0xffff0000u); r[2] = __uint_as_float(v.y << 16); r[3] = __uint_as_float(v.y & 0xffff0000u); return r; }
__device__ __forceinline__ int vpos(int pos) { return (pos & ~31) | (((pos >> 2) & 3) << 3) | (((pos >> 4) & 1) << 2) | (pos & 3); }
__device__ __forceinline__ float silu_f(float x) { return x * __builtin_amdgcn_rcpf(1.f + __expf(-x)); }
__device__ __forceinline__ float sigm_f(float x) { return __builtin_amdgcn_rcpf(1.f + __expf(-x)); }
__device__ __forceinline__ float rstd1024(const float* ssq, int row) { return rsqrtf(ssq[row] * (1.f / 1024.f) + EPSN); }
#define EPI_ROW(ai, m) (u.pm * 256 + (ai) * 128 + wr * 64 + (m) * 16 + fr)
#define EPI_RSTD(ssqp) float rs_[2][4]; { _Pragma("unroll") for (int ai = 0; ai < 2; ++ai) _Pragma("unroll") for (int m = 0; m < 4; ++m) rs_[ai][m] = (ssqp)[EPI_ROW(ai, m)]; \
    _Pragma("unroll") for (int ai = 0; ai < 2; ++ai) _Pragma("unroll") for (int m = 0; m < 4; ++m) rs_[ai][m] = rsqrtf(rs_[ai][m] * (1.f / 1024.f) + EPSN); }

struct EpiSwiGLU {
    static constexpr bool PERM = false, AFTER_DRAIN = false;
    bf16_t* act; const float* ssq;
    __device__ __forceinline__ void operator()(const f32x4 (&acc)[2][2][4][2], const pg8::Unit& u, int wr, int wc, int fr, int fq) const {
        EPI_RSTD(ssq)
#pragma unroll
        for (int ai = 0; ai < 2; ++ai)
#pragma unroll
            for (int m = 0; m < 4; ++m) {
                const int row = EPI_ROW(ai, m); const float r = rs_[ai][m];
#pragma unroll
                for (int bj = 0; bj < 2; ++bj) {
                    const int f0 = u.pn * 128 + bj * 64 + wc * 16 + fq * 4;
                    const f32x4 g = acc[ai][bj][m][0] * r, uu = acc[ai][bj][m][1] * r;
                    *(uint2*)(act + (size_t)row * DFF + f0) = pack4(silu_f(g[0]) * uu[0], silu_f(g[1]) * uu[1], silu_f(g[2]) * uu[2], silu_f(g[3]) * uu[3]);
                }
            }
    }
};

struct EpiResid {
    static constexpr bool PERM = false, AFTER_DRAIN = false;
    const float* resf; const bf16_t* resd; const float* meta; float* outf; bf16_t* outb; bf16_t* outd; float* ssq; float alpha;
    __device__ __forceinline__ void operator()(const f32x4 (&acc)[2][2][4][2], const pg8::Unit& u, int wr, int wc, int fr, int fq) const {
#pragma unroll
        for (int ai = 0; ai < 2; ++ai)
#pragma unroll
            for (int mh = 0; mh < 2; ++mh) {
                f32x4 res[2][2][2]; uint2 rd[2][2][2];
#pragma unroll
                for (int m2 = 0; m2 < 2; ++m2) {
                    const int row = EPI_ROW(ai, 2 * mh + m2);
#pragma unroll
                    for (int bj = 0; bj < 2; ++bj)
#pragma unroll
                        for (int n = 0; n < 2; ++n) {
                            const int c0 = u.pn * 256 + bj * 128 + wc * 32 + n * 16 + fq * 4;
                            res[m2][bj][n] = (f32x4){0.f, 0.f, 0.f, 0.f}; rd[m2][bj][n] = make_uint2(0u, 0u);
                            if (row < MR) { res[m2][bj][n] = *(const f32x4*)(resf + (size_t)row * DM + c0); if (resd) rd[m2][bj][n] = *(const uint2*)(resd + (size_t)row * DM + c0); }
                            else if (meta && row < MR + NMETA) res[m2][bj][n] = *(const f32x4*)(meta + (size_t)(row - MR) * DM + c0);
                        }
                }
#pragma unroll
                for (int m2 = 0; m2 < 2; ++m2) {
                    const int m = 2 * mh + m2; const int row = EPI_ROW(ai, m);
                    float part = 0.f;
#pragma unroll
                    for (int bj = 0; bj < 2; ++bj)
#pragma unroll
                        for (int n = 0; n < 2; ++n) {
                            const int c0 = u.pn * 256 + bj * 128 + wc * 32 + n * 16 + fq * 4;
                            const f32x4 a = acc[ai][bj][m][n] * alpha;
                            const f32x4 h = res[m2][bj][n] + unpack4(rd[m2][bj][n]) + a;
                            part += (h[0] * h[0] + h[1] * h[1]) + (h[2] * h[2] + h[3] * h[3]);
                            if (outf && row < MR) *(f32x4*)(outf + (size_t)row * DM + c0) = h;
                            if (outb) *(uint2*)(outb + (size_t)row * DM + c0) = pack4(h[0], h[1], h[2], h[3]);
                            if (outd && row < MR) *(uint2*)(outd + (size_t)row * DM + c0) = pack4(a[0], a[1], a[2], a[3]);
                        }
                    part += __shfl_xor(part, 16); part += __shfl_xor(part, 32);
                    if (fq == 0) atomicAdd(ssq + row, part);
                }
            }
    }
};

__device__ __forceinline__ void rope4(const f32x4 x1, const f32x4 x2, const float4 t0, const float4 t1, uint2& o1, uint2& o2) {
    o1 = pack4(x1[0] * t0.x - x2[0] * t0.y, x1[1] * t0.z - x2[1] * t0.w, x1[2] * t1.x - x2[2] * t1.y, x1[3] * t1.z - x2[3] * t1.w);
    o2 = pack4(x2[0] * t0.x + x1[0] * t0.y, x2[1] * t0.z + x1[1] * t0.w, x2[2] * t1.x + x1[2] * t1.y, x2[3] * t1.z + x1[3] * t1.w);
}

struct EpiRet {
    static constexpr bool PERM = false, AFTER_DRAIN = false;
    const float* ssq1; const float2* tab256; bf16_t* RQ; bf16_t* RKs; bf16_t* RVt;
    __device__ __forceinline__ void operator()(const f32x4 (&acc)[2][2][4][2], const pg8::Unit& u, int wr, int wc, int fr, int fq) const {
        EPI_RSTD(ssq1)
        if (u.pn < 8) {
            const int head = u.pn & 3; const float sc = u.pn < 4 ? 1.f : 0.0625f;
#pragma unroll
            for (int ai = 0; ai < 2; ++ai)
#pragma unroll
                for (int mh = 0; mh < 2; ++mh) {
                    float4 tb[2][2][2];
#pragma unroll
                    for (int m2 = 0; m2 < 2; ++m2) {
                        const int row = EPI_ROW(ai, 2 * mh + m2); const int pos = row < MR ? NMETA + (row & 2047) : (row < MR + NMETA ? row - MR : 0);
#pragma unroll
                        for (int bj = 0; bj < 2; ++bj) { const float4* tp = (const float4*)(tab256 + (size_t)pos * 128 + 16 * (4 * bj + wc) + 4 * fq); tb[m2][bj][0] = tp[0]; tb[m2][bj][1] = tp[1]; }
                    }
#pragma unroll
                    for (int m2 = 0; m2 < 2; ++m2) {
                        const int m = 2 * mh + m2; const int row = EPI_ROW(ai, m);
                        const bool real = row < MR; const int b = row >> 11; const int pos = real ? NMETA + (row & 2047) : row - MR;
                        if (row < MR + NMETA && (u.pn >= 4 || real)) {
                            const float r = rs_[ai][m] * sc;
#pragma unroll
                            for (int bj = 0; bj < 2; ++bj) {
                                const int jj0 = 16 * (4 * bj + wc) + 4 * fq; uint2 o1, o2;
                                rope4(acc[ai][bj][m][0] * r, acc[ai][bj][m][1] * r, tb[m2][bj][0], tb[m2][bj][1], o1, o2);
                                if (u.pn < 4) { bf16_t* d = RQ + (size_t)row * 1024 + head * 256 + jj0; *(uint2*)d = o1; *(uint2*)(d + 128) = o2; }
                                else if (real) { bf16_t* d = RKs + ((size_t)b * TP + SPOS0 + pos) * 1024 + head * 256 + jj0; *(uint2*)d = o1; *(uint2*)(d + 128) = o2; }
                                else { for (int bb = 0; bb < NB; ++bb) { bf16_t* d = RKs + ((size_t)bb * TP + SPOS0 + pos) * 1024 + head * 256 + jj0; *(uint2*)d = o1; *(uint2*)(d + 128) = o2; } }
                            }
                        }
                    }
                }
        } else {
#pragma unroll
            for (int ai = 0; ai < 2; ++ai)
#pragma unroll
                for (int m = 0; m < 4; ++m) {
                    const int row = EPI_ROW(ai, m);
                    if (row < MR + NMETA) {
                        const bool real = row < MR; const int b = row >> 11; const int pos = real ? NMETA + (row & 2047) : row - MR; const float r = rs_[ai][m];
#pragma unroll
                        for (int bj = 0; bj < 2; ++bj)
#pragma unroll
                            for (int n = 0; n < 2; ++n) {
                                const int cin = (u.pn - 8) * 256 + bj * 128 + wc * 32 + n * 16 + fq * 4; const int head = cin >> 9, dv = cin & 511;
                                const f32x4 v = acc[ai][bj][m][n] * r;
                                const bf16_t v0 = f2bf(v[0]), v1 = f2bf(v[1]), v2 = f2bf(v[2]), v3 = f2bf(v[3]);
                                if (real) { bf16_t* d = RVt + ((size_t)(b * 4 + head) * 512 + dv) * TP + vpos(SPOS0 + pos); d[0] = v0; d[TP] = v1; d[2 * TP] = v2; d[3 * TP] = v3; }
                                else { for (int bb = 0; bb < NB; ++bb) { bf16_t* d = RVt + ((size_t)(bb * 4 + head) * 512 + dv) * TP + vpos(SPOS0 + pos); d[0] = v0; d[TP] = v1; d[2 * TP] = v2; d[3 * TP] = v3; } }
                            }
                    }
                }
        }
    }
};

struct EpiAtt {
    static constexpr bool PERM = false, AFTER_DRAIN = false;
    const float* ssq1; const float2* tab128; const float2* tab64; const float* ssqY;
    bf16_t* AQ; bf16_t* AKs; bf16_t* AVt; bf16_t* IQ; bf16_t* IK; float* IW; bf16_t* Y;
    __device__ __forceinline__ void operator()(const f32x4 (&acc)[2][2][4][2], const pg8::Unit& u, int wr, int wc, int fr, int fq) const {
        EPI_RSTD(ssq1)
        if (u.pn < 8 || u.pn == 12 || u.pn == 13) {
            const bool d128 = u.pn < 8;
#pragma unroll
            for (int ai = 0; ai < 2; ++ai)
#pragma unroll
                for (int mh = 0; mh < 2; ++mh) {
                    float4 tb[2][2];
#pragma unroll
                    for (int m2 = 0; m2 < 2; ++m2) {
                        const int row = EPI_ROW(ai, 2 * mh + m2); const int pos = row < MR ? NMETA + (row & 2047) : (row < MR + NMETA ? row - MR : 0);
                        const float4* tp = d128 ? (const float4*)(tab128 + (size_t)pos * 64 + 16 * wc + 4 * fq) : (const float4*)(tab64 + (size_t)pos * 32 + 16 * (wc & 1) + 4 * fq);
                        tb[m2][0] = tp[0]; tb[m2][1] = tp[1];
                    }
#pragma unroll
                    for (int m2 = 0; m2 < 2; ++m2) {
                        const int m = 2 * mh + m2; const int row = EPI_ROW(ai, m);
                        const bool real = row < MR; const int b = row >> 11; const int pos = real ? NMETA + (row & 2047) : row - MR;
                        if (real || (row < MR + NMETA && u.pn >= 4 && u.pn < 8)) {
                            const float r = rs_[ai][m];
#pragma unroll
                            for (int bj = 0; bj < 2; ++bj) {
                                uint2 o1, o2; rope4(acc[ai][bj][m][0] * r, acc[ai][bj][m][1] * r, tb[m2][0], tb[m2][1], o1, o2);
                                if (d128) {
                                    const int head = 2 * (u.pn & 3) + bj; const int jj0 = 16 * wc + 4 * fq;
                                    if (u.pn < 4) { bf16_t* d = AQ + (size_t)row * 1024 + head * 128 + jj0; *(uint2*)d = o1; *(uint2*)(d + 64) = o2; }
                                    else if (real) { bf16_t* d = AKs + ((size_t)b * TP + SPOS0 + pos) * 1024 + head * 128 + jj0; *(uint2*)d = o1; *(uint2*)(d + 64) = o2; }
                                    else { for (int bb = 0; bb < NB; ++bb) { bf16_t* d = AKs + ((size_t)bb * TP + SPOS0 + pos) * 1024 + head * 128 + jj0; *(uint2*)d = o1; *(uint2*)(d + 64) = o2; } }
                                } else {
                                    const int head = (u.pn - 12) * 4 + 2 * bj + (wc >> 1); const int jj0 = 16 * (wc & 1) + 4 * fq;
                                    bf16_t* d = IQ + (size_t)row * 512 + head * 64 + jj0; *(uint2*)d = o1; *(uint2*)(d + 32) = o2;
                                }
                            }
                        }
                    }
                }
        } else if (u.pn < 12) {
#pragma unroll
            for (int ai = 0; ai < 2; ++ai)
#pragma unroll
                for (int m = 0; m < 4; ++m) {
                    const int row = EPI_ROW(ai, m);
                    if (row < MR + NMETA) {
                        const bool real = row < MR; const int b = row >> 11; const int pos = real ? NMETA + (row & 2047) : row - MR; const float r = rs_[ai][m];
#pragma unroll
                        for (int bj = 0; bj < 2; ++bj)
#pragma unroll
                            for (int n = 0; n < 2; ++n) {
                                const int cin = (u.pn - 8) * 256 + bj * 128 + wc * 32 + n * 16 + fq * 4; const int head = cin >> 7, dd = cin & 127;
                                const f32x4 v = acc[ai][bj][m][n] * r;
                                const bf16_t v0 = f2bf(v[0]), v1 = f2bf(v[1]), v2 = f2bf(v[2]), v3 = f2bf(v[3]);
                                if (real) { bf16_t* d = AVt + ((size_t)(b * 8 + head) * 128 + dd) * TP + vpos(SPOS0 + pos); d[0] = v0; d[TP] = v1; d[2 * TP] = v2; d[3 * TP] = v3; }
                                else { for (int bb = 0; bb < NB; ++bb) { bf16_t* d = AVt + ((size_t)(bb * 8 + head) * 128 + dd) * TP + vpos(SPOS0 + pos); d[0] = v0; d[TP] = v1; d[2 * TP] = v2; d[3 * TP] = v3; } }
                            }
                    }
                }
        } else if (u.pn == 14) {
#pragma unroll
            for (int ai = 0; ai < 2; ++ai) {
                float4 tb[4][2];
                if (wc < 2) {
#pragma unroll
                    for (int m = 0; m < 4; ++m) { const int row = EPI_ROW(ai, m); const int pos = row < MR ? NMETA + (row & 2047) : 0;
                        const float4* tp = (const float4*)(tab64 + (size_t)pos * 32 + 16 * wc + 4 * fq); tb[m][0] = tp[0]; tb[m][1] = tp[1]; }
                }
#pragma unroll
                for (int m = 0; m < 4; ++m) {
                    const int row = EPI_ROW(ai, m);
                    if (row < MR) {
                        const float r = rs_[ai][m];
                        if (wc < 2) {
                            uint2 o1, o2; rope4(acc[ai][0][m][0] * r, acc[ai][0][m][1] * r, tb[m][0], tb[m][1], o1, o2);
                            bf16_t* d = IK + (size_t)row * 64 + 16 * wc + 4 * fq; *(uint2*)d = o1; *(uint2*)(d + 32) = o2;
                        } else if (wc == 2 && fq < 2) {
                            *(f32x4*)(IW + (size_t)row * 8 + 4 * fq) = acc[ai][0][m][0] * r;
                        }
                    }
                }
            }
        } else {
            const int head = (u.pn - 15) >> 1;
#pragma unroll
            for (int ai = 0; ai < 2; ++ai)
#pragma unroll
                for (int mh = 0; mh < 2; ++mh) {
                    uint2 yv[2][2][2]; float ysq[2];
#pragma unroll
                    for (int m2 = 0; m2 < 2; ++m2) {
                        const int row = EPI_ROW(ai, 2 * mh + m2); const int rr = row < MR ? row : 0;
                        ysq[m2] = ssqY[(size_t)rr * 4 + head];
#pragma unroll
                        for (int bj = 0; bj < 2; ++bj)
#pragma unroll
                            for (int n = 0; n < 2; ++n) yv[m2][bj][n] = *(const uint2*)(Y + (size_t)rr * 2048 + (u.pn - 15) * 256 + bj * 128 + wc * 32 + n * 16 + fq * 4);
                    }
#pragma unroll
                    for (int m2 = 0; m2 < 2; ++m2) {
                        const int m = 2 * mh + m2; const int row = EPI_ROW(ai, m);
                        if (row < MR) {
                            const float r = rs_[ai][m]; const float ys = rsqrtf(ysq[m2] * (1.f / 512.f) + EPSN);
#pragma unroll
                            for (int bj = 0; bj < 2; ++bj)
#pragma unroll
                                for (int n = 0; n < 2; ++n) {
                                    const int cin = (u.pn - 15) * 256 + bj * 128 + wc * 32 + n * 16 + fq * 4;
                                    const f32x4 y = unpack4(yv[m2][bj][n]); const f32x4 g = acc[ai][bj][m][n] * r;
                                    *(uint2*)(Y + (size_t)row * 2048 + cin) = pack4(silu_f(g[0]) * y[0] * ys, silu_f(g[1]) * y[1] * ys, silu_f(g[2]) * y[2] * ys, silu_f(g[3]) * y[3] * ys);
                                }
                        }
                    }
                }
        }
    }
};

struct EpiPlain {
    static constexpr bool PERM = false, AFTER_DRAIN = false;
    bf16_t* out;
    __device__ __forceinline__ void operator()(const f32x4 (&acc)[2][2][4][2], const pg8::Unit& u, int wr, int wc, int fr, int fq) const {
#pragma unroll
        for (int ai = 0; ai < 2; ++ai)
#pragma unroll
            for (int m = 0; m < 4; ++m) {
                const int row = EPI_ROW(ai, m);
#pragma unroll
                for (int bj = 0; bj < 2; ++bj)
#pragma unroll
                    for (int n = 0; n < 2; ++n) {
                        const int c0 = u.pn * 256 + bj * 128 + wc * 32 + n * 16 + fq * 4; const f32x4 a = acc[ai][bj][m][n];
                        *(uint2*)(out + (size_t)row * DM + c0) = pack4(a[0], a[1], a[2], a[3]);
                    }
            }
    }
};

struct EpiGate {
    static constexpr bool PERM = false, AFTER_DRAIN = false;
    const float* ssq1; bf16_t* yr; const bf16_t* ya;
    __device__ __forceinline__ void operator()(const f32x4 (&acc)[2][2][4][2], const pg8::Unit& u, int wr, int wc, int fr, int fq) const {
        EPI_RSTD(ssq1)
#pragma unroll
        for (int ai = 0; ai < 2; ++ai) {
            uint2 av[4][2], cv[4][2];
#pragma unroll
            for (int m = 0; m < 4; ++m)
#pragma unroll
                for (int bj = 0; bj < 2; ++bj) { const size_t o = (size_t)EPI_ROW(ai, m) * DM + u.pn * 128 + bj * 64 + wc * 16 + fq * 4; av[m][bj] = *(const uint2*)(yr + o); cv[m][bj] = *(const uint2*)(ya + o); }
#pragma unroll
            for (int m = 0; m < 4; ++m) {
                const float r = rs_[ai][m];
#pragma unroll
                for (int bj = 0; bj < 2; ++bj) {
                    const size_t o = (size_t)EPI_ROW(ai, m) * DM + u.pn * 128 + bj * 64 + wc * 16 + fq * 4;
                    const f32x4 gr = acc[ai][bj][m][0] * r, ga = acc[ai][bj][m][1] * r; const f32x4 a = unpack4(av[m][bj]), c = unpack4(cv[m][bj]);
                    *(uint2*)(yr + o) = pack4(sigm_f(gr[0]) * a[0] + sigm_f(ga[0]) * c[0], sigm_f(gr[1]) * a[1] + sigm_f(ga[1]) * c[1],
                                              sigm_f(gr[2]) * a[2] + sigm_f(ga[2]) * c[2], sigm_f(gr[3]) * a[3] + sigm_f(ga[3]) * c[3]);
                }
            }
        }
    }
};
template <class Map>
__device__ __forceinline__ void convert_w(int K, int N, bf16_t* Wt, int Nd, const float* gain, Map map, unsigned char* smem) {
    bf16_t* tile = (bf16_t*)smem;
    const int tid = threadIdx.x; const int ntk = K / 256, nt = (Nd / 64) * ntk;
    for (int t = blockIdx.x; t < nt; t += gridDim.x) {
        const int n0 = (t / ntk) * 64, k0 = (t % ntk) * 256;
        const int kr = tid >> 4, nq = tid & 15;
        const float* W = nullptr; const int src = map(n0 + 4 * nq, W);
        float4 v[8];
#pragma unroll
        for (int p = 0; p < 8; ++p) { v[p] = make_float4(0.f, 0.f, 0.f, 0.f); if (src >= 0) v[p] = *(const float4*)(W + (size_t)(k0 + kr + 32 * p) * N + src); }
#pragma unroll
        for (int p = 0; p < 8; ++p) {
            const int kl = kr + 32 * p; const float g = gain ? gain[k0 + kl] : 1.f;
            bf16_t* tl = tile + (kl >> 6) * (64 * 72) + (kl & 63);
            tl[(4 * nq + 0) * 72] = f2bf(v[p].x * g); tl[(4 * nq + 1) * 72] = f2bf(v[p].y * g); tl[(4 * nq + 2) * 72] = f2bf(v[p].z * g); tl[(4 * nq + 3) * 72] = f2bf(v[p].w * g);
        }
        __syncthreads();
        const int nl = tid >> 3, kc = tid & 7;
#pragma unroll
        for (int q = 0; q < 4; ++q) *(uint4*)(Wt + (size_t)(n0 + nl) * K + k0 + 64 * q + 8 * kc) = *(const uint4*)(tile + q * (64 * 72) + nl * 72 + 8 * kc);
        __syncthreads();
    }
}
__device__ __forceinline__ int rope_nat(int c, int dbits) {
    const int g = c >> 5, hi = (c >> 4) & 1, i = c & 15; return (hi << (dbits - 1)) + 16 * g + i;
}

__device__ __forceinline__ void p0_prologue(const Args& A, unsigned char* smem) {
    unsigned char* ws = A.ws;
    const int tid = threadIdx.x, lane = tid & 63, wave = tid >> 6;
    const size_t gtid = (size_t)blockIdx.x * 512 + tid, gsz = (size_t)gridDim.x * 512;
    for (size_t i = gtid; i < ZERO_BYTES / 16; i += gsz) ((uint4*)(ws + WS_ZERO))[i] = make_uint4(0, 0, 0, 0);
    {
        bf16_t* xb = (bf16_t*)A.out; float* ssq0 = (float*)(ws + OFF_SSQ0);
        const int gw = blockIdx.x * 8 + wave, ngw = gridDim.x * 8;
        for (int row = gw; row < MP; row += ngw) {
            const float* src = row < MR ? A.in[0] + (size_t)row * DM : (row < MR + NMETA ? A.in[1] + (size_t)(row - MR) * DM : nullptr);
            float s = 0.f;
#pragma unroll
            for (int j = 0; j < 4; ++j) {
                float4 v = make_float4(0.f, 0.f, 0.f, 0.f);
                if (src) v = ((const float4*)src)[lane + 64 * j];
                s += (v.x * v.x + v.y * v.y) + (v.z * v.z + v.w * v.w);
                *(uint2*)(xb + (size_t)row * DM + 4 * (lane + 64 * j)) = pack4(v.x, v.y, v.z, v.w);
            }
            s = wave_sum(s);
            if (lane == 0) ssq0[row] = s;
        }
    }
    { uint4* hp = (uint4*)(ws + OFF_H1B + (size_t)(MR + NMETA) * DM * 2); for (size_t i = gtid; i < (size_t)(MP - MR - NMETA) * DM * 2 / 16; i += gsz) hp[i] = make_uint4(0, 0, 0, 0); }
    {
        float2* t256 = (float2*)(ws + OFF_TAB256); float2* t128 = (float2*)(ws + OFF_TAB128); float2* t64 = (float2*)(ws + OFF_TAB64);
        for (size_t i = gtid; i < (size_t)2064 * 128; i += gsz) {
            const int pos = (int)(i >> 7), j = (int)(i & 127);
            const float inv = exp2f(-(float)j * (13.287712379549449f / 128.f));
            const float ang = (float)pos * inv;
            const double a = (double)ang; const double k = __builtin_rint(a * 0.15915494309189535);
            const double rr = a - k * 6.283185307179586; const double x = rr * 0.25, x2 = x * x;
            double s = x * (1.0 - x2 * (1.0 / 6.0) * (1.0 - x2 * (1.0 / 20.0) * (1.0 - x2 * (1.0 / 42.0) * (1.0 - x2 * (1.0 / 72.0) * (1.0 - x2 * (1.0 / 110.0) * (1.0 - x2 * (1.0 / 156.0)))))));
            double c = 1.0 - x2 * 0.5 * (1.0 - x2 * (1.0 / 12.0) * (1.0 - x2 * (1.0 / 30.0) * (1.0 - x2 * (1.0 / 56.0) * (1.0 - x2 * (1.0 / 90.0) * (1.0 - x2 * (1.0 / 132.0) * (1.0 - x2 * (1.0 / 182.0)))))));
            const double s2 = 2.0 * s * c, c2 = c * c - s * s; const double s4 = 2.0 * s2 * c2, c4 = c2 * c2 - s2 * s2;
            const float2 o = make_float2((float)c4, (float)s4);
            t256[i] = o;
            if ((j & 1) == 0) t128[(size_t)pos * 64 + (j >> 1)] = o;
            if ((j & 3) == 0) t64[(size_t)pos * 32 + (j >> 2)] = o;
        }
    }
    const float* w_in = A.in[7];
    convert_w(DM, DFF, (bf16_t*)(ws + OFF_W1), 5632, A.in[2], [&](int n, const float*& W) { W = ((n >> 4) & 1) ? A.in[4] : A.in[3]; return 16 * (n >> 5) + (n & 15); }, smem);
    convert_w(DFF, DM, (bf16_t*)(ws + OFF_WD1), 1024, nullptr, [&](int n, const float*& W) { W = A.in[5]; return n; }, smem);
    convert_w(DM, DIN, (bf16_t*)(ws + OFF_WINA), 4096, A.in[6], [&](int n, const float*& W) { W = w_in;
        if (n < 2048) return (n < 1024 ? O_RQ : O_RK) + ((n & 1023) >> 8) * 256 + rope_nat(n & 255, 8);
        return O_RV + (n - 2048); }, smem);
    convert_w(DM, DIN, (bf16_t*)(ws + OFF_WINB), 5888, A.in[6], [&](int n, const float*& W) { W = w_in;
        if (n < 2048) return (n < 1024 ? O_AQ : O_AK) + ((n & 1023) >> 7) * 128 + rope_nat(n & 127, 7);
        if (n < 3072) return O_AV + (n - 2048);
        if (n < 3584) return O_IQ + ((n - 3072) >> 6) * 64 + rope_nat((n - 3072) & 63, 6);
        if (n < 3648) return O_IK + rope_nat(n - 3584, 6);
        if (n < 3656) return O_IW + (n - 3648);
        if (n < 3840) return -1;
        return O_RG + (n - 3840); }, smem);
    convert_w(DM, DIN, (bf16_t*)(ws + OFF_WINC), 2048, A.in[6], [&](int n, const float*& W) { W = w_in; return (((n >> 4) & 1) ? O_GA : O_GR) + 16 * (n >> 5) + (n & 15); }, smem);
    convert_w(2048, DM, (bf16_t*)(ws + OFF_WRO), 1024, nullptr, [&](int n, const float*& W) { W = A.in[8]; return n; }, smem);
    convert_w(DM, DM, (bf16_t*)(ws + OFF_WAO), 1024, nullptr, [&](int n, const float*& W) { W = A.in[9]; return n; }, smem);
    convert_w(DM, DM, (bf16_t*)(ws + OFF_WMX), 1024, nullptr, [&](int n, const float*& W) { W = A.in[10]; return n; }, smem);
    convert_w(DM, DFF, (bf16_t*)(ws + OFF_W2), 5632, A.in[11], [&](int n, const float*& W) { W = ((n >> 4) & 1) ? A.in[13] : A.in[12]; return 16 * (n >> 5) + (n & 15); }, smem);
    convert_w(DFF, DM, (bf16_t*)(ws + OFF_WD2), 1024, nullptr, [&](int n, const float*& W) { W = A.in[14]; return n; }, smem);
}

template <int DQK, int DV, int RB, bool SOFTMAX, int NSTG>
__device__ __forceinline__ void flash_unit(const bf16_t* __restrict__ Q, int ldq, const bf16_t* __restrict__ Kb, int ldk, const bf16_t* __restrict__ Vt,
                                           bf16_t* Out, int ldo, int qpos0, int kt_lo, int kt_hi, const u64* __restrict__ mask64, float p0, float* ssqY, unsigned char* smem) {
    constexpr int KCH = DQK / 8, NKD = KCH / 8, NVD = DV / 64, NKS = DQK / 32, NNB = DV / 16;
    constexpr int KBYTES = 64 * DQK * 2, STAGE = KBYTES + DV * 64 * 2;
    const int tid = threadIdx.x, lane = tid & 63, w = __builtin_amdgcn_readfirstlane(tid >> 6), fr = lane & 15, quad = lane >> 4;
    bf16x8 qf[RB][NKS];
#pragma unroll
    for (int rb = 0; rb < RB; ++rb)
#pragma unroll
        for (int ks = 0; ks < NKS; ++ks) qf[rb][ks] = *(const bf16x8*)(Q + (size_t)(w * 16 * RB + rb * 16 + fr) * ldq + ks * 32 + quad * 8);
    f32x4 o[NNB][RB];
#pragma unroll
    for (int nb = 0; nb < NNB; ++nb)
#pragma unroll
        for (int rb = 0; rb < RB; ++rb) o[nb][rb] = (f32x4){0.f, 0.f, 0.f, 0.f};
    float mrun[RB], lrun[RB];
#pragma unroll
    for (int rb = 0; rb < RB; ++rb) { mrun[rb] = -INFINITY; lrun[rb] = 0.f; }
    PG8_LAS unsigned char* lds = (PG8_LAS unsigned char*)smem;
    int koff[4], voff[4];
    float bk[4][4];
#pragma unroll
    for (int kb = 0; kb < 4; ++kb)
#pragma unroll
        for (int j = 0; j < 4; ++j) bk[kb][j] = SOFTMAX ? 1.f : __builtin_amdgcn_exp2f(-(float)(kb * 16 + quad * 4 + j) * p0);
#pragma unroll
    for (int a = 0; a < 4; ++a) { koff[a] = (fr * KCH + ((a * 4) ^ quad ^ fr)) * 16; voff[a] = (fr * 8 + (((a & 1) * 4) ^ quad ^ ((fr >> 1) & 7))) * 16; }
#define FL_DMA(KT, BUF) do { \
    _Pragma("unroll") for (int i = 0; i < NKD; ++i) { const int gi = (i * 8 + w) * 64 + lane, r = gi / KCH, cc = (gi % KCH) ^ (r & 15); int t = 64 * (KT) + r; t = t < TT ? t : TT - 1; \
        __builtin_amdgcn_global_load_lds((const unsigned*)(Kb + (size_t)t * ldk + cc * 8), (PG8_LAS unsigned*)(lds + (BUF) * STAGE + (i * 8 + w) * 1024), 16, 0, 0); } \
    _Pragma("unroll") for (int i = 0; i < NVD; ++i) { const int gi = (i * 8 + w) * 64 + lane, r = gi >> 3, cc = (gi & 7) ^ ((r >> 1) & 7); int t = 64 * (KT) + 8 * cc; t = t < TP ? t : TP - 8; \
        __builtin_amdgcn_global_load_lds((const unsigned*)(Vt + (size_t)r * TP + t), (PG8_LAS unsigned*)(lds + (BUF) * STAGE + KBYTES + (i * 8 + w) * 1024), 16, 0, 0); } } while (0)
    constexpr int NDMA = NKD + NVD;
    PG8_LAS u64* mlds = (PG8_LAS u64*)(lds + NSTG * STAGE);
    if (SOFTMAX) {
        constexpr int NR = 16 * RB * 8;
        for (int i = tid; i < NR * 33; i += 512) { const int r = i / 33, c = i % 33; mlds[c * NR + r] = mask64[(size_t)r * 33 + c]; }
    }
    FL_DMA(kt_lo, 0);
#pragma unroll
    for (int p = 1; p < NSTG - 1; ++p) if (kt_lo + p <= kt_hi) FL_DMA(kt_lo + p, p);
    int cur = 0;
    for (int kt = kt_lo; kt <= kt_hi; ++kt) {
        if (NSTG == 2 || kt + NSTG - 2 > kt_hi) asm volatile("s_waitcnt vmcnt(0)" ::: "memory");
        else if (NSTG == 3) asm volatile("s_waitcnt vmcnt(%0)" :: "n"(NDMA) : "memory");
        else asm volatile("s_waitcnt vmcnt(%0)" :: "n"(2 * NDMA) : "memory");
        __syncthreads();
        { const int nb_ = cur == 0 ? NSTG - 1 : cur - 1; if (kt + NSTG - 1 <= kt_hi) FL_DMA(kt + NSTG - 1, nb_); }
        const PG8_LAS unsigned char* Ks = lds + cur * STAGE; const PG8_LAS unsigned char* Vs = Ks + KBYTES;
        cur = (cur + 1 == NSTG) ? 0 : cur + 1;
        const PG8_LAS unsigned char* kp[4]; const PG8_LAS unsigned char* vp4[4];
#pragma unroll
        for (int a = 0; a < 4; ++a) { kp[a] = Ks + koff[a]; vp4[a] = Vs + voff[a]; }
        u64 mw[RB];
        if (SOFTMAX) {
#pragma unroll
            for (int rb = 0; rb < RB; ++rb) mw[rb] = mlds[kt * (16 * RB * 8) + w * 16 * RB + rb * 16 + fr];
        }
        f32x4 s[4][RB];
#pragma unroll
        for (int kb = 0; kb < 4; ++kb)
#pragma unroll
            for (int rb = 0; rb < RB; ++rb) s[kb][rb] = (f32x4){0.f, 0.f, 0.f, 0.f};
        {
            constexpr int GPK = NKS / 4, NGS = 4 * GPK;
            bf16x8 fg[3][4];
#define FL_LDK(G) do { _Pragma("unroll") for (int q4 = 0; q4 < 4; ++q4) { const int ks_ = ((G) % GPK) * 4 + q4; \
                fg[(G) % 3][q4] = *(const PG8_LAS bf16x8*)(kp[ks_ & 3] + ((G) / GPK) * 16 * KCH * 16 + (ks_ >> 2) * 256); } } while (0)
            FL_LDK(0); if (NGS > 1) FL_LDK(1);
#pragma unroll
            for (int g = 0; g < NGS; ++g) {
                if (g + 2 < NGS) FL_LDK(g + 2);
                __builtin_amdgcn_sched_barrier(0);
#pragma unroll
                for (int q4 = 0; q4 < 4; ++q4)
#pragma unroll
                    for (int rb = 0; rb < RB; ++rb) s[g / GPK][rb] = __builtin_amdgcn_mfma_f32_16x16x32_bf16(fg[g % 3][q4], qf[rb][(g % GPK) * 4 + q4], s[g / GPK][rb], 0, 0, 0);
                __builtin_amdgcn_sched_barrier(0);
            }
        }
        bf16x8 pa[RB][2];
#pragma unroll
        for (int rb = 0; rb < RB; ++rb) {
            const int qpos = qpos0 + w * 16 * RB + rb * 16 + fr;
            float p[4][4];
            if (SOFTMAX) {
                const u64 mq = mw[rb] >> (quad * 4);
                const unsigned mlo = (unsigned)mq, mhi = (unsigned)(mq >> 32);
                float tmax = -INFINITY;
#pragma unroll
                for (int kb = 0; kb < 4; ++kb)
#pragma unroll
                    for (int j = 0; j < 4; ++j) {
                        const unsigned wsel = (kb < 2) ? mlo : mhi; const unsigned bitm = 1u << ((kb & 1) * 16 + j);
                        const float v = (wsel & bitm) ? s[kb][rb][j] : -INFINITY;
                        p[kb][j] = v; tmax = fmaxf(tmax, v);
                    }
                tmax = fmaxf(tmax, __shfl_xor(tmax, 16)); tmax = fmaxf(tmax, __shfl_xor(tmax, 32));
                const float tm = tmax * p0;
                if (__ballot(tm > mrun[rb] + 8.f) != 0ull) {
                    const float mnew = fmaxf(mrun[rb], tm); const float msafe = (mnew == -INFINITY) ? 0.f : mnew;
                    const float alpha = __builtin_amdgcn_exp2f(mrun[rb] - msafe);
                    lrun[rb] *= alpha; mrun[rb] = mnew;
#pragma unroll
                    for (int nb = 0; nb < NNB; ++nb) o[nb][rb] *= alpha;
                }
                const float mref = (mrun[rb] == -INFINITY) ? 0.f : mrun[rb];
                float ps = 0.f;
#pragma unroll
                for (int kb = 0; kb < 4; ++kb)
#pragma unroll
                    for (int j = 0; j < 4; ++j) { const float e = __builtin_amdgcn_exp2f(fmaf(p[kb][j], p0, -mref)); p[kb][j] = e; ps += e; }
                lrun[rb] += ps;
            } else {
                const float aq = __builtin_amdgcn_exp2f((float)(qpos - 64 * kt) * p0);
                if (64 * kt + 63 > qpos0 + w * 16 * RB) {
#pragma unroll
                    for (int kb = 0; kb < 4; ++kb)
#pragma unroll
                        for (int j = 0; j < 4; ++j) { const int kpos = 64 * kt + kb * 16 + quad * 4 + j; p[kb][j] = (kpos <= qpos) ? s[kb][rb][j] * (aq * bk[kb][j]) : 0.f; }
                } else {
#pragma unroll
                    for (int kb = 0; kb < 4; ++kb)
#pragma unroll
                        for (int j = 0; j < 4; ++j) p[kb][j] = s[kb][rb][j] * (aq * bk[kb][j]);
                }
                if (kt == 0) {
#pragma unroll
                    for (int kb = 0; kb < 3; ++kb)
#pragma unroll
                        for (int j = 0; j < 4; ++j) p[kb][j] = 0.f;
                }
            }
#pragma unroll
            for (int i = 0; i < 2; ++i) {
                union { bf16x8 v; unsigned u[4]; } t;
                t.u[0] = cvt_pk_bf16(p[2 * i][0], p[2 * i][1]); t.u[1] = cvt_pk_bf16(p[2 * i][2], p[2 * i][3]);
                t.u[2] = cvt_pk_bf16(p[2 * i + 1][0], p[2 * i + 1][1]); t.u[3] = cvt_pk_bf16(p[2 * i + 1][2], p[2 * i + 1][3]);
                pa[rb][i] = t.v;
            }
        }
        {
            constexpr int GPI = NNB / 4, NGV = 2 * GPI;
            bf16x8 vg[3][4];
#define FL_LDV(G) do { _Pragma("unroll") for (int q4 = 0; q4 < 4; ++q4) { const int nb_ = ((G) % GPI) * 4 + q4, i_ = (G) / GPI; \
                vg[(G) % 3][q4] = *(const PG8_LAS bf16x8*)(vp4[i_] + nb_ * 2048); } } while (0)
            FL_LDV(0); FL_LDV(1);
#pragma unroll
            for (int g = 0; g < NGV; ++g) {
                if (g + 2 < NGV) FL_LDV(g + 2);
                __builtin_amdgcn_sched_barrier(0);
#pragma unroll
                for (int q4 = 0; q4 < 4; ++q4)
#pragma unroll
                    for (int rb = 0; rb < RB; ++rb) o[(g % GPI) * 4 + q4][rb] = __builtin_amdgcn_mfma_f32_16x16x32_bf16(vg[g % 3][q4], pa[rb][g / GPI], o[(g % GPI) * 4 + q4][rb], 0, 0, 0);
                __builtin_amdgcn_sched_barrier(0);
            }
        }
    }
#pragma unroll
    for (int rb = 0; rb < RB; ++rb) {
        const int qrow = w * 16 * RB + rb * 16 + fr;
        float scale = 1.f;
        if (SOFTMAX) { float l = lrun[rb]; l += __shfl_xor(l, 16); l += __shfl_xor(l, 32); scale = 1.f / l; }
        float part = 0.f;
#pragma unroll
        for (int nb = 0; nb < NNB; ++nb) {
            const f32x4 v = o[nb][rb] * scale;
            part += (v[0] * v[0] + v[1] * v[1]) + (v[2] * v[2] + v[3] * v[3]);
            *(uint2*)(Out + (size_t)qrow * ldo + nb * 16 + quad * 4) = pack4(v[0], v[1], v[2], v[3]);
        }
        if (!SOFTMAX) { part += __shfl_xor(part, 16); part += __shfl_xor(part, 32); if (quad == 0) atomicAdd(ssqY + (size_t)qrow * 4, part); }
    }
}

__device__ __forceinline__ unsigned next_unit(unsigned* ctr, unsigned char* smem) {
    volatile unsigned* sh = (volatile unsigned*)(smem + LDS_CTL);
    __syncthreads();
    if (threadIdx.x == 0) *sh = atomicAdd(ctr, 1u);
    __syncthreads();
    return (unsigned)__builtin_amdgcn_readfirstlane((int)*sh);
}

__device__ __forceinline__ void retention_unit(const Args& A, unsigned char* smem, int b, int h, int qb, int dvh) {
    unsigned char* ws = A.ws;
    const bf16_t* RQ = (const bf16_t*)(ws + OFF_RQ); const bf16_t* RKs = (const bf16_t*)(ws + OFF_RKS); const bf16_t* RVt = (const bf16_t*)(ws + OFF_RVT);
    bf16_t* Y = (bf16_t*)A.out; float* ssqY = (float*)(ws + OFF_SSQY);
    const int s0 = 128 * qb, row0 = b * SEQ + s0, qpos0 = SPOS0 + NMETA + s0;
    const float l2g = A.l2g[h]; const int cut = (int)(40.f / -l2g);
    int kt_lo = (qpos0 - cut) / 64; if (qpos0 < cut) kt_lo = 0;
    flash_unit<256, 256, 1, false, 2>(RQ + (size_t)row0 * 1024 + h * 256, 1024, RKs + (size_t)b * TP * 1024 + h * 256, 1024, RVt + ((size_t)(b * 4 + h) * 512 + dvh * 256) * TP,
                                      Y + (size_t)row0 * 2048 + h * 512 + dvh * 256, 2048, qpos0, kt_lo, (qpos0 + 127) / 64, nullptr, l2g, ssqY + (size_t)row0 * 4 + h, smem);
}
__device__ __forceinline__ void retention_phase(const Args& A, unsigned char* smem) {
    if (gridDim.x == 256) {
        const int b = blockIdx.x & 7, c = blockIdx.x >> 3, dvh = c & 1, j = c >> 1;
        for (int r = 0; r < 4; ++r) { __syncthreads(); retention_unit(A, smem, b, 3 - r, (r & 1) ? 15 - j : j, dvh); }
    } else {
        unsigned* ctr = (unsigned*)(A.ws + OFF_CTR) + 0;
        for (;;) { const unsigned u = next_unit(ctr, smem); if (u >= 1024u) break;
            const int rest = (int)(u & 63); retention_unit(A, smem, rest >> 3, (rest >> 1) & 3, 15 - (int)(u >> 6), rest & 1); }
    }
}
__device__ __forceinline__ void attention_unit(const Args& A, unsigned char* smem, int b, int h, int qb) {
    unsigned char* ws = A.ws;
    bf16_t* AQ = (bf16_t*)(ws + OFF_AQ); const bf16_t* AKs = (const bf16_t*)(ws + OFF_AKS); const bf16_t* AVt = (const bf16_t*)(ws + OFF_AVT);
    const u64* mask64 = (const u64*)(ws + OFF_MASK);
    const int s0 = 256 * qb, row0 = b * SEQ + s0, qpos0 = SPOS0 + NMETA + s0;
    flash_unit<128, 128, 2, true, 2>(AQ + (size_t)row0 * 1024 + h * 128, 1024, AKs + (size_t)b * TP * 1024 + h * 128, 1024, AVt + (size_t)(b * 8 + h) * 128 * TP,
                                     AQ + (size_t)row0 * 1024 + h * 128, 1024, qpos0, 0, (qpos0 + 255) / 64, mask64 + (size_t)row0 * 33, 0.08838834764831845f * 1.4426950408889634f, nullptr, smem);
}
__device__ __forceinline__ void attention_phase(const Args& A, unsigned char* smem) {
    if (gridDim.x == 256) {
        const int b = blockIdx.x & 7, c = blockIdx.x >> 3;
        for (int r = 0; r < 2; ++r) { __syncthreads(); attention_unit(A, smem, b, 4 * r + (c >> 3), (r & 1) ? 7 - (c & 7) : (c & 7)); }
    } else {
        unsigned* ctr = (unsigned*)(A.ws + OFF_CTR) + 2;
        for (;;) { const unsigned u = next_unit(ctr, smem); if (u >= 512u) break;
            const int bh = (int)(u & 63); attention_unit(A, smem, bh >> 3, bh & 7, 7 - (int)(u >> 6)); }
    }
}

template <int NP>
__device__ __forceinline__ int pk_count_ge(const unsigned (&x)[NP], unsigned cand) {
    const unsigned cm1 = (cand - 1u) * 0x00010001u, one = 0x00010001u;
    unsigned c = 0u;
#pragma unroll
    for (int m = 0; m < NP; ++m) {
        unsigned t;
        asm("v_pk_sub_u16 %0, %1, %2 clamp" : "=v"(t) : "v"(x[m]), "v"(cm1));
        asm("v_pk_min_u16 %0, %1, %2" : "=v"(t) : "v"(t), "v"(one));
        asm("v_pk_add_u16 %0, %1, %2" : "=v"(c) : "v"(c), "v"(t));
    }
    int v = (int)((c & 0xFFFFu) + (c >> 16));
    v += __builtin_amdgcn_update_dpp(0, v, 0x111, 0xf, 0xf, true);
    v += __builtin_amdgcn_update_dpp(0, v, 0x112, 0xf, 0xf, true);
    v += __builtin_amdgcn_update_dpp(0, v, 0x114, 0xf, 0xf, true);
    v += __builtin_amdgcn_update_dpp(0, v, 0x118, 0xf, 0xf, true);
    v += __builtin_amdgcn_update_dpp(0, v, 0x142, 0xa, 0xf, false);
    v += __builtin_amdgcn_update_dpp(0, v, 0x143, 0xc, 0xf, false);
    return __builtin_amdgcn_readlane(v, 63);
}

template <int NI>
__device__ __forceinline__ u64 select_query(const unsigned* skq, int lane) {
    unsigned uk[NI];
#pragma unroll
    for (int i = 0; i < NI; ++i) uk[i] = skq[64 * i + lane];
    unsigned hp[NI / 2];
#pragma unroll
    for (int m = 0; m < NI / 2; ++m) hp[m] = (uk[2 * m] >> 16) | (uk[2 * m + 1] & 0xFFFF0000u);
    unsigned T16 = 0u;
    for (int bit = 15; bit >= 0; --bit) {
        const unsigned cand = T16 | (1u << bit);
        if (pk_count_ge<NI / 2>(hp, cand) >= 256) T16 = cand;
    }
    const int cgt_hi = (T16 < 0xFFFFu) ? pk_count_ge<NI / 2>(hp, T16 + 1u) : 0;
    const int need_lo = 256 - cgt_hi;
#pragma unroll
    for (int m = 0; m < NI / 2; ++m) {
        const unsigned a = uk[2 * m], b2 = uk[2 * m + 1];
        const unsigned la = ((a >> 16) == T16) ? (a & 0xFFFFu) : 0u, lb = ((b2 >> 16) == T16) ? (b2 << 16) : 0u;
        hp[m] = la | lb;
    }
    unsigned L16 = 0u;
    for (int bit = 15; bit >= 0; --bit) {
        const unsigned cand = L16 | (1u << bit);
        if (pk_count_ge<NI / 2>(hp, cand) >= need_lo) L16 = cand;
    }
    const unsigned Tq = (T16 << 16) | L16;
    int cgt = 0;
#pragma unroll
    for (int i = 0; i < NI; ++i) cgt += __builtin_popcountll(__ballot(uk[i] > Tq));
    int rem = 256 - cgt;
    u64 myout = (lane == 0) ? (0xFFFFull << 48) : 0ull;
#pragma unroll
    for (int i = 0; i < NI; ++i) {
        const u64 gt = __ballot(uk[i] > Tq); u64 eq = __ballot(uk[i] == Tq);
        const int ce = __builtin_popcountll(eq);
        if (ce > rem) eq = __ballot(((eq >> lane) & 1ull) && (int)__builtin_amdgcn_mbcnt_hi((unsigned)(eq >> 32), __builtin_amdgcn_mbcnt_lo((unsigned)eq, 0u)) < rem);
        rem -= (ce > rem) ? rem : ce;
        const u64 sel = gt | eq;
        if (lane == i + 1) myout = sel;
    }
    return myout;
}

__device__ __forceinline__ void indexer_phase(const Args& A, unsigned char* smem) {
    unsigned char* ws = A.ws; unsigned* ctr = (unsigned*)(ws + OFF_CTR) + 1;
    const bf16_t* IQ = (const bf16_t*)(ws + OFF_IQ); const bf16_t* IK = (const bf16_t*)(ws + OFF_IK); const float* IW = (const float*)(ws + OFF_IW);
    u64* mask64 = (u64*)(ws + OFF_MASK);
    constexpr int SKS = 2052;
    unsigned* sk = (unsigned*)smem;
    const int tid = threadIdx.x, lane = tid & 63, w = __builtin_amdgcn_readfirstlane(tid >> 6), fr = lane & 15, quad = lane >> 4;
    for (;;) {
        const unsigned u = next_unit(ctr, smem); if (u >= 1024u) break;
        const int g = 127 - (int)(u >> 3), b = (int)(u & 7), s0 = 16 * g, row0 = b * SEQ + s0;
        const int nkeys = s0 + 16, ni = (nkeys + 63) >> 6;
        if (g >= 16) {
            { const int nz = 512 * ((ni + 7) >> 3) - nkeys; for (int i = tid; i < 16 * nz; i += 512) { const int r = i / nz, c = nkeys + (i % nz); sk[r * SKS + c] = 0u; } }
            bf16x8 qf[8][2];
#pragma unroll
            for (int h = 0; h < 8; ++h)
#pragma unroll
                for (int ks = 0; ks < 2; ++ks) qf[h][ks] = *(const bf16x8*)(IQ + (size_t)(row0 + fr) * 512 + h * 64 + ks * 32 + quad * 8);
            const float4 w0 = *(const float4*)(IW + (size_t)(row0 + fr) * 8), w1 = *(const float4*)(IW + (size_t)(row0 + fr) * 8 + 4);
            const float wq[8] = {w0.x, w0.y, w0.z, w0.w, w1.x, w1.y, w1.z, w1.w};
            const bf16_t* kbase = IK + (size_t)(b * SEQ + fr) * 64 + quad * 8;
            bf16x8 nk0 = *(const bf16x8*)(kbase + (size_t)(16 * w) * 64), nk1 = *(const bf16x8*)(kbase + (size_t)(16 * w) * 64 + 32);
            for (int kt = w; kt <= g; kt += 8) {
                const bf16x8 kf0 = nk0, kf1 = nk1;
                if (kt + 8 <= g) { nk0 = *(const bf16x8*)(kbase + (size_t)(16 * (kt + 8)) * 64); nk1 = *(const bf16x8*)(kbase + (size_t)(16 * (kt + 8)) * 64 + 32); }
                float sc[4] = {0.f, 0.f, 0.f, 0.f};
#pragma unroll
                for (int h = 0; h < 8; ++h) {
                    f32x4 c = __builtin_amdgcn_mfma_f32_16x16x32_bf16(kf0, qf[h][0], (f32x4){0.f, 0.f, 0.f, 0.f}, 0, 0, 0);
                    c = __builtin_amdgcn_mfma_f32_16x16x32_bf16(kf1, qf[h][1], c, 0, 0, 0);
#pragma unroll
                    for (int j = 0; j < 4; ++j) sc[j] += wq[h] * fmaxf(c[j], 0.f);
                }
                unsigned kk[4];
#pragma unroll
                for (int j = 0; j < 4; ++j) {
                    const int s = 16 * kt + quad * 4 + j;
                    const unsigned bits = __float_as_uint(sc[j] + 0.0f);
                    const unsigned ok = bits ^ ((unsigned)((int)bits >> 31) | 0x80000000u);
                    kk[j] = (s > s0 + fr) ? 0u : ok;
                }
                *(uint4*)(sk + fr * SKS + 16 * kt + quad * 4) = make_uint4(kk[0], kk[1], kk[2], kk[3]);
            }
        }
        __syncthreads();
#ifdef DUPB
#define NQQ 4
#else
#define NQQ 2
#endif
#pragma unroll 1
        for (int qq_ = 0; qq_ < NQQ; ++qq_) {
            const int qq = qq_ & 1; const int q = 2 * w + qq; const int sq = s0 + q;
            u64 myout = 0ull;
            if (g >= 16) {
                const unsigned* skq = sk + q * SKS;
                const int n8 = (ni + 7) >> 3;
                if (n8 == 1) myout = select_query<8>(skq, lane); else if (n8 == 2) myout = select_query<16>(skq, lane);
                else if (n8 == 3) myout = select_query<24>(skq, lane); else myout = select_query<32>(skq, lane);
            } else {
                const int lim = sq - 64 * (lane - 1);
                myout = lane == 0 ? (0xFFFFull << 48) : (lim >= 63 ? ~0ull : (lim < 0 ? 0ull : ((2ull << lim) - 1ull)));
            }
            if (lane < 33) mask64[(size_t)(row0 + q) * 33 + lane] = myout;
        }
    }
}


__device__ __forceinline__ void meta_down_phase(const Args& A, unsigned char* smem) {
    unsigned char* ws = A.ws;
    const bf16_t* act = (const bf16_t*)(ws + OFF_ACT); const bf16_t* Wd = (const bf16_t*)(ws + OFF_WD1);
    float* part = (float*)(ws + OFF_MPART); unsigned* ctr = (unsigned*)(ws + OFF_CTR) + 16;
    bf16_t* h1b = (bf16_t*)(ws + OFF_H1B); float* ssq1 = (float*)(ws + OFF_SSQ1);
    const int tid = threadIdx.x, lane = tid & 63, w = __builtin_amdgcn_readfirstlane(tid >> 6), fr = lane & 15, quad = lane >> 4;
    float* lred = (float*)smem;
    volatile unsigned* sh = (volatile unsigned*)(smem + LDS_CTL + 16);
    for (int task = blockIdx.x; task < 64; task += gridDim.x) {
        const int ct = task & 15, ksp = task >> 4;
        f32x4 acc[4];
#pragma unroll
        for (int h = 0; h < 4; ++h) acc[h] = (f32x4){0.f, 0.f, 0.f, 0.f};
        for (int ks = w; ks < 22; ks += 8) {
            const int kb = ksp * 704 + ks * 32 + quad * 8;
            const bf16x8 af = *(const bf16x8*)(act + (size_t)(MR + fr) * DFF + kb);
            bf16x8 bfv[4];
#pragma unroll
            for (int h = 0; h < 4; ++h) bfv[h] = *(const bf16x8*)(Wd + (size_t)(64 * ct + 16 * h + fr) * DFF + kb);
#pragma unroll
            for (int h = 0; h < 4; ++h) acc[h] = __builtin_amdgcn_mfma_f32_16x16x32_bf16(af, bfv[h], acc[h], 0, 0, 0);
        }
        __syncthreads();
#pragma unroll
        for (int h = 0; h < 4; ++h)
#pragma unroll
            for (int j = 0; j < 4; ++j) lred[(w * 16 + quad * 4 + j) * 64 + 16 * h + fr] = acc[h][j];
        __syncthreads();
#pragma unroll
        for (int q = 0; q < 2; ++q) {
            const int e = tid + 512 * q; float v = 0.f;
#pragma unroll
            for (int ww = 0; ww < 8; ++ww) v += lred[ww * 1024 + e];
            part[((size_t)ksp * 16 + (e >> 6)) * DM + 64 * ct + (e & 63)] = v;
        }
        __threadfence();
        __syncthreads();
        if (tid == 0) { const unsigned old = atomicAdd(ctr + ct, 1u); *sh = (old == 3u) ? 1u : 0u; }
        __syncthreads();
        if (*sh) {
            __threadfence();
#pragma unroll
            for (int q = 0; q < 2; ++q) {
                const int e = tid + 512 * q, m = e >> 6, c = 64 * ct + (e & 63);
                float hv = 0.f;
#pragma unroll
                for (int k4 = 0; k4 < 4; ++k4) hv += __hip_atomic_load(part + ((size_t)k4 * 16 + m) * DM + c, __ATOMIC_RELAXED, __HIP_MEMORY_SCOPE_AGENT);
                const float hval = A.in[1][(size_t)m * DM + c] + 0.5f * hv;
                h1b[(size_t)(MR + m) * DM + c] = f2bf(hval);
                const float s = wave_sum(hval * hval);
                if (lane == 0) atomicAdd(ssq1 + MR + m, s);
            }
        }
    }
    __syncthreads();
}
#define LAS __attribute__((address_space(3)))
#define XB_TMO      128
#define XB_XCNT(j)  (256  + 64 * (j))
#define XB_XSUB(j)  (1280 + 64 * (j))
#define XB_XGEN(j)  (2304 + 64 * (j))
#define XB_TOP      3328
#define XB_TOPGEN   3392
#define XCD_BAR_WORDS 3456
#define XB_SPIN_CAP (1u << 18)

__device__ __forceinline__ unsigned xb_ld(unsigned* p)              { return __hip_atomic_load(p, __ATOMIC_RELAXED, __HIP_MEMORY_SCOPE_AGENT); }
__device__ __forceinline__ unsigned xb_add(unsigned* p, unsigned v) { return __hip_atomic_fetch_add(p, v, __ATOMIC_RELAXED, __HIP_MEMORY_SCOPE_AGENT); }
__device__ __forceinline__ unsigned xb_xcc_id() { return (unsigned)__builtin_amdgcn_s_getreg((3 << 11) | 20) & 0xFu; }
#define XB_SPIN(cond, bar) do { unsigned _sp = 0; while (cond) { __builtin_amdgcn_s_sleep(1); \
    if ((++_sp & 255u) == 0u) { if (xb_ld(&(bar)[XB_TMO])) break; if (_sp > XB_SPIN_CAP) { atomicAdd(&(bar)[XB_TMO], 1u); break; } } } } while (0)

struct XcdBarrier {
    unsigned* bar; unsigned x;
    volatile LAS unsigned* st;
};

__device__ __forceinline__ XcdBarrier xcd_barrier_post(unsigned* bar, volatile LAS unsigned* st) {
    XcdBarrier b; b.bar = bar; b.x = xb_xcc_id(); b.st = st;
    if (threadIdx.x == 0) (void)xb_add(&bar[XB_XCNT(b.x)], 1u);
    return b;
}
__device__ __forceinline__ void xcd_barrier_complete(unsigned* bar, unsigned x, unsigned& nloc, unsigned& nx) {
    const unsigned G = gridDim.x * gridDim.y * gridDim.z;
    unsigned sum, cnt, mine, sp = 0u;
    for (;;) {
        sum = 0u; cnt = 0u; mine = 0u;
#pragma unroll
        for (unsigned j = 0; j < 16; ++j) { const unsigned c = xb_ld(&bar[XB_XCNT(j)]); sum += c; cnt += (c > 0u) ? 1u : 0u; mine = (j == x) ? c : mine; }
        if (sum == G) break;
        __builtin_amdgcn_s_sleep(1);
        if ((++sp & 255u) == 0u) { if (xb_ld(&bar[XB_TMO])) break; if (sp > XB_SPIN_CAP) { atomicAdd(&bar[XB_TMO], 1u); break; } }
    }
    nloc = mine > 0u ? mine : 1u; nx = cnt > 0u ? cnt : 1u;
}

__device__ __forceinline__ void xcd_barrier(const XcdBarrier& b) {
    asm volatile("s_waitcnt vmcnt(0)" ::: "memory");
    __syncthreads();
    if (threadIdx.x == 0) {
        unsigned* bar = b.bar;
        __builtin_amdgcn_s_waitcnt(0);
        unsigned nloc = b.st[0], nx = b.st[1];
        if (nloc == 0u) { xcd_barrier_complete(bar, b.x, nloc, nx); b.st[0] = nloc; b.st[1] = nx; }
        const unsigned old = xb_add(&bar[XB_XSUB(b.x)], 1u);
        const unsigned gen = old / nloc;
        if (old + 1u == (gen + 1u) * nloc) {
            __builtin_amdgcn_fence(__ATOMIC_RELEASE, "agent");
            asm volatile("s_waitcnt vmcnt(0)" ::: "memory");
            const unsigned og = xb_add(&bar[XB_TOP], 1u);
            const unsigned tg = og / nx;
            if (og + 1u == (tg + 1u) * nx) xb_add(&bar[XB_TOPGEN], 1u);
            else XB_SPIN(xb_ld(&bar[XB_TOPGEN]) == tg, bar);
            __builtin_amdgcn_fence(__ATOMIC_ACQUIRE, "agent");
            xb_add(&bar[XB_XGEN(b.x)], 1u);
            asm volatile("s_waitcnt vmcnt(0)" ::: "memory");
        } else {
            XB_SPIN(xb_ld(&bar[XB_XGEN(b.x)]) == gen, bar);
            __builtin_amdgcn_fence(__ATOMIC_ACQUIRE, "agent");
            asm volatile("s_waitcnt vmcnt(0)" ::: "memory");
        }
    }
    __syncthreads();
}
#define GEMM_PHASE(EPI, e, Aptr, Bptr, Mrows, Ncols, Kdim) do { pg8::Gemm g_{(const bf16_t*)(Aptr), (const bf16_t*)(Bptr), (Mrows), (Ncols), (Kdim)}; pg8::StaticOrder S_; S_.init((Mrows), (Ncols), (int)gridDim.x, (int)blockIdx.x); \
    pg8::gemm_phase<EPI, pg8::StaticOrder, true, true>((PG8_LAS unsigned char*)smem, g_, S_, e); } while (0)

__global__ void __launch_bounds__(512, 2) mk_fwd(Args A) {
    extern __shared__ __attribute__((aligned(16))) unsigned char smem[];
    unsigned char* ws = A.ws;
    const int lo = A.ph_lo, hi = A.ph_hi;
    volatile LAS unsigned* xst = (volatile LAS unsigned*)((LAS unsigned char*)smem + LDS_CTL + 64);
    if (threadIdx.x < 2) xst[threadIdx.x] = 0u;
    __syncthreads();
    const XcdBarrier xbar = xcd_barrier_post((unsigned*)(ws + OFF_BAR), xst);
#ifndef PHMASK
#define PHMASK 0xFFFFF
#endif
#define IN(k) (((PHMASK >> (k)) & 1) && lo <= (k) && (k) < hi)
#if MK_COOP
#define SEAM(k) do { if (IN(k) && IN((k) + 1)) { if ((k) == 0) cg::this_grid().sync(); else xcd_barrier(xbar); } } while (0)
#else
#define SEAM(k) do { } while (0)
#endif
#ifdef PROBE_PHASE
    unsigned long long pt0 = 0, pt1 = 0;
#define PSTAMP(k) do { if ((k) == PROBE_PHASE) pt0 = __builtin_amdgcn_s_memrealtime(); if ((k) == PROBE_PHASE + 1) pt1 = __builtin_amdgcn_s_memrealtime(); } while (0)
#else
#define PSTAMP(k) do { } while (0)
#endif
    float* ssq0 = (float*)(ws + OFF_SSQ0); float* ssq1 = (float*)(ws + OFF_SSQ1); float* ssq2 = (float*)(ws + OFF_SSQ2); float* ssq3 = (float*)(ws + OFF_SSQ3); float* ssqY = (float*)(ws + OFF_SSQY);
    bf16_t* h1b = (bf16_t*)(ws + OFF_H1B); bf16_t* delta = (bf16_t*)(ws + OFF_DELTA);
    PSTAMP(0);
    if (IN(0)) { p0_prologue(A, smem); }
    SEAM(0);
    PSTAMP(1);
    if (IN(1)) { EpiSwiGLU e{(bf16_t*)(ws + OFF_ACT), ssq0}; GEMM_PHASE(EpiSwiGLU, e, A.out, ws + OFF_W1, MP, 5632, DM); }
    SEAM(1);
    PSTAMP(2);
    if (IN(2)) { meta_down_phase(A, smem); EpiResid e{A.in[0], nullptr, nullptr, nullptr, h1b, delta, ssq1, 0.5f}; GEMM_PHASE(EpiResid, e, ws + OFF_ACT, ws + OFF_WD1, MR, DM, DFF); }
    SEAM(2);
    PSTAMP(3);
    if (IN(3)) { EpiRet e{ssq1, (const float2*)(ws + OFF_TAB256), (bf16_t*)(ws + OFF_RQ), (bf16_t*)(ws + OFF_RKS), (bf16_t*)(ws + OFF_RVT)}; GEMM_PHASE(EpiRet, e, h1b, ws + OFF_WINA, MP, 4096, DM); }
    SEAM(3);
    PSTAMP(4);
    if (IN(4)) { retention_phase(A, smem); }
    SEAM(4);
    PSTAMP(5);
    if (IN(5)) { EpiAtt e{ssq1, (const float2*)(ws + OFF_TAB128), (const float2*)(ws + OFF_TAB64), ssqY, (bf16_t*)(ws + OFF_AQ), (bf16_t*)(ws + OFF_AKS), (bf16_t*)(ws + OFF_AVT),
                          (bf16_t*)(ws + OFF_IQ), (bf16_t*)(ws + OFF_IK), (float*)(ws + OFF_IW), (bf16_t*)A.out};
                 GEMM_PHASE(EpiAtt, e, h1b, ws + OFF_WINB, MP, 5888, DM); }
    SEAM(5);
    PSTAMP(6);
    if (IN(6)) { indexer_phase(A, smem); }
    SEAM(6);
    PSTAMP(7);
    if (IN(7)) { attention_phase(A, smem); }
    SEAM(7);
    PSTAMP(8);
    if (IN(8)) { { EpiPlain e{(bf16_t*)(ws + OFF_YR)}; GEMM_PHASE(EpiPlain, e, A.out, ws + OFF_WRO, MR, DM, 2048); }
                 { EpiPlain e{(bf16_t*)(ws + OFF_YA)}; GEMM_PHASE(EpiPlain, e, ws + OFF_AQ, ws + OFF_WAO, MR, DM, DM); } }
    SEAM(8);
    PSTAMP(9);
    if (IN(9)) { EpiGate e{ssq1, (bf16_t*)(ws + OFF_YR), (const bf16_t*)(ws + OFF_YA)}; GEMM_PHASE(EpiGate, e, h1b, ws + OFF_WINC, MR, 2048, DM); }
    SEAM(9);
    PSTAMP(10);
    if (IN(10)) { EpiResid e{A.in[0], delta, nullptr, A.out, h1b, nullptr, ssq2, 1.0f}; GEMM_PHASE(EpiResid, e, ws + OFF_YR, ws + OFF_WMX, MR, DM, DM); }
    SEAM(10);
    PSTAMP(11);
    if (IN(11)) { EpiSwiGLU e{(bf16_t*)(ws + OFF_ACT2), ssq2}; GEMM_PHASE(EpiSwiGLU, e, h1b, ws + OFF_W2, MR, 5632, DM); }
    SEAM(11);
    PSTAMP(12);
    if (IN(12)) { EpiResid e{A.out, nullptr, nullptr, A.out, nullptr, nullptr, ssq3, 0.5f}; GEMM_PHASE(EpiResid, e, ws + OFF_ACT2, ws + OFF_WD2, MR, DM, DFF); }
    SEAM(12);
    PSTAMP(13);
    if (IN(13)) {
        const float* gf = A.in[15];
        const int lane = threadIdx.x & 63, wave = threadIdx.x >> 6;
        for (int row = blockIdx.x * 8 + wave; row < MR; row += gridDim.x * 8) {
            const float r = rstd1024(ssq3, row);
            float4* p = (float4*)(A.out + (size_t)row * DM);
#ifdef PROBE_PHASE
            const float pd = 0.08f * sqrtf((float)(pt1 - pt0) * 1e-5f);
#endif
#pragma unroll
            for (int j = 0; j < 4; ++j) { float4 v = p[lane + 64 * j]; const float4 g = ((const float4*)gf)[lane + 64 * j];
                v.x *= r * g.x; v.y *= r * g.y; v.z *= r * g.z; v.w *= r * g.w;
#ifdef PROBE_PHASE
                if (j == 0 && lane == 0) v.x += pd;
#endif
                p[lane + 64 * j] = v; }
        }
    }
}
constexpr int NPHASE = 14;

extern "C" void kernel_launch(void* const* d_in, const int* in_sizes, int n_in, void* d_out, int out_size, void* d_ws, size_t ws_size, hipStream_t stream) {
    static int grid = 0;
    if (grid == 0) {
        if (n_in != 16 || out_size != MR * DM || ws_size < 256 * MiB) { fprintf(stderr, "kernel_launch: unexpected problem (n_in %d out %d ws %zu)\n", n_in, out_size, ws_size); grid = -1; return; }
        int dev = 0, cus = 0, per_cu = 0;
        hipGetDevice(&dev); hipDeviceGetAttribute(&cus, hipDeviceAttributeMultiprocessorCount, dev);
        if (hipFuncSetAttribute((const void*)mk_fwd, hipFuncAttributeMaxDynamicSharedMemorySize, LDS_BYTES) != hipSuccess) { fprintf(stderr, "kernel_launch: hipFuncSetAttribute failed\n"); grid = -1; return; }
        hipOccupancyMaxActiveBlocksPerMultiprocessor(&per_cu, (const void*)mk_fwd, 512, LDS_BYTES);
        (void)hipGetLastError();
        if (per_cu < 1) per_cu = 1;
        grid = cus * 1;
        fprintf(stderr, "kernel_launch: cus %d per_cu %d grid %d\n", cus, per_cu, grid);
    }
    if (grid < 0) return;
    Args a{};
    for (int i = 0; i < 16; ++i) a.in[i] = (const float*)d_in[i];
    a.out = (float*)d_out; a.ws = (unsigned char*)d_ws;
    for (int h = 0; h < 4; ++h) a.l2g[h] = (float)(std::log1p(-std::ldexp(1.0, -5 - h)) / std::log(2.0));
#if MK_COOP
    if (hipMemsetAsync((char*)d_ws + OFF_BAR, 0, 16384, stream) != hipSuccess) { fprintf(stderr, "kernel_launch: memset failed\n"); return; }
    a.ph_lo = 0; a.ph_hi = NPHASE;
    void* args[] = {&a};
    hipError_t e = hipLaunchCooperativeKernel((const void*)mk_fwd, dim3(grid), dim3(512), args, LDS_BYTES, stream);
    if (e != hipSuccess) fprintf(stderr, "cooperative launch failed: %s (grid %d)\n", hipGetErrorString(e), grid);
#else
    for (int p = 0; p < NPHASE; ++p) { a.ph_lo = p; a.ph_hi = p + 1; hipLaunchKernelGGL(mk_fwd, dim3(grid), dim3(512), LDS_BYTES, stream, a); }
#endif
}
```

```cpp
#include <hip/hip_runtime.h>
#include <hip/hip_cooperative_groups.h>
#include <cstdio>
#include <cstdint>
#include <cmath>
namespace cg = cooperative_groups;
namespace pg8 {
#define PG8_LAS __attribute__((address_space(3)))
typedef unsigned short bf16_t;
typedef short bf16x8 __attribute__((ext_vector_type(8)));
typedef float f32x4 __attribute__((ext_vector_type(4)));
typedef unsigned u32x4 __attribute__((ext_vector_type(4)));
constexpr int BM = 256, BK = 64, HALF = 128, HTB = HALF * BK * 2  , STAGE_BYTES = 8 * HTB, NXCD = 8, WGM = 8;

__host__ __device__ __forceinline__ int lds_byte(int r, int c) { const int st = (r >> 4) * 2 + (c >> 5), rr = r & 15, cc = c & 31, ob = rr * 64 + cc * 2; return st * 1024 + (ob ^ (((ob >> 9) & 1) << 5)); }
__host__ __device__ __forceinline__ void stage_rc(int b, int& R, int& C) { const int st = b / 1024, sb = b % 1024, swz = sb ^ (((sb >> 9) & 1) << 5); R = (st >> 1) * 16 + swz / 64; C = (st & 1) * 32 + (swz % 64) / 2; }
__host__ __device__ __forceinline__ int perm32(int rho) { const int n = rho >> 4, i = rho & 15; return 8 * (i >> 2) + 4 * n + (i & 3); }

struct Unit { int pm, pn; };
struct Gemm { const bf16_t* A; const bf16_t* Bt; int M, N, K; };

struct StaticOrder {
    int nM, nN, nwg, G, c;
    __host__ __device__ void init(int M, int N, int G_, int c_) { nM = M / BM; nN = N / BM; nwg = nM * nN; G = G_; c = c_; }
    __host__ __device__ bool next(int i, Unit& u) const {
        const long L = (long)i * G + c; if (L >= nwg) return false;
        int wgid = (int)L; { const int q = nwg / NXCD, r = nwg % NXCD, xcd = wgid % NXCD, off = wgid / NXCD; wgid = (xcd < r ? xcd * (q + 1) : r * (q + 1) + (xcd - r) * q) + off; }
        const int nig = WGM * nN, gid = wgid / nig, fm = gid * WGM, gsz = (nM - fm) < WGM ? (nM - fm) : WGM;
        u.pm = fm + ((wgid % nig) % gsz); u.pn = (wgid % nig) / gsz; return true;
    }
    __device__ __forceinline__ void a_ready(const Unit&) const {}
    __device__ __forceinline__ void done(const Unit&) const {}
};

__device__ __forceinline__ unsigned cvt_pk_bf16(float lo, float hi) { unsigned r; asm volatile("v_cvt_pk_bf16_f32 %0, %1, %2" : "=v"(r) : "v"(lo), "v"(hi)); return r; }

template <class Epi, class Sched, bool ALIGN_EPI = false, bool SP2 = false>
__device__ __forceinline__ void gemm_phase(PG8_LAS unsigned char* lds, const Gemm g, const Sched& S, const Epi& E) {
    const int tid = threadIdx.x, wid = __builtin_amdgcn_readfirstlane(tid >> 6), lane = tid & 63, wr = wid >> 2, wc = wid & 3, fr = lane & 15, fq = lane >> 4;
    const int K = g.K, nt = K / BK;
    unsigned voffA[2], voffB[2];
#pragma unroll
    for (int i = 0; i < 2; ++i) { int R, C; stage_rc(tid * 16 + i * 8192, R, C); const int Rb = Epi::PERM ? ((R & ~31) + perm32(R & 31)) : R;
        voffA[i] = (unsigned)(R * K + C) * 2u; voffB[i] = (unsigned)(Rb * K + C) * 2u; }
    const size_t kstep = (size_t)(BK * 2);
    const size_t hstep = (size_t)HALF * K * 2;
    const size_t tstep = 2 * hstep;
    const unsigned ldsw = (unsigned)wid * 1024u;
    const int aoff = lds_byte(wr * 64 + fr, fq * 8), boff = lds_byte(wc * 32 + fr, fq * 8);
#define PG8_SA(b, h) (((b) * 2 + (h)) * HTB)
#define PG8_SB(b, h) ((4 + (b) * 2 + (h)) * HTB)
#define PG8_STAGE(bufoff, gbase, voff) do { _Pragma("unroll") for (int _i = 0; _i < 2; ++_i) \
        __builtin_amdgcn_global_load_lds((const unsigned*)((const char*)(gbase) + (voff)[_i]), (PG8_LAS unsigned*)(lds + (bufoff) + ldsw + _i * 8192), 16, 0, 0); } while (0)
#define PG8_LDA(dst, b, h) do { _Pragma("unroll") for (int m = 0; m < 4; ++m) _Pragma("unroll") for (int k = 0; k < 2; ++k) dst[m][k] = *(const PG8_LAS bf16x8*)(lds + PG8_SA(b, h) + aoff + m * 2048 + k * 1024); } while (0)
#define PG8_LDB(dst, b, h) do { _Pragma("unroll") for (int n = 0; n < 2; ++n) _Pragma("unroll") for (int k = 0; k < 2; ++k) dst[n][k] = *(const PG8_LAS bf16x8*)(lds + PG8_SB(b, h) + boff + n * 2048 + k * 1024); } while (0)
#define PG8_MMA(ai, bj, At, Bt) do { __builtin_amdgcn_s_setprio(1); _Pragma("unroll") for (int m = 0; m < 4; ++m) _Pragma("unroll") for (int n = 0; n < 2; ++n) _Pragma("unroll") for (int k = 0; k < 2; ++k) \
        acc[ai][bj][m][n] = __builtin_amdgcn_mfma_f32_16x16x32_bf16(Bt[n][k], At[m][k], acc[ai][bj][m][n], 0, 0, 0); __builtin_amdgcn_s_setprio(0); } while (0)
#define PG8_WAIT_V(n) asm volatile("s_waitcnt vmcnt(" #n ")" ::: "memory")
#define PG8_WAIT_L(n) asm volatile("s_waitcnt lgkmcnt(" #n ")" ::: "memory")
#define PG8_BAR __builtin_amdgcn_s_barrier()
#define PG8_SCHED __builtin_amdgcn_sched_barrier(0)
    Unit cur, nxt; int ui = 0;
    if (!S.next(0, cur)) return;
    f32x4 acc[2][2][4][2];
#pragma unroll
    for (int a = 0; a < 2; ++a)
#pragma unroll
        for (int b = 0; b < 2; ++b)
#pragma unroll
            for (int m = 0; m < 4; ++m)
#pragma unroll
                for (int n = 0; n < 2; ++n) acc[a][b][m][n] = (f32x4){0.f, 0.f, 0.f, 0.f};
    bf16x8 At[4][2], B0[2][2], B1[2][2];
    const char* cA = (const char*)g.A + (size_t)cur.pm * tstep; const char* cB = (const char*)g.Bt + (size_t)cur.pn * tstep;
    S.a_ready(cur);
    if constexpr (SP2) {
        PG8_STAGE(PG8_SB(0, 0), cB, voffB); PG8_STAGE(PG8_SB(0, 1), cB + hstep, voffB); PG8_STAGE(PG8_SA(0, 0), cA, voffA); PG8_STAGE(PG8_SA(0, 1), cA + hstep, voffA);
        if (wr == 1) PG8_BAR;
        PG8_WAIT_V(2); PG8_BAR;
        PG8_STAGE(PG8_SB(1, 0), cB + kstep, voffB); PG8_STAGE(PG8_SA(1, 0), cA + kstep, voffA); PG8_STAGE(PG8_SB(1, 1), cB + hstep + kstep, voffB);
        PG8_WAIT_V(6); PG8_BAR;
    } else {
        PG8_STAGE(PG8_SB(0, 0), cB, voffB); PG8_STAGE(PG8_SA(0, 0), cA, voffA); PG8_STAGE(PG8_SB(0, 1), cB + hstep, voffB); PG8_STAGE(PG8_SA(0, 1), cA + hstep, voffA);
        if (wr == 1) PG8_BAR;
        PG8_WAIT_V(4); PG8_BAR;
        PG8_STAGE(PG8_SB(1, 0), cB + kstep, voffB); PG8_STAGE(PG8_SA(1, 0), cA + kstep, voffA); PG8_STAGE(PG8_SB(1, 1), cB + hstep + kstep, voffB);
        PG8_WAIT_V(6); PG8_BAR;
    }
    for (;;) {
        const bool has_next = S.next(ui + 1, nxt);
        const char* nA = has_next ? (const char*)g.A + (size_t)nxt.pm * tstep : cA; const char* nB = has_next ? (const char*)g.Bt + (size_t)nxt.pn * tstep : cB;
        for (int t = 0; t < nt; t += 2) {
            const bool last = (t == nt - 2);
            const char* a1 = cA + (size_t)(t + 1) * kstep;
            const char* a2 = last ? nA : cA + (size_t)(t + 2) * kstep; const char* b2 = last ? nB : cB + (size_t)(t + 2) * kstep;
            const char* a3 = a2 + kstep; const char* b3 = b2 + kstep;
            if (last && has_next) S.a_ready(nxt);
            if constexpr (SP2) {
            PG8_LDB(B0, 0, 0); PG8_LDB(B1, 0, 1); PG8_SCHED; PG8_LDA(At, 0, 0); PG8_STAGE(PG8_SA(1, 1), a1 + hstep, voffA);
            PG8_WAIT_V(8); PG8_WAIT_L(0); PG8_BAR; PG8_MMA(0, 0, At, B0); PG8_MMA(0, 1, At, B1); PG8_BAR; PG8_SCHED;
            PG8_LDA(At, 0, 1); PG8_STAGE(PG8_SB(0, 0), b2, voffB); PG8_STAGE(PG8_SB(0, 1), b2 + hstep, voffB); PG8_STAGE(PG8_SA(0, 0), a2, voffA);
            PG8_WAIT_V(8); PG8_WAIT_L(0); PG8_BAR; PG8_MMA(1, 0, At, B0); PG8_MMA(1, 1, At, B1); PG8_BAR; PG8_SCHED;
            PG8_LDB(B0, 1, 0); PG8_LDB(B1, 1, 1); PG8_SCHED; PG8_LDA(At, 1, 0); PG8_STAGE(PG8_SA(0, 1), a2 + hstep, voffA);
            PG8_WAIT_V(8); PG8_WAIT_L(0); PG8_BAR; PG8_MMA(0, 0, At, B0); PG8_MMA(0, 1, At, B1); PG8_BAR; PG8_SCHED;
            PG8_LDA(At, 1, 1); PG8_STAGE(PG8_SB(1, 0), b3, voffB); PG8_STAGE(PG8_SB(1, 1), b3 + hstep, voffB); PG8_STAGE(PG8_SA(1, 0), a3, voffA);
            PG8_WAIT_V(8); PG8_WAIT_L(0); PG8_BAR; PG8_MMA(1, 0, At, B0); PG8_MMA(1, 1, At, B1); PG8_BAR; PG8_SCHED;
            } else {
            PG8_LDB(B0, 0, 0); PG8_SCHED; PG8_LDA(At, 0, 0); PG8_STAGE(PG8_SA(1, 1), a1 + hstep, voffA);
            PG8_WAIT_L(8); PG8_BAR; PG8_WAIT_L(0); PG8_MMA(0, 0, At, B0); PG8_BAR; PG8_SCHED;
            PG8_LDB(B1, 0, 1); PG8_STAGE(PG8_SB(0, 0), b2, voffB);
            PG8_BAR; PG8_WAIT_L(0); PG8_MMA(0, 1, At, B1); PG8_BAR;
            PG8_LDA(At, 0, 1); PG8_STAGE(PG8_SA(0, 0), a2, voffA);
            PG8_BAR; PG8_WAIT_L(0); PG8_MMA(1, 0, At, B0); PG8_BAR; PG8_SCHED;
            PG8_STAGE(PG8_SB(0, 1), b2 + hstep, voffB);
            PG8_WAIT_V(6); PG8_BAR; PG8_MMA(1, 1, At, B1); PG8_BAR;
            PG8_LDB(B0, 1, 0); PG8_SCHED; PG8_LDA(At, 1, 0); PG8_STAGE(PG8_SA(0, 1), a2 + hstep, voffA);
            PG8_WAIT_L(8); PG8_BAR; PG8_WAIT_L(0); PG8_MMA(0, 0, At, B0); PG8_BAR; PG8_SCHED;
            PG8_LDB(B1, 1, 1); PG8_STAGE(PG8_SB(1, 0), b3, voffB);
            PG8_BAR; PG8_WAIT_L(0); PG8_MMA(0, 1, At, B1); PG8_BAR;
            PG8_LDA(At, 1, 1); PG8_STAGE(PG8_SA(1, 0), a3, voffA);
            PG8_BAR; PG8_WAIT_L(0); PG8_MMA(1, 0, At, B0); PG8_BAR; PG8_SCHED;
            PG8_STAGE(PG8_SB(1, 1), b3 + hstep, voffB);
            PG8_WAIT_V(6); PG8_BAR; PG8_MMA(1, 1, At, B1); PG8_BAR;
            }
        }
        if constexpr (ALIGN_EPI) { if (wr == 0) PG8_BAR; }
        if constexpr (!Epi::AFTER_DRAIN) { E(acc, cur, wr, wc, fr, fq); S.done(cur); }
        if (!has_next) break;
#pragma unroll
        for (int a = 0; a < 2; ++a)
#pragma unroll
            for (int b = 0; b < 2; ++b)
#pragma unroll
                for (int m = 0; m < 4; ++m)
#pragma unroll
                    for (int n = 0; n < 2; ++n) acc[a][b][m][n] = (f32x4){0.f, 0.f, 0.f, 0.f};
        cur = nxt; cA = nA; cB = nB; ++ui;
        if constexpr (ALIGN_EPI) { if (wr == 1) PG8_BAR; }
    }
    PG8_WAIT_V(0);
    if constexpr (!ALIGN_EPI) { if (wr == 0) PG8_BAR; }
    PG8_BAR;
    if constexpr (Epi::AFTER_DRAIN) { E.fused(acc, cur, wr, wc, fr, fq, lds, wid, lane); S.done(cur); }
#undef PG8_SA
#undef PG8_SB
#undef PG8_STAGE
#undef PG8_LDA
#undef PG8_LDB
#undef PG8_MMA
#undef PG8_WAIT_V
#undef PG8_WAIT_L
#undef PG8_BAR
#undef PG8_SCHED
}
}
#ifndef MK_COOP
#define MK_COOP 1
#endif
using pg8::bf16_t; using pg8::bf16x8; using pg8::f32x4; using pg8::cvt_pk_bf16;
typedef short bf16x4 __attribute__((ext_vector_type(4)));
typedef unsigned long long u64;
typedef unsigned u32x2 __attribute__((ext_vector_type(2)));

constexpr int NB = 8, SEQ = 2048, NMETA = 16, TT = 2112, TP = 2112, DM = 1024, DFF = 2816;
constexpr int SPOS0 = 48;
constexpr int MR = NB * SEQ;
constexpr int MP = MR + 256;
constexpr int DIN = 11848;
constexpr int O_RQ = 0, O_RK = 1024, O_RV = 2048, O_RG = 4096, O_AQ = 6144, O_AK = 7168, O_AV = 8192, O_IQ = 9216, O_IK = 9728, O_IW = 9792, O_GR = 9800, O_GA = 10824;
constexpr float EPSN = 1e-6f;
constexpr size_t MiB = 1u << 20;
constexpr size_t WS_ZERO = 0;
constexpr size_t OFF_CTR = 0;
constexpr size_t OFF_SSQ1 = 4096;
constexpr size_t OFF_SSQ2 = OFF_SSQ1 + MP * 4;
constexpr size_t OFF_SSQ3 = OFF_SSQ2 + MR * 4;
constexpr size_t OFF_SSQY = OFF_SSQ3 + MR * 4;
constexpr size_t ZERO_BYTES = OFF_SSQY + (size_t)MR * 16;
constexpr size_t OFF_SSQ0 = 512 * 1024;
constexpr size_t OFF_BAR = 768 * 1024;
constexpr size_t OFF_IW = 1 * MiB;
constexpr size_t OFF_MPART = 1 * MiB + 512 * 1024;
constexpr size_t OFF_TAB256 = 2 * MiB;
constexpr size_t OFF_TAB128 = OFF_TAB256 + (size_t)2064 * 128 * 8;
constexpr size_t OFF_TAB64 = OFF_TAB128 + (size_t)2064 * 64 * 8;
constexpr size_t OFF_MASK = 6 * MiB;
constexpr size_t OFF_WINA = 11 * MiB;
constexpr size_t OFF_WINB = 19 * MiB;
constexpr size_t OFF_WINC = OFF_WINB + (size_t)5888 * 1024 * 2;
constexpr size_t OFF_WRO = OFF_WINC + 4 * MiB;
constexpr size_t OFF_WAO = OFF_WRO + 4 * MiB;
constexpr size_t OFF_WMX = OFF_WAO + 2 * MiB;
constexpr size_t OFF_W2 = OFF_WMX + 2 * MiB;
constexpr size_t OFF_WD2 = OFF_W2 + 11 * MiB;
constexpr size_t OFF_H1B = 59 * MiB;
constexpr size_t OFF_DELTA = OFF_H1B + (size_t)MP * 1024 * 2;
constexpr size_t OFF_R = OFF_DELTA + 32 * MiB;
constexpr size_t OFF_W1 = OFF_R;
constexpr size_t OFF_WD1 = OFF_R + 11 * MiB;
constexpr size_t OFF_ACT = OFF_R + 16 * MiB + MiB / 2;
constexpr size_t OFF_RQ = OFF_R;
constexpr size_t OFF_RKS = OFF_R + 32 * MiB;
constexpr size_t OFF_RVT = OFF_R + 65 * MiB;
constexpr size_t OFF_AQ = OFF_R;
constexpr size_t OFF_AKS = OFF_R + 32 * MiB;
constexpr size_t OFF_AVT = OFF_R + 65 * MiB;
constexpr size_t OFF_IQ = OFF_R + 98 * MiB;
constexpr size_t OFF_IK = OFF_R + 114 * MiB;
constexpr size_t OFF_YR = OFF_R + 32 * MiB;
constexpr size_t OFF_YA = OFF_R + 65 * MiB;
constexpr size_t OFF_ACT2 = OFF_R;
static_assert(OFF_ACT + (size_t)MP * DFF * 2 <= 256 * MiB && OFF_RVT + (size_t)8 * 4 * 512 * TP * 2 <= 256 * MiB && OFF_IK + 2 * MiB <= 256 * MiB, "ws map");
static_assert(OFF_WD2 + (size_t)1024 * 2816 * 2 <= OFF_H1B && OFF_MASK + (size_t)MR * 66 * 4 <= OFF_WINA && OFF_TAB64 + (size_t)2064 * 32 * 8 <= OFF_MASK && ZERO_BYTES <= OFF_SSQ0, "ws map 2");
constexpr int LDS_BYTES = 135168 + 1024;
constexpr int LDS_CTL = 135168;

struct Args {
    const float* in[16]; float* out; unsigned char* ws; float l2g[4]; int ph_lo, ph_hi;
};
static_assert(sizeof(Args) == 16 * 8 + 16 + 16 + 8, "Args has no padding");

__device__ __forceinline__ float wave_sum(float v) {
#pragma unroll
    for (int o = 1; o < 64; o <<= 1) v += __shfl_xor(v, o);
    return v;
}
__device__ __forceinline__ bf16_t f2bf(float v) { return (bf16_t)(cvt_pk_bf16(v, 0.f) & 0xffffu); }
__device__ __forceinline__ float bf2f(unsigned short b) { return __uint_as_float((unsigned)b << 16); }
__device__ __forceinline__ uint2 pack4(float a, float b, float c, float d) { uint2 r; r.x = cvt_pk_bf16(a, b); r.y = cvt_pk_bf16(c, d); return r; }
__device__ __forceinline__ f32x4 unpack4(uint2 v) { f32x4 r; r[0] = __uint_as_float(v.x << 16); r[1] = __uint_as_float(v.x & 0xffff0000u); r[2] = __uint_as_float(v.y << 16); r[3] = __uint_as_float(v.y & 0xffff0000u); return r; }
__device__ __forceinline__ int vpos(int pos) { return (pos & ~31) | (((pos >> 2) & 3) << 3) | (((pos >> 4) & 1) << 2) | (pos & 3); }
__device__ __forceinline__ float silu_f(float x) { return x * __builtin_amdgcn_rcpf(1.f + __expf(-x)); }
__device__ __forceinline__ float sigm_f(float x) { return __builtin_amdgcn_rcpf(1.f + __expf(-x)); }
__device__ __forceinline__ float rstd1024(const float* ssq, int row) { return rsqrtf(ssq[row] * (1.f / 1024.f) + EPSN); }
#define EPI_ROW(ai, m) (u.pm * 256 + (ai) * 128 + wr * 64 + (m) * 16 + fr)
#define EPI_RSTD(ssqp) float rs_[2][4]; { _Pragma("unroll") for (int ai = 0; ai < 2; ++ai) _Pragma("unroll") for (int m = 0; m < 4; ++m) rs_[ai][m] = (ssqp)[EPI_ROW(ai, m)]; \
    _Pragma("unroll") for (int ai = 0; ai < 2; ++ai) _Pragma("unroll") for (int m = 0; m < 4; ++m) rs_[ai][m] = rsqrtf(rs_[ai][m] * (1.f / 1024.f) + EPSN); }

struct EpiSwiGLU {
    static constexpr bool PERM = false, AFTER_DRAIN = false;
    bf16_t* act; const float* ssq;
    __device__ __forceinline__ void operator()(const f32x4 (&acc)[2][2][4][2], const pg8::Unit& u, int wr, int wc, int fr, int fq) const {
        EPI_RSTD(ssq)
#pragma unroll
        for (int ai = 0; ai < 2; ++ai)
#pragma unroll
            for (int m = 0; m < 4; ++m) {
                const int row = EPI_ROW(ai, m); const float r = rs_[ai][m];
#pragma unroll
                for (int bj = 0; bj < 2; ++bj) {
                    const int f0 = u.pn * 128 + bj * 64 + wc * 16 + fq * 4;
                    const f32x4 g = acc[ai][bj][m][0] * r, uu = acc[ai][bj][m][1] * r;
                    *(uint2*)(act + (size_t)row * DFF + f0) = pack4(silu_f(g[0]) * uu[0], silu_f(g[1]) * uu[1], silu_f(g[2]) * uu[2], silu_f(g[3]) * uu[3]);
                }
            }
    }
};

struct EpiResid {
    static constexpr bool PERM = false, AFTER_DRAIN = false;
    const float* resf; const bf16_t* resd; const float* meta; float* outf; bf16_t* outb; bf16_t* outd; float* ssq; float alpha;
    __device__ __forceinline__ void operator()(const f32x4 (&acc)[2][2][4][2], const pg8::Unit& u, int wr, int wc, int fr, int fq) const {
#pragma unroll
        for (int ai = 0; ai < 2; ++ai)
#pragma unroll
            for (int mh = 0; mh < 2; ++mh) {
                f32x4 res[2][2][2]; uint2 rd[2][2][2];
#pragma unroll
                for (int m2 = 0; m2 < 2; ++m2) {
                    const int row = EPI_ROW(ai, 2 * mh + m2);
#pragma unroll
                    for (int bj = 0; bj < 2; ++bj)
#pragma unroll
                        for (int n = 0; n < 2; ++n) {
                            const int c0 = u.pn * 256 + bj * 128 + wc * 32 + n * 16 + fq * 4;
                            res[m2][bj][n] = (f32x4){0.f, 0.f, 0.f, 0.f}; rd[m2][bj][n] = make_uint2(0u, 0u);
                            if (row < MR) { res[m2][bj][n] = *(const f32x4*)(resf + (size_t)row * DM + c0); if (resd) rd[m2][bj][n] = *(const uint2*)(resd + (size_t)row * DM + c0); }
                            else if (meta && row < MR + NMETA) res[m2][bj][n] = *(const f32x4*)(meta + (size_t)(row - MR) * DM + c0);
                        }
                }
#pragma unroll
                for (int m2 = 0; m2 < 2; ++m2) {
                    const int m = 2 * mh + m2; const int row = EPI_ROW(ai, m);
                    float part = 0.f;
#pragma unroll
                    for (int bj = 0; bj < 2; ++bj)
#pragma unroll
                        for (int n = 0; n < 2; ++n) {
                            const int c0 = u.pn * 256 + bj * 128 + wc * 32 + n * 16 + fq * 4;
                            const f32x4 a = acc[ai][bj][m][n] * alpha;
                            const f32x4 h = res[m2][bj][n] + unpack4(rd[m2][bj][n]) + a;
                            part += (h[0] * h[0] + h[1] * h[1]) + (h[2] * h[2] + h[3] * h[3]);
                            if (outf && row < MR) *(f32x4*)(outf + (size_t)row * DM + c0) = h;
                            if (outb) *(uint2*)(outb + (size_t)row * DM + c0) = pack4(h[0], h[1], h[2], h[3]);
                            if (outd && row < MR) *(uint2*)(outd + (size_t)row * DM + c0) = pack4(a[0], a[1], a[2], a[3]);
                        }
                    part += __shfl_xor(part, 16); part += __shfl_xor(part, 32);
                    if (fq == 0) atomicAdd(ssq + row, part);
                }
            }
    }
};

__device__ __forceinline__ void rope4(const f32x4 x1, const f32x4 x2, const float4 t0, const float4 t1, uint2& o1, uint2& o2) {
    o1 = pack4(x1[0] * t0.x - x2[0] * t0.y, x1[1] * t0.z - x2[1] * t0.w, x1[2] * t1.x - x2[2] * t1.y, x1[3] * t1.z - x2[3] * t1.w);
    o2 = pack4(x2[0] * t0.x + x1[0] * t0.y, x2[1] * t0.z + x1[1] * t0.w, x2[2] * t1.x + x1[2] * t1.y, x2[3] * t1.z + x1[3] * t1.w);
}

struct EpiRet {
    static constexpr bool PERM = false, AFTER_DRAIN = false;
    const float* ssq1; const float2* tab256; bf16_t* RQ; bf16_t* RKs; bf16_t* RVt;
    __device__ __forceinline__ void operator()(const f32x4 (&acc)[2][2][4][2], const pg8::Unit& u, int wr, int wc, int fr, int fq) const {
        EPI_RSTD(ssq1)
        if (u.pn < 8) {
            const int head = u.pn & 3; const float sc = u.pn < 4 ? 1.f : 0.0625f;
#pragma unroll
            for (int ai = 0; ai < 2; ++ai)
#pragma unroll
                for (int mh = 0; mh < 2; ++mh) {
                    float4 tb[2][2][2];
#pragma unroll
                    for (int m2 = 0; m2 < 2; ++m2) {
                        const int row = EPI_ROW(ai, 2 * mh + m2); const int pos = row < MR ? NMETA + (row & 2047) : (row < MR + NMETA ? row - MR : 0);
#pragma unroll
                        for (int bj = 0; bj < 2; ++bj) { const float4* tp = (const float4*)(tab256 + (size_t)pos * 128 + 16 * (4 * bj + wc) + 4 * fq); tb[m2][bj][0] = tp[0]; tb[m2][bj][1] = tp[1]; }
                    }
#pragma unroll
                    for (int m2 = 0; m2 < 2; ++m2) {
                        const int m = 2 * mh + m2; const int row = EPI_ROW(ai, m);
                        const bool real = row < MR; const int b = row >> 11; const int pos = real ? NMETA + (row & 2047) : row - MR;
                        if (row < MR + NMETA && (u.pn >= 4 || real)) {
                            const float r = rs_[ai][m] * sc;
#pragma unroll
                            for (int bj = 0; bj < 2; ++bj) {
                                const int jj0 = 16 * (4 * bj + wc) + 4 * fq; uint2 o1, o2;
                                rope4(acc[ai][bj][m][0] * r, acc[ai][bj][m][1] * r, tb[m2][bj][0], tb[m2][bj][1], o1, o2);
                                if (u.pn < 4) { bf16_t* d = RQ + (size_t)row * 1024 + head * 256 + jj0; *(uint2*)d = o1; *(uint2*)(d + 128) = o2; }
                                else if (real) { bf16_t* d = RKs + ((size_t)b * TP + SPOS0 + pos) * 1024 + head * 256 + jj0; *(uint2*)d = o1; *(uint2*)(d + 128) = o2; }
                                else { for (int bb = 0; bb < NB; ++bb) { bf16_t* d = RKs + ((size_t)bb * TP + SPOS0 + pos) * 1024 + head * 256 + jj0; *(uint2*)d = o1; *(uint2*)(d + 128) = o2; } }
                            }
                        }
                    }
                }
        } else {
#pragma unroll
            for (int ai = 0; ai < 2; ++ai)
#pragma unroll
                for (int m = 0; m < 4; ++m) {
                    const int row = EPI_ROW(ai, m);
                    if (row < MR + NMETA) {
                        const bool real = row < MR; const int b = row >> 11; const int pos = real ? NMETA + (row & 2047) : row - MR; const float r = rs_[ai][m];
#pragma unroll
                        for (int bj = 0; bj < 2; ++bj)
#pragma unroll
                            for (int n = 0; n < 2; ++n) {
                                const int cin = (u.pn - 8) * 256 + bj * 128 + wc * 32 + n * 16 + fq * 4; const int head = cin >> 9, dv = cin & 511;
                                const f32x4 v = acc[ai][bj][m][n] * r;
                                const bf16_t v0 = f2bf(v[0]), v1 = f2bf(v[1]), v2 = f2bf(v[2]), v3 = f2bf(v[3]);
                                if (real) { bf16_t* d = RVt + ((size_t)(b * 4 + head) * 512 + dv) * TP + vpos(SPOS0 + pos); d[0] = v0; d[TP] = v1; d[2 * TP] = v2; d[3 * TP] = v3; }
                                else { for (int bb = 0; bb < NB; ++bb) { bf16_t* d = RVt + ((size_t)(bb * 4 + head) * 512 + dv) * TP + vpos(SPOS0 + pos); d[0] = v0; d[TP] = v1; d[2 * TP] = v2; d[3 * TP] = v3; } }
                            }
                    }
                }
        }
    }
};

struct EpiAtt {
    static constexpr bool PERM = false, AFTER_DRAIN = false;
    const float* ssq1; const float2* tab128; const float2* tab64; const float* ssqY;
    bf16_t* AQ; bf16_t* AKs; bf16_t* AVt; bf16_t* IQ; bf16_t* IK; float* IW; bf16_t* Y;
    __device__ __forceinline__ void operator()(const f32x4 (&acc)[2][2][4][2], const pg8::Unit& u, int wr, int wc, int fr, int fq) const {
        EPI_RSTD(ssq1)
        if (u.pn < 8 || u.pn == 12 || u.pn == 13) {
            const bool d128 = u.pn < 8;
#pragma unroll
            for (int ai = 0; ai < 2; ++ai)
#pragma unroll
                for (int mh = 0; mh < 2; ++mh) {
                    float4 tb[2][2];
#pragma unroll
                    for (int m2 = 0; m2 < 2; ++m2) {
                        const int row = EPI_ROW(ai, 2 * mh + m2); const int pos = row < MR ? NMETA + (row & 2047) : (row < MR + NMETA ? row - MR : 0);
                        const float4* tp = d128 ? (const float4*)(tab128 + (size_t)pos * 64 + 16 * wc + 4 * fq) : (const float4*)(tab64 + (size_t)pos * 32 + 16 * (wc & 1) + 4 * fq);
                        tb[m2][0] = tp[0]; tb[m2][1] = tp[1];
                    }
#pragma unroll
                    for (int m2 = 0; m2 < 2; ++m2) {
                        const int m = 2 * mh + m2; const int row = EPI_ROW(ai, m);
                        const bool real = row < MR; const int b = row >> 11; const int pos = real ? NMETA + (row & 2047) : row - MR;
                        if (real || (row < MR + NMETA && u.pn >= 4 && u.pn < 8)) {
                            const float r = rs_[ai][m];
#pragma unroll
                            for (int bj = 0; bj < 2; ++bj) {
                                uint2 o1, o2; rope4(acc[ai][bj][m][0] * r, acc[ai][bj][m][1] * r, tb[m2][0], tb[m2][1], o1, o2);
                                if (d128) {
                                    const int head = 2 * (u.pn & 3) + bj; const int jj0 = 16 * wc + 4 * fq;
                                    if (u.pn < 4) { bf16_t* d = AQ + (size_t)row * 1024 + head * 128 + jj0; *(uint2*)d = o1; *(uint2*)(d + 64) = o2; }
                                    else if (real) { bf16_t* d = AKs + ((size_t)b * TP + SPOS0 + pos) * 1024 + head * 128 + jj0; *(uint2*)d = o1; *(uint2*)(d + 64) = o2; }
                                    else { for (int bb = 0; bb < NB; ++bb) { bf16_t* d = AKs + ((size_t)bb * TP + SPOS0 + pos) * 1024 + head * 128 + jj0; *(uint2*)d = o1; *(uint2*)(d + 64) = o2; } }
                                } else {
                                    const int head = (u.pn - 12) * 4 + 2 * bj + (wc >> 1); const int jj0 = 16 * (wc & 1) + 4 * fq;
                                    bf16_t* d = IQ + (size_t)row * 512 + head * 64 + jj0; *(uint2*)d = o1; *(uint2*)(d + 32) = o2;
                                }
                            }
                        }
                    }
                }
        } else if (u.pn < 12) {
#pragma unroll
            for (int ai = 0; ai < 2; ++ai)
#pragma unroll
                for (int m = 0; m < 4; ++m) {
                    const int row = EPI_ROW(ai, m);
                    if (row < MR + NMETA) {
                        const bool real = row < MR; const int b = row >> 11; const int pos = real ? NMETA + (row & 2047) : row - MR; const float r = rs_[ai][m];
#pragma unroll
                        for (int bj = 0; bj < 2; ++bj)
#pragma unroll
                            for (int n = 0; n < 2; ++n) {
                                const int cin = (u.pn - 8) * 256 + bj * 128 + wc * 32 + n * 16 + fq * 4; const int head = cin >> 7, dd = cin & 127;
                                const f32x4 v = acc[ai][bj][m][n] * r;
                                const bf16_t v0 = f2bf(v[0]), v1 = f2bf(v[1]), v2 = f2bf(v[2]), v3 = f2bf(v[3]);
                                if (real) { bf16_t* d = AVt + ((size_t)(b * 8 + head) * 128 + dd) * TP + vpos(SPOS0 + pos); d[0] = v0; d[TP] = v1; d[2 * TP] = v2; d[3 * TP] = v3; }
                                else { for (int bb = 0; bb < NB; ++bb) { bf16_t* d = AVt + ((size_t)(bb * 8 + head) * 128 + dd) * TP + vpos(SPOS0 + pos); d[0] = v0; d[TP] = v1; d[2 * TP] = v2; d[3 * TP] = v3; } }
                            }
                    }
                }
        } else if (u.pn == 14) {
#pragma unroll
            for (int ai = 0; ai < 2; ++ai) {
                float4 tb[4][2];
                if (wc < 2) {
#pragma unroll
                    for (int m = 0; m < 4; ++m) { const int row = EPI_ROW(ai, m); const int pos = row < MR ? NMETA + (row & 2047) : 0;
                        const float4* tp = (const float4*)(tab64 + (size_t)pos * 32 + 16 * wc + 4 * fq); tb[m][0] = tp[0]; tb[m][1] = tp[1]; }
                }
#pragma unroll
                for (int m = 0; m < 4; ++m) {
                    const int row = EPI_ROW(ai, m);
                    if (row < MR) {
                        const float r = rs_[ai][m];
                        if (wc < 2) {
                            uint2 o1, o2; rope4(acc[ai][0][m][0] * r, acc[ai][0][m][1] * r, tb[m][0], tb[m][1], o1, o2);
                            bf16_t* d = IK + (size_t)row * 64 + 16 * wc + 4 * fq; *(uint2*)d = o1; *(uint2*)(d + 32) = o2;
                        } else if (wc == 2 && fq < 2) {
                            *(f32x4*)(IW + (size_t)row * 8 + 4 * fq) = acc[ai][0][m][0] * r;
                        }
                    }
                }
            }
        } else {
            const int head = (u.pn - 15) >> 1;
#pragma unroll
            for (int ai = 0; ai < 2; ++ai)
#pragma unroll
                for (int mh = 0; mh < 2; ++mh) {
                    uint2 yv[2][2][2]; float ysq[2];
#pragma unroll
                    for (int m2 = 0; m2 < 2; ++m2) {
                        const int row = EPI_ROW(ai, 2 * mh + m2); const int rr = row < MR ? row : 0;
                        ysq[m2] = ssqY[(size_t)rr * 4 + head];
#pragma unroll
                        for (int bj = 0; bj < 2; ++bj)
#pragma unroll
                            for (int n = 0; n < 2; ++n) yv[m2][bj][n] = *(const uint2*)(Y + (size_t)rr * 2048 + (u.pn - 15) * 256 + bj * 128 + wc * 32 + n * 16 + fq * 4);
                    }
#pragma unroll
                    for (int m2 = 0; m2 < 2; ++m2) {
                        const int m = 2 * mh + m2; const int row = EPI_ROW(ai, m);
                        if (row < MR) {
                            const float r = rs_[ai][m]; const float ys = rsqrtf(ysq[m2] * (1.f / 512.f) + EPSN);
#pragma unroll
                            for (int bj = 0; bj < 2; ++bj)
#pragma unroll
                                for (int n = 0; n < 2; ++n) {
                                    const int cin = (u.pn - 15) * 256 + bj * 128 + wc * 32 + n * 16 + fq * 4;
                                    const f32x4 y = unpack4(yv[m2][bj][n]); const f32x4 g = acc[ai][bj][m][n] * r;
                                    *(uint2*)(Y + (size_t)row * 2048 + cin) = pack4(silu_f(g[0]) * y[0] * ys, silu_f(g[1]) * y[1] * ys, silu_f(g[2]) * y[2] * ys, silu_f(g[3]) * y[3] * ys);
                                }
                        }
                    }
                }
        }
    }
};

struct EpiPlain {
    static constexpr bool PERM = false, AFTER_DRAIN = false;
    bf16_t* out;
    __device__ __forceinline__ void operator()(const f32x4 (&acc)[2][2][4][2], const pg8::Unit& u, int wr, int wc, int fr, int fq) const {
#pragma unroll
        for (int ai = 0; ai < 2; ++ai)
#pragma unroll
            for (int m = 0; m < 4; ++m) {
                const int row = EPI_ROW(ai, m);
#pragma unroll
                for (int bj = 0; bj < 2; ++bj)
#pragma unroll
                    for (int n = 0; n < 2; ++n) {
                        const int c0 = u.pn * 256 + bj * 128 + wc * 32 + n * 16 + fq * 4; const f32x4 a = acc[ai][bj][m][n];
                        *(uint2*)(out + (size_t)row * DM + c0) = pack4(a[0], a[1], a[2], a[3]);
                    }
            }
    }
};

struct EpiGate {
    static constexpr bool PERM = false, AFTER_DRAIN = false;
    const float* ssq1; bf16_t* yr; const bf16_t* ya;
    __device__ __forceinline__ void operator()(const f32x4 (&acc)[2][2][4][2], const pg8::Unit& u, int wr, int wc, int fr, int fq) const {
        EPI_RSTD(ssq1)
#pragma unroll
        for (int ai = 0; ai < 2; ++ai) {
            uint2 av[4][2], cv[4][2];
#pragma unroll
            for (int m = 0; m < 4; ++m)
#pragma unroll
                for (int bj = 0; bj < 2; ++bj) { const size_t o = (size_t)EPI_ROW(ai, m) * DM + u.pn * 128 + bj * 64 + wc * 16 + fq * 4; av[m][bj] = *(const uint2*)(yr + o); cv[m][bj] = *(const uint2*)(ya + o); }
#pragma unroll
            for (int m = 0; m < 4; ++m) {
                const float r = rs_[ai][m];
#pragma unroll
                for (int bj = 0; bj < 2; ++bj) {
                    const size_t o = (size_t)EPI_ROW(ai, m) * DM + u.pn * 128 + bj * 64 + wc * 16 + fq * 4;
                    const f32x4 gr = acc[ai][bj][m][0] * r, ga = acc[ai][bj][m][1] * r; const f32x4 a = unpack4(av[m][bj]), c = unpack4(cv[m][bj]);
                    *(uint2*)(yr + o) = pack4(sigm_f(gr[0]) * a[0] + sigm_f(ga[0]) * c[0], sigm_f(gr[1]) * a[1] + sigm_f(ga[1]) * c[1],
                                              sigm_f(gr[2]) * a[2] + sigm_f(ga[2]) * c[2], sigm_f(gr[3]) * a[3] + sigm_f(ga[3]) * c[3]);
                }
            }
        }
    }
};
template <class Map>
__device__ __forceinline__ void convert_w(int K, int N, bf16_t* Wt, int Nd, const float* gain, Map map, unsigned char* smem) {
    bf16_t* tile = (bf16_t*)smem;
    const int tid = threadIdx.x; const int ntk = K / 256, nt = (Nd / 64) * ntk;
    for (int t = blockIdx.x; t < nt; t += gridDim.x) {
        const int n0 = (t / ntk) * 64, k0 = (t % ntk) * 256;
        const int kr = tid >> 4, nq = tid & 15;
        const float* W = nullptr; const int src = map(n0 + 4 * nq, W);
        float4 v[8];
#pragma unroll
        for (int p = 0; p < 8; ++p) { v[p] = make_float4(0.f, 0.f, 0.f, 0.f); if (src >= 0) v[p] = *(const float4*)(W + (size_t)(k0 + kr + 32 * p) * N + src); }
#pragma unroll
        for (int p = 0; p < 8; ++p) {
            const int kl = kr + 32 * p; const float g = gain ? gain[k0 + kl] : 1.f;
            bf16_t* tl = tile + (kl >> 6) * (64 * 72) + (kl & 63);
            tl[(4 * nq + 0) * 72] = f2bf(v[p].x * g); tl[(4 * nq + 1) * 72] = f2bf(v[p].y * g); tl[(4 * nq + 2) * 72] = f2bf(v[p].z * g); tl[(4 * nq + 3) * 72] = f2bf(v[p].w * g);
        }
        __syncthreads();
        const int nl = tid >> 3, kc = tid & 7;
#pragma unroll
        for (int q = 0; q < 4; ++q) *(uint4*)(Wt + (size_t)(n0 + nl) * K + k0 + 64 * q + 8 * kc) = *(const uint4*)(tile + q * (64 * 72) + nl * 72 + 8 * kc);
        __syncthreads();
    }
}
__device__ __forceinline__ int rope_nat(int c, int dbits) {
    const int g = c >> 5, hi = (c >> 4) & 1, i = c & 15; return (hi << (dbits - 1)) + 16 * g + i;
}

__device__ __forceinline__ void p0_prologue(const Args& A, unsigned char* smem) {
    unsigned char* ws = A.ws;
    const int tid = threadIdx.x, lane = tid & 63, wave = tid >> 6;
    const size_t gtid = (size_t)blockIdx.x * 512 + tid, gsz = (size_t)gridDim.x * 512;
    for (size_t i = gtid; i < ZERO_BYTES / 16; i += gsz) ((uint4*)(ws + WS_ZERO))[i] = make_uint4(0, 0, 0, 0);
    {
        bf16_t* xb = (bf16_t*)A.out; float* ssq0 = (float*)(ws + OFF_SSQ0);
        const int gw = blockIdx.x * 8 + wave, ngw = gridDim.x * 8;
        for (int row = gw; row < MP; row += ngw) {
            const float* src = row < MR ? A.in[0] + (size_t)row * DM : (row < MR + NMETA ? A.in[1] + (size_t)(row - MR) * DM : nullptr);
            float s = 0.f;
#pragma unroll
            for (int j = 0; j < 4; ++j) {
                float4 v = make_float4(0.f, 0.f, 0.f, 0.f);
                if (src) v = ((const float4*)src)[lane + 64 * j];
                s += (v.x * v.x + v.y * v.y) + (v.z * v.z + v.w * v.w);
                *(uint2*)(xb + (size_t)row * DM + 4 * (lane + 64 * j)) = pack4(v.x, v.y, v.z, v.w);
            }
            s = wave_sum(s);
            if (lane == 0) ssq0[row] = s;
        }
    }
    { uint4* hp = (uint4*)(ws + OFF_H1B + (size_t)(MR + NMETA) * DM * 2); for (size_t i = gtid; i < (size_t)(MP - MR - NMETA) * DM * 2 / 16; i += gsz) hp[i] = make_uint4(0, 0, 0, 0); }
    {
        float2* t256 = (float2*)(ws + OFF_TAB256); float2* t128 = (float2*)(ws + OFF_TAB128); float2* t64 = (float2*)(ws + OFF_TAB64);
        for (size_t i = gtid; i < (size_t)2064 * 128; i += gsz) {
            const int pos = (int)(i >> 7), j = (int)(i & 127);
            const float inv = exp2f(-(float)j * (13.287712379549449f / 128.f));
            const float ang = (float)pos * inv;
            const double a = (double)ang; const double k = __builtin_rint(a * 0.15915494309189535);
            const double rr = a - k * 6.283185307179586; const double x = rr * 0.25, x2 = x * x;
            double s = x * (1.0 - x2 * (1.0 / 6.0) * (1.0 - x2 * (1.0 / 20.0) * (1.0 - x2 * (1.0 / 42.0) * (1.0 - x2 * (1.0 / 72.0) * (1.0 - x2 * (1.0 / 110.0) * (1.0 - x2 * (1.0 / 156.0)))))));
            double c = 1.0 - x2 * 0.5 * (1.0 - x2 * (1.0 / 12.0) * (1.0 - x2 * (1.0 / 30.0) * (1.0 - x2 * (1.0 / 56.0) * (1.0 - x2 * (1.0 / 90.0) * (1.0 - x2 * (1.0 / 132.0) * (1.0 - x2 * (1.0 / 182.0)))))));
            const double s2 = 2.0 * s * c, c2 = c * c - s * s; const double s4 = 2.0 * s2 * c2, c4 = c2 * c2 - s2 * s2;
            const float2 o = make_float2((float)c4, (float)s4);
            t256[i] = o;
            if ((j & 1) == 0) t128[(size_t)pos * 64 + (j >> 1)] = o;
            if ((j & 3) == 0) t64[(size_t)pos * 32 + (j >> 2)] = o;
        }
    }
    const float* w_in = A.in[7];
    convert_w(DM, DFF, (bf16_t*)(ws + OFF_W1), 5632, A.in[2], [&](int n, const float*& W) { W = ((n >> 4) & 1) ? A.in[4] : A.in[3]; return 16 * (n >> 5) + (n & 15); }, smem);
    convert_w(DFF, DM, (bf16_t*)(ws + OFF_WD1), 1024, nullptr, [&](int n, const float*& W) { W = A.in[5]; return n; }, smem);
    convert_w(DM, DIN, (bf16_t*)(ws + OFF_WINA), 4096, A.in[6], [&](int n, const float*& W) { W = w_in;
        if (n < 2048) return (n < 1024 ? O_RQ : O_RK) + ((n & 1023) >> 8) * 256 + rope_nat(n & 255, 8);
        return O_RV + (n - 2048); }, smem);
    convert_w(DM, DIN, (bf16_t*)(ws + OFF_WINB), 5888, A.in[6], [&](int n, const float*& W) { W = w_in;
        if (n < 2048) return (n < 1024 ? O_AQ : O_AK) + ((n & 1023) >> 7) * 128 + rope_nat(n & 127, 7);
        if (n < 3072) return O_AV + (n - 2048);
        if (n < 3584) return O_IQ + ((n - 3072) >> 6) * 64 + rope_nat((n - 3072) & 63, 6);
        if (n < 3648) return O_IK + rope_nat(n - 3584, 6);
        if (n < 3656) return O_IW + (n - 3648);
        if (n < 3840) return -1;
        return O_RG + (n - 3840); }, smem);
    convert_w(DM, DIN, (bf16_t*)(ws + OFF_WINC), 2048, A.in[6], [&](int n, const float*& W) { W = w_in; return (((n >> 4) & 1) ? O_GA : O_GR) + 16 * (n >> 5) + (n & 15); }, smem);
    convert_w(2048, DM, (bf16_t*)(ws + OFF_WRO), 1024, nullptr, [&](int n, const float*& W) { W = A.in[8]; return n; }, smem);
    convert_w(DM, DM, (bf16_t*)(ws + OFF_WAO), 1024, nullptr, [&](int n, const float*& W) { W = A.in[9]; return n; }, smem);
    convert_w(DM, DM, (bf16_t*)(ws + OFF_WMX), 1024, nullptr, [&](int n, const float*& W) { W = A.in[10]; return n; }, smem);
    convert_w(DM, DFF, (bf16_t*)(ws + OFF_W2), 5632, A.in[11], [&](int n, const float*& W) { W = ((n >> 4) & 1) ? A.in[13] : A.in[12]; return 16 * (n >> 5) + (n & 15); }, smem);
    convert_w(DFF, DM, (bf16_t*)(ws + OFF_WD2), 1024, nullptr, [&](int n, const float*& W) { W = A.in[14]; return n; }, smem);
}

template <int DQK, int DV, int RB, bool SOFTMAX, int NSTG>
__device__ __forceinline__ void flash_unit(const bf16_t* __restrict__ Q, int ldq, const bf16_t* __restrict__ Kb, int ldk, const bf16_t* __restrict__ Vt,
                                           bf16_t* Out, int ldo, int qpos0, int kt_lo, int kt_hi, const u64* __restrict__ mask64, float p0, float* ssqY, unsigned char* smem) {
    constexpr int KCH = DQK / 8, NKD = KCH / 8, NVD = DV / 64, NKS = DQK / 32, NNB = DV / 16;
    constexpr int KBYTES = 64 * DQK * 2, STAGE = KBYTES + DV * 64 * 2;
    const int tid = threadIdx.x, lane = tid & 63, w = __builtin_amdgcn_readfirstlane(tid >> 6), fr = lane & 15, quad = lane >> 4;
    bf16x8 qf[RB][NKS];
#pragma unroll
    for (int rb = 0; rb < RB; ++rb)
#pragma unroll
        for (int ks = 0; ks < NKS; ++ks) qf[rb][ks] = *(const bf16x8*)(Q + (size_t)(w * 16 * RB + rb * 16 + fr) * ldq + ks * 32 + quad * 8);
    f32x4 o[NNB][RB];
#pragma unroll
    for (int nb = 0; nb < NNB; ++nb)
#pragma unroll
        for (int rb = 0; rb < RB; ++rb) o[nb][rb] = (f32x4){0.f, 0.f, 0.f, 0.f};
    float mrun[RB], lrun[RB];
#pragma unroll
    for (int rb = 0; rb < RB; ++rb) { mrun[rb] = -INFINITY; lrun[rb] = 0.f; }
    PG8_LAS unsigned char* lds = (PG8_LAS unsigned char*)smem;
    int koff[4], voff[4];
    float bk[4][4];
#pragma unroll
    for (int kb = 0; kb < 4; ++kb)
#pragma unroll
        for (int j = 0; j < 4; ++j) bk[kb][j] = SOFTMAX ? 1.f : __builtin_amdgcn_exp2f(-(float)(kb * 16 + quad * 4 + j) * p0);
#pragma unroll
    for (int a = 0; a < 4; ++a) { koff[a] = (fr * KCH + ((a * 4) ^ quad ^ fr)) * 16; voff[a] = (fr * 8 + (((a & 1) * 4) ^ quad ^ ((fr >> 1) & 7))) * 16; }
#define FL_DMA(KT, BUF) do { \
    _Pragma("unroll") for (int i = 0; i < NKD; ++i) { const int gi = (i * 8 + w) * 64 + lane, r = gi / KCH, cc = (gi % KCH) ^ (r & 15); int t = 64 * (KT) + r; t = t < TT ? t : TT - 1; \
        __builtin_amdgcn_global_load_lds((const unsigned*)(Kb + (size_t)t * ldk + cc * 8), (PG8_LAS unsigned*)(lds + (BUF) * STAGE + (i * 8 + w) * 1024), 16, 0, 0); } \
    _Pragma("unroll") for (int i = 0; i < NVD; ++i) { const int gi = (i * 8 + w) * 64 + lane, r = gi >> 3, cc = (gi & 7) ^ ((r >> 1) & 7); int t = 64 * (KT) + 8 * cc; t = t < TP ? t : TP - 8; \
        __builtin_amdgcn_global_load_lds((const unsigned*)(Vt + (size_t)r * TP + t), (PG8_LAS unsigned*)(lds + (BUF) * STAGE + KBYTES + (i * 8 + w) * 1024), 16, 0, 0); } } while (0)
    constexpr int NDMA = NKD + NVD;
    PG8_LAS u64* mlds = (PG8_LAS u64*)(lds + NSTG * STAGE);
    if (SOFTMAX) {
        constexpr int NR = 16 * RB * 8;
        for (int i = tid; i < NR * 33; i += 512) { const int r = i / 33, c = i % 33; mlds[c * NR + r] = mask64[(size_t)r * 33 + c]; }
    }
    FL_DMA(kt_lo, 0);
#pragma unroll
    for (int p = 1; p < NSTG - 1; ++p) if (kt_lo + p <= kt_hi) FL_DMA(kt_lo + p, p);
    int cur = 0;
    for (int kt = kt_lo; kt <= kt_hi; ++kt) {
        if (NSTG == 2 || kt + NSTG - 2 > kt_hi) asm volatile("s_waitcnt vmcnt(0)" ::: "memory");
        else if (NSTG == 3) asm volatile("s_waitcnt vmcnt(%0)" :: "n"(NDMA) : "memory");
        else asm volatile("s_waitcnt vmcnt(%0)" :: "n"(2 * NDMA) : "memory");
        __syncthreads();
        { const int nb_ = cur == 0 ? NSTG - 1 : cur - 1; if (kt + NSTG - 1 <= kt_hi) FL_DMA(kt + NSTG - 1, nb_); }
        const PG8_LAS unsigned char* Ks = lds + cur * STAGE; const PG8_LAS unsigned char* Vs = Ks + KBYTES;
        cur = (cur + 1 == NSTG) ? 0 : cur + 1;
        const PG8_LAS unsigned char* kp[4]; const PG8_LAS unsigned char* vp4[4];
#pragma unroll
        for (int a = 0; a < 4; ++a) { kp[a] = Ks + koff[a]; vp4[a] = Vs + voff[a]; }
        u64 mw[RB];
        if (SOFTMAX) {
#pragma unroll
            for (int rb = 0; rb < RB; ++rb) mw[rb] = mlds[kt * (16 * RB * 8) + w * 16 * RB + rb * 16 + fr];
        }
        f32x4 s[4][RB];
#pragma unroll
        for (int kb = 0; kb < 4; ++kb)
#pragma unroll
            for (int rb = 0; rb < RB; ++rb) s[kb][rb] = (f32x4){0.f, 0.f, 0.f, 0.f};
        {
            constexpr int GPK = NKS / 4, NGS = 4 * GPK;
            bf16x8 fg[3][4];
#define FL_LDK(G) do { _Pragma("unroll") for (int q4 = 0; q4 < 4; ++q4) { const int ks_ = ((G) % GPK) * 4 + q4; \
                fg[(G) % 3][q4] = *(const PG8_LAS bf16x8*)(kp[ks_ & 3] + ((G) / GPK) * 16 * KCH * 16 + (ks_ >> 2) * 256); } } while (0)
            FL_LDK(0); if (NGS > 1) FL_LDK(1);
#pragma unroll
            for (int g = 0; g < NGS; ++g) {
                if (g + 2 < NGS) FL_LDK(g + 2);
                __builtin_amdgcn_sched_barrier(0);
#pragma unroll
                for (int q4 = 0; q4 < 4; ++q4)
#pragma unroll
                    for (int rb = 0; rb < RB; ++rb) s[g / GPK][rb] = __builtin_amdgcn_mfma_f32_16x16x32_bf16(fg[g % 3][q4], qf[rb][(g % GPK) * 4 + q4], s[g / GPK][rb], 0, 0, 0);
                __builtin_amdgcn_sched_barrier(0);
            }
        }
        bf16x8 pa[RB][2];
#pragma unroll
        for (int rb = 0; rb < RB; ++rb) {
            const int qpos = qpos0 + w * 16 * RB + rb * 16 + fr;
            float p[4][4];
            if (SOFTMAX) {
                const u64 mq = mw[rb] >> (quad * 4);
                const unsigned mlo = (unsigned)mq, mhi = (unsigned)(mq >> 32);
                float tmax = -INFINITY;
#pragma unroll
                for (int kb = 0; kb < 4; ++kb)
#pragma unroll
                    for (int j = 0; j < 4; ++j) {
                        const unsigned wsel = (kb < 2) ? mlo : mhi; const unsigned bitm = 1u << ((kb & 1) * 16 + j);
                        const float v = (wsel & bitm) ? s[kb][rb][j] : -INFINITY;
                        p[kb][j] = v; tmax = fmaxf(tmax, v);
                    }
                tmax = fmaxf(tmax, __shfl_xor(tmax, 16)); tmax = fmaxf(tmax, __shfl_xor(tmax, 32));
                const float tm = tmax * p0;
                if (__ballot(tm > mrun[rb] + 8.f) != 0ull) {
                    const float mnew = fmaxf(mrun[rb], tm); const float msafe = (mnew == -INFINITY) ? 0.f : mnew;
                    const float alpha = __builtin_amdgcn_exp2f(mrun[rb] - msafe);
                    lrun[rb] *= alpha; mrun[rb] = mnew;
#pragma unroll
                    for (int nb = 0; nb < NNB; ++nb) o[nb][rb] *= alpha;
                }
                const float mref = (mrun[rb] == -INFINITY) ? 0.f : mrun[rb];
                float ps = 0.f;
#pragma unroll
                for (int kb = 0; kb < 4; ++kb)
#pragma unroll
                    for (int j = 0; j < 4; ++j) { const float e = __builtin_amdgcn_exp2f(fmaf(p[kb][j], p0, -mref)); p[kb][j] = e; ps += e; }
                lrun[rb] += ps;
            } else {
                const float aq = __builtin_amdgcn_exp2f((float)(qpos - 64 * kt) * p0);
                if (64 * kt + 63 > qpos0 + w * 16 * RB) {
#pragma unroll
                    for (int kb = 0; kb < 4; ++kb)
#pragma unroll
                        for (int j = 0; j < 4; ++j) { const int kpos = 64 * kt + kb * 16 + quad * 4 + j; p[kb][j] = (kpos <= qpos) ? s[kb][rb][j] * (aq * bk[kb][j]) : 0.f; }
                } else {
#pragma unroll
                    for (int kb = 0; kb < 4; ++kb)
#pragma unroll
                        for (int j = 0; j < 4; ++j) p[kb][j] = s[kb][rb][j] * (aq * bk[kb][j]);
                }
                if (kt == 0) {
#pragma unroll
                    for (int kb = 0; kb < 3; ++kb)
#pragma unroll
                        for (int j = 0; j < 4; ++j) p[kb][j] = 0.f;
                }
            }
#pragma unroll
            for (int i = 0; i < 2; ++i) {
                union { bf16x8 v; unsigned u[4]; } t;
                t.u[0] = cvt_pk_bf16(p[2 * i][0], p[2 * i][1]); t.u[1] = cvt_pk_bf16(p[2 * i][2], p[2 * i][3]);
                t.u[2] = cvt_pk_bf16(p[2 * i + 1][0], p[2 * i + 1][1]); t.u[3] = cvt_pk_bf16(p[2 * i + 1][2], p[2 * i + 1][3]);
                pa[rb][i] = t.v;
            }
        }
        {
            constexpr int GPI = NNB / 4, NGV = 2 * GPI;
            bf16x8 vg[3][4];
#define FL_LDV(G) do { _Pragma("unroll") for (int q4 = 0; q4 < 4; ++q4) { const int nb_ = ((G) % GPI) * 4 + q4, i_ = (G) / GPI; \
                vg[(G) % 3][q4] = *(const PG8_LAS bf16x8*)(vp4[i_] + nb_ * 2048); } } while (0)
            FL_LDV(0); FL_LDV(1);
#pragma unroll
            for (int g = 0; g < NGV; ++g) {
                if (g + 2 < NGV) FL_LDV(g + 2);
                __builtin_amdgcn_sched_barrier(0);
#pragma unroll
                for (int q4 = 0; q4 < 4; ++q4)
#pragma unroll
                    for (int rb = 0; rb < RB; ++rb) o[(g % GPI) * 4 + q4][rb] = __builtin_amdgcn_mfma_f32_16x16x32_bf16(vg[g % 3][q4], pa[rb][g / GPI], o[(g % GPI) * 4 + q4][rb], 0, 0, 0);
                __builtin_amdgcn_sched_barrier(0);
            }
        }
    }
#pragma unroll
    for (int rb = 0; rb < RB; ++rb) {
        const int qrow = w * 16 * RB + rb * 16 + fr;
        float scale = 1.f;
        if (SOFTMAX) { float l = lrun[rb]; l += __shfl_xor(l, 16); l += __shfl_xor(l, 32); scale = 1.f / l; }
        float part = 0.f;
#pragma unroll
        for (int nb = 0; nb < NNB; ++nb) {
            const f32x4 v = o[nb][rb] * scale;
            part += (v[0] * v[0] + v[1] * v[1]) + (v[2] * v[2] + v[3] * v[3]);
            *(uint2*)(Out + (size_t)qrow * ldo + nb * 16 + quad * 4) = pack4(v[0], v[1], v[2], v[3]);
        }
        if (!SOFTMAX) { part += __shfl_xor(part, 16); part += __shfl_xor(part, 32); if (quad == 0) atomicAdd(ssqY + (size_t)qrow * 4, part); }
    }
}

__device__ __forceinline__ unsigned next_unit(unsigned* ctr, unsigned char* smem) {
    volatile unsigned* sh = (volatile unsigned*)(smem + LDS_CTL);
    __syncthreads();
    if (threadIdx.x == 0) *sh = atomicAdd(ctr, 1u);
    __syncthreads();
    return (unsigned)__builtin_amdgcn_readfirstlane((int)*sh);
}

__device__ __forceinline__ void retention_unit(const Args& A, unsigned char* smem, int b, int h, int qb, int dvh) {
    unsigned char* ws = A.ws;
    const bf16_t* RQ = (const bf16_t*)(ws + OFF_RQ); const bf16_t* RKs = (const bf16_t*)(ws + OFF_RKS); const bf16_t* RVt = (const bf16_t*)(ws + OFF_RVT);
    bf16_t* Y = (bf16_t*)A.out; float* ssqY = (float*)(ws + OFF_SSQY);
    const int s0 = 128 * qb, row0 = b * SEQ + s0, qpos0 = SPOS0 + NMETA + s0;
    const float l2g = A.l2g[h]; const int cut = (int)(40.f / -l2g);
    int kt_lo = (qpos0 - cut) / 64; if (qpos0 < cut) kt_lo = 0;
    flash_unit<256, 256, 1, false, 2>(RQ + (size_t)row0 * 1024 + h * 256, 1024, RKs + (size_t)b * TP * 1024 + h * 256, 1024, RVt + ((size_t)(b * 4 + h) * 512 + dvh * 256) * TP,
                                      Y + (size_t)row0 * 2048 + h * 512 + dvh * 256, 2048, qpos0, kt_lo, (qpos0 + 127) / 64, nullptr, l2g, ssqY + (size_t)row0 * 4 + h, smem);
}
__device__ __forceinline__ void retention_phase(const Args& A, unsigned char* smem) {
    if (gridDim.x == 256) {
        const int b = blockIdx.x & 7, c = blockIdx.x >> 3, dvh = c & 1, j = c >> 1;
        for (int r = 0; r < 4; ++r) { __syncthreads(); retention_unit(A, smem, b, 3 - r, (r & 1) ? 15 - j : j, dvh); }
    } else {
        unsigned* ctr = (unsigned*)(A.ws + OFF_CTR) + 0;
        for (;;) { const unsigned u = next_unit(ctr, smem); if (u >= 1024u) break;
            const int rest = (int)(u & 63); retention_unit(A, smem, rest >> 3, (rest >> 1) & 3, 15 - (int)(u >> 6), rest & 1); }
    }
}
__device__ __forceinline__ void attention_unit(const Args& A, unsigned char* smem, int b, int h, int qb) {
    unsigned char* ws = A.ws;
    bf16_t* AQ = (bf16_t*)(ws + OFF_AQ); const bf16_t* AKs = (const bf16_t*)(ws + OFF_AKS); const bf16_t* AVt = (const bf16_t*)(ws + OFF_AVT);
    const u64* mask64 = (const u64*)(ws + OFF_MASK);
    const int s0 = 256 * qb, row0 = b * SEQ + s0, qpos0 = SPOS0 + NMETA + s0;
    flash_unit<128, 128, 2, true, 2>(AQ + (size_t)row0 * 1024 + h * 128, 1024, AKs + (size_t)b * TP * 1024 + h * 128, 1024, AVt + (size_t)(b * 8 + h) * 128 * TP,
                                     AQ + (size_t)row0 * 1024 + h * 128, 1024, qpos0, 0, (qpos0 + 255) / 64, mask64 + (size_t)row0 * 33, 0.08838834764831845f * 1.4426950408889634f, nullptr, smem);
}
__device__ __forceinline__ void attention_phase(const Args& A, unsigned char* smem) {
    if (gridDim.x == 256) {
        const int b = blockIdx.x & 7, c = blockIdx.x >> 3;
        for (int r = 0; r < 2; ++r) { __syncthreads(); attention_unit(A, smem, b, 4 * r + (c >> 3), (r & 1) ? 7 - (c & 7) : (c & 7)); }
    } else {
        unsigned* ctr = (unsigned*)(A.ws + OFF_CTR) + 2;
        for (;;) { const unsigned u = next_unit(ctr, smem); if (u >= 512u) break;
            const int bh = (int)(u & 63); attention_unit(A, smem, bh >> 3, bh & 7, 7 - (int)(u >> 6)); }
    }
}

template <int NP>
__device__ __forceinline__ int pk_count_ge(const unsigned (&x)[NP], unsigned cand) {
    const unsigned cm1 = (cand - 1u) * 0x00010001u, one = 0x00010001u;
    unsigned c = 0u;
#pragma unroll
    for (int m = 0; m < NP; ++m) {
        unsigned t;
        asm("v_pk_sub_u16 %0, %1, %2 clamp" : "=v"(t) : "v"(x[m]), "v"(cm1));
        asm("v_pk_min_u16 %0, %1, %2" : "=v"(t) : "v"(t), "v"(one));
        asm("v_pk_add_u16 %0, %1, %2" : "=v"(c) : "v"(c), "v"(t));
    }
    int v = (int)((c & 0xFFFFu) + (c >> 16));
    v += __builtin_amdgcn_update_dpp(0, v, 0x111, 0xf, 0xf, true);
    v += __builtin_amdgcn_update_dpp(0, v, 0x112, 0xf, 0xf, true);
    v += __builtin_amdgcn_update_dpp(0, v, 0x114, 0xf, 0xf, true);
    v += __builtin_amdgcn_update_dpp(0, v, 0x118, 0xf, 0xf, true);
    v += __builtin_amdgcn_update_dpp(0, v, 0x142, 0xa, 0xf, false);
    v += __builtin_amdgcn_update_dpp(0, v, 0x143, 0xc, 0xf, false);
    return __builtin_amdgcn_readlane(v, 63);
}

template <int NI>
__device__ __forceinline__ u64 select_query(const unsigned* skq, int lane) {
    unsigned uk[NI];
#pragma unroll
    for (int i = 0; i < NI; ++i) uk[i] = skq[64 * i + lane];
    unsigned hp[NI / 2];
#pragma unroll
    for (int m = 0; m < NI / 2; ++m) hp[m] = (uk[2 * m] >> 16) | (uk[2 * m + 1] & 0xFFFF0000u);
    unsigned T16 = 0u;
    for (int bit = 15; bit >= 0; --bit) {
        const unsigned cand = T16 | (1u << bit);
        if (pk_count_ge<NI / 2>(hp, cand) >= 256) T16 = cand;
    }
    const int cgt_hi = (T16 < 0xFFFFu) ? pk_count_ge<NI / 2>(hp, T16 + 1u) : 0;
    const int need_lo = 256 - cgt_hi;
#pragma unroll
    for (int m = 0; m < NI / 2; ++m) {
        const unsigned a = uk[2 * m], b2 = uk[2 * m + 1];
        const unsigned la = ((a >> 16) == T16) ? (a & 0xFFFFu) : 0u, lb = ((b2 >> 16) == T16) ? (b2 << 16) : 0u;
        hp[m] = la | lb;
    }
    unsigned L16 = 0u;
    for (int bit = 15; bit >= 0; --bit) {
        const unsigned cand = L16 | (1u << bit);
        if (pk_count_ge<NI / 2>(hp, cand) >= need_lo) L16 = cand;
    }
    const unsigned Tq = (T16 << 16) | L16;
    int cgt = 0;
#pragma unroll
    for (int i = 0; i < NI; ++i) cgt += __builtin_popcountll(__ballot(uk[i] > Tq));
    int rem = 256 - cgt;
    u64 myout = (lane == 0) ? (0xFFFFull << 48) : 0ull;
#pragma unroll
    for (int i = 0; i < NI; ++i) {
        const u64 gt = __ballot(uk[i] > Tq); u64 eq = __ballot(uk[i] == Tq);
        const int ce = __builtin_popcountll(eq);
        if (ce > rem) eq = __ballot(((eq >> lane) & 1ull) && (int)__builtin_amdgcn_mbcnt_hi((unsigned)(eq >> 32), __builtin_amdgcn_mbcnt_lo((unsigned)eq, 0u)) < rem);
        rem -= (ce > rem) ? rem : ce;
        const u64 sel = gt | eq;
        if (lane == i + 1) myout = sel;
    }
    return myout;
}

__device__ __forceinline__ void indexer_phase(const Args& A, unsigned char* smem) {
    unsigned char* ws = A.ws; unsigned* ctr = (unsigned*)(ws + OFF_CTR) + 1;
    const bf16_t* IQ = (const bf16_t*)(ws + OFF_IQ); const bf16_t* IK = (const bf16_t*)(ws + OFF_IK); const float* IW = (const float*)(ws + OFF_IW);
    u64* mask64 = (u64*)(ws + OFF_MASK);
    constexpr int SKS = 2052;
    unsigned* sk = (unsigned*)smem;
    const int tid = threadIdx.x, lane = tid & 63, w = __builtin_amdgcn_readfirstlane(tid >> 6), fr = lane & 15, quad = lane >> 4;
    for (;;) {
        const unsigned u = next_unit(ctr, smem); if (u >= 1024u) break;
        const int g = 127 - (int)(u >> 3), b = (int)(u & 7), s0 = 16 * g, row0 = b * SEQ + s0;
        const int nkeys = s0 + 16, ni = (nkeys + 63) >> 6;
        if (g >= 16) {
            { const int nz = 512 * ((ni + 7) >> 3) - nkeys; for (int i = tid; i < 16 * nz; i += 512) { const int r = i / nz, c = nkeys + (i % nz); sk[r * SKS + c] = 0u; } }
            bf16x8 qf[8][2];
#pragma unroll
            for (int h = 0; h < 8; ++h)
#pragma unroll
                for (int ks = 0; ks < 2; ++ks) qf[h][ks] = *(const bf16x8*)(IQ + (size_t)(row0 + fr) * 512 + h * 64 + ks * 32 + quad * 8);
            const float4 w0 = *(const float4*)(IW + (size_t)(row0 + fr) * 8), w1 = *(const float4*)(IW + (size_t)(row0 + fr) * 8 + 4);
            const float wq[8] = {w0.x, w0.y, w0.z, w0.w, w1.x, w1.y, w1.z, w1.w};
            const bf16_t* kbase = IK + (size_t)(b * SEQ + fr) * 64 + quad * 8;
            bf16x8 nk0 = *(const bf16x8*)(kbase + (size_t)(16 * w) * 64), nk1 = *(const bf16x8*)(kbase + (size_t)(16 * w) * 64 + 32);
            for (int kt = w; kt <= g; kt += 8) {
                const bf16x8 kf0 = nk0, kf1 = nk1;
                if (kt + 8 <= g) { nk0 = *(const bf16x8*)(kbase + (size_t)(16 * (kt + 8)) * 64); nk1 = *(const bf16x8*)(kbase + (size_t)(16 * (kt + 8)) * 64 + 32); }
                float sc[4] = {0.f, 0.f, 0.f, 0.f};
#pragma unroll
                for (int h = 0; h < 8; ++h) {
                    f32x4 c = __builtin_amdgcn_mfma_f32_16x16x32_bf16(kf0, qf[h][0], (f32x4){0.f, 0.f, 0.f, 0.f}, 0, 0, 0);
                    c = __builtin_amdgcn_mfma_f32_16x16x32_bf16(kf1, qf[h][1], c, 0, 0, 0);
#pragma unroll
                    for (int j = 0; j < 4; ++j) sc[j] += wq[h] * fmaxf(c[j], 0.f);
                }
                unsigned kk[4];
#pragma unroll
                for (int j = 0; j < 4; ++j) {
                    const int s = 16 * kt + quad * 4 + j;
                    const unsigned bits = __float_as_uint(sc[j] + 0.0f);
                    const unsigned ok = bits ^ ((unsigned)((int)bits >> 31) | 0x80000000u);
                    kk[j] = (s > s0 + fr) ? 0u : ok;
                }
                *(uint4*)(sk + fr * SKS + 16 * kt + quad * 4) = make_uint4(kk[0], kk[1], kk[2], kk[3]);
            }
        }
        __syncthreads();
#ifdef DUPB
#define NQQ 4
#else
#define NQQ 2
#endif
#pragma unroll 1
        for (int qq_ = 0; qq_ < NQQ; ++qq_) {
            const int qq = qq_ & 1; const int q = 2 * w + qq; const int sq = s0 + q;
            u64 myout = 0ull;
            if (g >= 16) {
                const unsigned* skq = sk + q * SKS;
                const int n8 = (ni + 7) >> 3;
                if (n8 == 1) myout = select_query<8>(skq, lane); else if (n8 == 2) myout = select_query<16>(skq, lane);
                else if (n8 == 3) myout = select_query<24>(skq, lane); else myout = select_query<32>(skq, lane);
            } else {
                const int lim = sq - 64 * (lane - 1);
                myout = lane == 0 ? (0xFFFFull << 48) : (lim >= 63 ? ~0ull : (lim < 0 ? 0ull : ((2ull << lim) - 1ull)));
            }
            if (lane < 33) mask64[(size_t)(row0 + q) * 33 + lane] = myout;
        }
    }
}


__device__ __forceinline__ void meta_down_phase(const Args& A, unsigned char* smem) {
    unsigned char* ws = A.ws;
    const bf16_t* act = (const bf16_t*)(ws + OFF_ACT); const bf16_t* Wd = (const bf16_t*)(ws + OFF_WD1);
    float* part = (float*)(ws + OFF_MPART); unsigned* ctr = (unsigned*)(ws + OFF_CTR) + 16;
    bf16_t* h1b = (bf16_t*)(ws + OFF_H1B); float* ssq1 = (float*)(ws + OFF_SSQ1);
    const int tid = threadIdx.x, lane = tid & 63, w = __builtin_amdgcn_readfirstlane(tid >> 6), fr = lane & 15, quad = lane >> 4;
    float* lred = (float*)smem;
    volatile unsigned* sh = (volatile unsigned*)(smem + LDS_CTL + 16);
    for (int task = blockIdx.x; task < 64; task += gridDim.x) {
        const int ct = task & 15, ksp = task >> 4;
        f32x4 acc[4];
#pragma unroll
        for (int h = 0; h < 4; ++h) acc[h] = (f32x4){0.f, 0.f, 0.f, 0.f};
        for (int ks = w; ks < 22; ks += 8) {
            const int kb = ksp * 704 + ks * 32 + quad * 8;
            const bf16x8 af = *(const bf16x8*)(act + (size_t)(MR + fr) * DFF + kb);
            bf16x8 bfv[4];
#pragma unroll
            for (int h = 0; h < 4; ++h) bfv[h] = *(const bf16x8*)(Wd + (size_t)(64 * ct + 16 * h + fr) * DFF + kb);
#pragma unroll
            for (int h = 0; h < 4; ++h) acc[h] = __builtin_amdgcn_mfma_f32_16x16x32_bf16(af, bfv[h], acc[h], 0, 0, 0);
        }
        __syncthreads();
#pragma unroll
        for (int h = 0; h < 4; ++h)
#pragma unroll
            for (int j = 0; j < 4; ++j) lred[(w * 16 + quad * 4 + j) * 64 + 16 * h + fr] = acc[h][j];
        __syncthreads();
#pragma unroll
        for (int q = 0; q < 2; ++q) {
            const int e = tid + 512 * q; float v = 0.f;
#pragma unroll
            for (int ww = 0; ww < 8; ++ww) v += lred[ww * 1024 + e];
            part[((size_t)ksp * 16 + (e >> 6)) * DM + 64 * ct + (e & 63)] = v;
        }
        __threadfence();
        __syncthreads();
        if (tid == 0) { const unsigned old = atomicAdd(ctr + ct, 1u); *sh = (old == 3u) ? 1u : 0u; }
        __syncthreads();
        if (*sh) {
            __threadfence();
#pragma unroll
            for (int q = 0; q < 2; ++q) {
                const int e = tid + 512 * q, m = e >> 6, c = 64 * ct + (e & 63);
                float hv = 0.f;
#pragma unroll
                for (int k4 = 0; k4 < 4; ++k4) hv += __hip_atomic_load(part + ((size_t)k4 * 16 + m) * DM + c, __ATOMIC_RELAXED, __HIP_MEMORY_SCOPE_AGENT);
                const float hval = A.in[1][(size_t)m * DM + c] + 0.5f * hv;
                h1b[(size_t)(MR + m) * DM + c] = f2bf(hval);
                const float s = wave_sum(hval * hval);
                if (lane == 0) atomicAdd(ssq1 + MR + m, s);
            }
        }
    }
    __syncthreads();
}

__device__ __forceinline__ void meta_proj_phase(const Args& A, unsigned char* smem) {
    unsigned char* ws = A.ws;
    const bf16_t* hm = (const bf16_t*)(ws + OFF_H1B) + (size_t)MR * DM; const bf16_t* W = (const bf16_t*)(ws + OFF_WINA);
    const float* ssq1 = (const float*)(ws + OFF_SSQ1); const float2* tab256 = (const float2*)(ws + OFF_TAB256);
    bf16_t* RKs = (bf16_t*)(ws + OFF_RKS); bf16_t* RVt = (bf16_t*)(ws + OFF_RVT);
    const int tid = threadIdx.x, lane = tid & 63, w = __builtin_amdgcn_readfirstlane(tid >> 6), fr = lane & 15, quad = lane >> 4;
    float* lred = (float*)smem;
    float* red2 = (float*)(smem + 65536);
    for (int task = blockIdx.x; task < 24; task += gridDim.x) {
        const int nbase = 1024 + 128 * task;
        f32x4 acc[8];
#pragma unroll
        for (int h = 0; h < 8; ++h) acc[h] = (f32x4){0.f, 0.f, 0.f, 0.f};
        for (int ks = w; ks < 32; ks += 8) {
            const int kb = ks * 32 + quad * 8;
            const bf16x8 af = *(const bf16x8*)(hm + (size_t)fr * DM + kb);
            bf16x8 bfv[8];
#pragma unroll
            for (int h = 0; h < 8; ++h) bfv[h] = *(const bf16x8*)(W + (size_t)(nbase + 16 * h + fr) * DM + kb);
#pragma unroll
            for (int h = 0; h < 8; ++h) acc[h] = __builtin_amdgcn_mfma_f32_16x16x32_bf16(af, bfv[h], acc[h], 0, 0, 0);
        }
        __syncthreads();
#pragma unroll
        for (int h = 0; h < 8; ++h)
#pragma unroll
            for (int j = 0; j < 4; ++j) lred[(w * 16 + quad * 4 + j) * 128 + 16 * h + fr] = acc[h][j];
        __syncthreads();
#pragma unroll
        for (int q = 0; q < 4; ++q) { const int e = tid + 512 * q; float v = 0.f;
#pragma unroll
            for (int ww = 0; ww < 8; ++ww) v += lred[ww * 2048 + e];
            red2[e] = v; }
        __syncthreads();
        if (task < 8) {
            const int head = task >> 1;
#pragma unroll
            for (int q = 0; q < 2; ++q) {
                const int pe = tid + 512 * q, row = pe >> 6, g4 = (pe >> 4) & 3, i = pe & 15;
                const float x1 = red2[row * 128 + 32 * g4 + i], x2 = red2[row * 128 + 32 * g4 + 16 + i];
                const float r = rsqrtf(ssq1[MR + row] * (1.f / 1024.f) + EPSN) * 0.0625f;
                const int jj = 16 * (4 * (task & 1) + g4) + i; const float2 cs = tab256[(size_t)row * 128 + jj];
                const bf16_t o1 = f2bf((x1 * cs.x - x2 * cs.y) * r), o2 = f2bf((x2 * cs.x + x1 * cs.y) * r);
                for (int bb = 0; bb < NB; ++bb) { bf16_t* d = RKs + ((size_t)bb * TP + SPOS0 + row) * 1024 + head * 256 + jj; d[0] = o1; d[128] = o2; }
            }
        } else {
#pragma unroll
            for (int q = 0; q < 4; ++q) {
                const int e = tid + 512 * q, row = e >> 7, cin = 128 * (task - 8) + (e & 127); const int head = cin >> 9, dv = cin & 511;
                const bf16_t v = f2bf(red2[e] * rsqrtf(ssq1[MR + row] * (1.f / 1024.f) + EPSN));
                for (int bb = 0; bb < NB; ++bb) RVt[((size_t)(bb * 4 + head) * 512 + dv) * TP + vpos(SPOS0 + row)] = v;
            }
        }
        __syncthreads();
    }
    __syncthreads();
}
#define LAS __attribute__((address_space(3)))
#define XB_TMO      128
#define XB_XCNT(j)  (256  + 64 * (j))
#define XB_XSUB(j)  (1280 + 64 * (j))
#define XB_XGEN(j)  (2304 + 64 * (j))
#define XB_TOP      3328
#define XB_TOPGEN   3392
#define XCD_BAR_WORDS 3456
#define XB_SPIN_CAP (1u << 18)

__device__ __forceinline__ unsigned xb_ld(unsigned* p)              { return __hip_atomic_load(p, __ATOMIC_RELAXED, __HIP_MEMORY_SCOPE_AGENT); }
__device__ __forceinline__ unsigned xb_add(unsigned* p, unsigned v) { return __hip_atomic_fetch_add(p, v, __ATOMIC_RELAXED, __HIP_MEMORY_SCOPE_AGENT); }
__device__ __forceinline__ unsigned xb_xcc_id() { return (unsigned)__builtin_amdgcn_s_getreg((3 << 11) | 20) & 0xFu; }
#define XB_SPIN(cond, bar) do { unsigned _sp = 0; while (cond) { __builtin_amdgcn_s_sleep(1); \
    if ((++_sp & 255u) == 0u) { if (xb_ld(&(bar)[XB_TMO])) break; if (_sp > XB_SPIN_CAP) { atomicAdd(&(bar)[XB_TMO], 1u); break; } } } } while (0)

struct XcdBarrier {
    unsigned* bar; unsigned x;
    volatile LAS unsigned* st;
};

__device__ __forceinline__ XcdBarrier xcd_barrier_post(unsigned* bar, volatile LAS unsigned* st) {
    XcdBarrier b; b.bar = bar; b.x = xb_xcc_id(); b.st = st;
    if (threadIdx.x == 0) (void)xb_add(&bar[XB_XCNT(b.x)], 1u);
    return b;
}
__device__ __forceinline__ void xcd_barrier_complete(unsigned* bar, unsigned x, unsigned& nloc, unsigned& nx) {
    const unsigned G = gridDim.x * gridDim.y * gridDim.z;
    unsigned sum, cnt, mine, sp = 0u;
    for (;;) {
        sum = 0u; cnt = 0u; mine = 0u;
#pragma unroll
        for (unsigned j = 0; j < 16; ++j) { const unsigned c = xb_ld(&bar[XB_XCNT(j)]); sum += c; cnt += (c > 0u) ? 1u : 0u; mine = (j == x) ? c : mine; }
        if (sum == G) break;
        __builtin_amdgcn_s_sleep(1);
        if ((++sp & 255u) == 0u) { if (xb_ld(&bar[XB_TMO])) break; if (sp > XB_SPIN_CAP) { atomicAdd(&bar[XB_TMO], 1u); break; } }
    }
    nloc = mine > 0u ? mine : 1u; nx = cnt > 0u ? cnt : 1u;
}

__device__ __forceinline__ void xcd_barrier(const XcdBarrier& b) {
    asm volatile("s_waitcnt vmcnt(0)" ::: "memory");
    __syncthreads();
    if (threadIdx.x == 0) {
        unsigned* bar = b.bar;
        __builtin_amdgcn_s_waitcnt(0);
        unsigned nloc = b.st[0], nx = b.st[1];
        if (nloc == 0u) { xcd_barrier_complete(bar, b.x, nloc, nx); b.st[0] = nloc; b.st[1] = nx; }
        const unsigned old = xb_add(&bar[XB_XSUB(b.x)], 1u);
        const unsigned gen = old / nloc;
        if (old + 1u == (gen + 1u) * nloc) {
            __builtin_amdgcn_fence(__ATOMIC_RELEASE, "agent");
            asm volatile("s_waitcnt vmcnt(0)" ::: "memory");
            const unsigned og = xb_add(&bar[XB_TOP], 1u);
            const unsigned tg = og / nx;
            if (og + 1u == (tg + 1u) * nx) xb_add(&bar[XB_TOPGEN], 1u);
            else XB_SPIN(xb_ld(&bar[XB_TOPGEN]) == tg, bar);
            __builtin_amdgcn_fence(__ATOMIC_ACQUIRE, "agent");
            xb_add(&bar[XB_XGEN(b.x)], 1u);
            asm volatile("s_waitcnt vmcnt(0)" ::: "memory");
        } else {
            XB_SPIN(xb_ld(&bar[XB_XGEN(b.x)]) == gen, bar);
            __builtin_amdgcn_fence(__ATOMIC_ACQUIRE, "agent");
            asm volatile("s_waitcnt vmcnt(0)" ::: "memory");
        }
    }
    __syncthreads();
}
#define GEMM_PHASE(EPI, e, Aptr, Bptr, Mrows, Ncols, Kdim) do { pg8::Gemm g_{(const bf16_t*)(Aptr), (const bf16_t*)(Bptr), (Mrows), (Ncols), (Kdim)}; pg8::StaticOrder S_; S_.init((Mrows), (Ncols), (int)gridDim.x, (int)blockIdx.x); \
    pg8::gemm_phase<EPI, pg8::StaticOrder, true, true>((PG8_LAS unsigned char*)smem, g_, S_, e); } while (0)

__global__ void __launch_bounds__(512, 2) mk_fwd(Args A) {
    extern __shared__ __attribute__((aligned(16))) unsigned char smem[];
    unsigned char* ws = A.ws;
    const int lo = A.ph_lo, hi = A.ph_hi;
    volatile LAS unsigned* xst = (volatile LAS unsigned*)((LAS unsigned char*)smem + LDS_CTL + 64);
    if (threadIdx.x < 2) xst[threadIdx.x] = 0u;
    __syncthreads();
    const XcdBarrier xbar = xcd_barrier_post((unsigned*)(ws + OFF_BAR), xst);
#ifndef PHMASK
#define PHMASK 0xFFFFF
#endif
#define IN(k) (((PHMASK >> (k)) & 1) && lo <= (k) && (k) < hi)
#if MK_COOP
#define SEAM(k) do { if (IN(k) && IN((k) + 1)) { if ((k) == 0) cg::this_grid().sync(); else xcd_barrier(xbar); } } while (0)
#else
#define SEAM(k) do { } while (0)
#endif
#ifdef PROBE_PHASE
    unsigned long long pt0 = 0, pt1 = 0;
#define PSTAMP(k) do { if ((k) == PROBE_PHASE) pt0 = __builtin_amdgcn_s_memrealtime(); if ((k) == PROBE_PHASE + 1) pt1 = __builtin_amdgcn_s_memrealtime(); } while (0)
#else
#define PSTAMP(k) do { } while (0)
#endif
    float* ssq0 = (float*)(ws + OFF_SSQ0); float* ssq1 = (float*)(ws + OFF_SSQ1); float* ssq2 = (float*)(ws + OFF_SSQ2); float* ssq3 = (float*)(ws + OFF_SSQ3); float* ssqY = (float*)(ws + OFF_SSQY);
    bf16_t* h1b = (bf16_t*)(ws + OFF_H1B); bf16_t* delta = (bf16_t*)(ws + OFF_DELTA);
    PSTAMP(0);
    if (IN(0)) { p0_prologue(A, smem); }
    SEAM(0);
    PSTAMP(1);
    if (IN(1)) { EpiSwiGLU e{(bf16_t*)(ws + OFF_ACT), ssq0}; GEMM_PHASE(EpiSwiGLU, e, A.out, ws + OFF_W1, MP, 5632, DM); }
    SEAM(1);
    PSTAMP(2);
    if (IN(2)) { meta_down_phase(A, smem); EpiResid e{A.in[0], nullptr, nullptr, nullptr, h1b, delta, ssq1, 0.5f}; GEMM_PHASE(EpiResid, e, ws + OFF_ACT, ws + OFF_WD1, MR, DM, DFF); }
    SEAM(2);
    PSTAMP(3);
    if (IN(3)) { EpiRet e{ssq1, (const float2*)(ws + OFF_TAB256), (bf16_t*)(ws + OFF_RQ), (bf16_t*)(ws + OFF_RKS), (bf16_t*)(ws + OFF_RVT)}; meta_proj_phase(A, smem); GEMM_PHASE(EpiRet, e, h1b, ws + OFF_WINA, MR, 4096, DM); }
    SEAM(3);
    PSTAMP(4);
    if (IN(4)) { retention_phase(A, smem); }
    SEAM(4);
    PSTAMP(5);
    if (IN(5)) { EpiAtt e{ssq1, (const float2*)(ws + OFF_TAB128), (const float2*)(ws + OFF_TAB64), ssqY, (bf16_t*)(ws + OFF_AQ), (bf16_t*)(ws + OFF_AKS), (bf16_t*)(ws + OFF_AVT),
                          (bf16_t*)(ws + OFF_IQ), (bf16_t*)(ws + OFF_IK), (float*)(ws + OFF_IW), (bf16_t*)A.out};
                 GEMM_PHASE(EpiAtt, e, h1b, ws + OFF_WINB, MP, 5888, DM); }
    SEAM(5);
    PSTAMP(6);
    if (IN(6)) { indexer_phase(A, smem); }
    SEAM(6);
    PSTAMP(7);
    if (IN(7)) { attention_phase(A, smem); }
    SEAM(7);
    PSTAMP(8);
    if (IN(8)) { { EpiPlain e{(bf16_t*)(ws + OFF_YR)}; GEMM_PHASE(EpiPlain, e, A.out, ws + OFF_WRO, MR, DM, 2048); }
                 { EpiPlain e{(bf16_t*)(ws + OFF_YA)}; GEMM_PHASE(EpiPlain, e, ws + OFF_AQ, ws + OFF_WAO, MR, DM, DM); } }
    SEAM(8);
    PSTAMP(9);
    if (IN(9)) { EpiGate e{ssq1, (bf16_t*)(ws + OFF_YR), (const bf16_t*)(ws + OFF_YA)}; GEMM_PHASE(EpiGate, e, h1b, ws + OFF_WINC, MR, 2048, DM); }
    SEAM(9);
    PSTAMP(10);
    if (IN(10)) { EpiResid e{A.in[0], delta, nullptr, A.out, h1b, nullptr, ssq2, 1.0f}; GEMM_PHASE(EpiResid, e, ws + OFF_YR, ws + OFF_WMX, MR, DM, DM); }
    SEAM(10);
    PSTAMP(11);
    if (IN(11)) { EpiSwiGLU e{(bf16_t*)(ws + OFF_ACT2), ssq2}; GEMM_PHASE(EpiSwiGLU, e, h1b, ws + OFF_W2, MR, 5632, DM); }
    SEAM(11);
    PSTAMP(12);
    if (IN(12)) { EpiResid e{A.out, nullptr, nullptr, A.out, nullptr, nullptr, ssq3, 0.5f}; GEMM_PHASE(EpiResid, e, ws + OFF_ACT2, ws + OFF_WD2, MR, DM, DFF); }
    SEAM(12);
    PSTAMP(13);
    if (IN(13)) {
        const float* gf = A.in[15];
        const int lane = threadIdx.x & 63, wave = threadIdx.x >> 6;
        for (int row = blockIdx.x * 8 + wave; row < MR; row += gridDim.x * 8) {
            const float r = rstd1024(ssq3, row);
            float4* p = (float4*)(A.out + (size_t)row * DM);
#ifdef PROBE_PHASE
            const float pd = 0.08f * sqrtf((float)(pt1 - pt0) * 1e-5f);
#endif
#pragma unroll
            for (int j = 0; j < 4; ++j) { float4 v = p[lane + 64 * j]; const float4 g = ((const float4*)gf)[lane + 64 * j];
                v.x *= r * g.x; v.y *= r * g.y; v.z *= r * g.z; v.w *= r * g.w;
#ifdef PROBE_PHASE
                if (j == 0 && lane == 0) v.x += pd;
#endif
                p[lane + 64 * j] = v; }
        }
    }
}
constexpr int NPHASE = 14;

extern "C" void kernel_launch(void* const* d_in, const int* in_sizes, int n_in, void* d_out, int out_size, void* d_ws, size_t ws_size, hipStream_t stream) {
    static int grid = 0;
    if (grid == 0) {
        if (n_in != 16 || out_size != MR * DM || ws_size < 256 * MiB) { fprintf(stderr, "kernel_launch: unexpected problem (n_in %d out %d ws %zu)\n", n_in, out_size, ws_size); grid = -1; return; }
        int dev = 0, cus = 0, per_cu = 0;
        hipGetDevice(&dev); hipDeviceGetAttribute(&cus, hipDeviceAttributeMultiprocessorCount, dev);
        if (hipFuncSetAttribute((const void*)mk_fwd, hipFuncAttributeMaxDynamicSharedMemorySize, LDS_BYTES) != hipSuccess) { fprintf(stderr, "kernel_launch: hipFuncSetAttribute failed\n"); grid = -1; return; }
        hipOccupancyMaxActiveBlocksPerMultiprocessor(&per_cu, (const void*)mk_fwd, 512, LDS_BYTES);
        (void)hipGetLastError();
        if (per_cu < 1) per_cu = 1;
        grid = cus * 1;
        fprintf(stderr, "kernel_launch: cus %d per_cu %d grid %d\n", cus, per_cu, grid);
    }
    if (grid < 0) return;
    Args a{};
    for (int i = 0; i < 16; ++i) a.in[i] = (const float*)d_in[i];
    a.out = (float*)d_out; a.ws = (unsigned char*)d_ws;
    for (int h = 0; h < 4; ++h) a.l2g[h] = (float)(std::log1p(-std::ldexp(1.0, -5 - h)) / std::log(2.0));
#if MK_COOP
    if (hipMemsetAsync((char*)d_ws + OFF_BAR, 0, 16384, stream) != hipSuccess) { fprintf(stderr, "kernel_launch: memset failed\n"); return; }
    a.ph_lo = 0; a.ph_hi = NPHASE;
    void* args[] = {&a};
    hipError_t e = hipLaunchCooperativeKernel((const void*)mk_fwd, dim3(grid), dim3(512), args, LDS_BYTES, stream);
    if (e != hipSuccess) fprintf(stderr, "cooperative launch failed: %s (grid %d)\n", hipGetErrorString(e), grid);
#else
    for (int p = 0; p < NPHASE; ++p) { a.ph_lo = p; a.ph_hi = p + 1; hipLaunchKernelGGL(mk_fwd, dim3(grid), dim3(512), LDS_BYTES, stream, a); }
#endif
}
```
